# Optimizing an MI355X kernel written in HIP

```python
import math
import jax, jax.numpy as jnp
from jax import lax
import numpy as np

D_MODEL = 2048
BATCH = 4
SEQ = 4096
DEPTH = 1

DN_HEADS = 16
DN_DK = 128
DN_DV = 128
DN_CONV = 4
DN_CHUNK = 64
DN_QK = DN_HEADS * DN_DK
DN_VW = DN_HEADS * DN_DV
MB_HEADS = 16
MB_HD = 128
MB_W = MB_HEADS * MB_HD
MB_BLOCK = 256
MB_TOPK = 3
MB_Q_CHUNK = 32
RP_BUCKETS = 32
RP_MAX_DIST = 1024
D_FF = 5632
NORM_EPS = 1e-6
N_ADA = 9
IN_SIZES = (2 * DN_QK + DN_VW, DN_VW, DN_HEADS, DN_HEADS, MB_W, MB_W, MB_W, D_MODEL, D_MODEL)
IN_WIDTH = 2 * DN_QK + 2 * DN_VW + 2 * DN_HEADS + 3 * MB_W + 2 * D_MODEL

kernel_name = "hybrid_deltanet_moba_macaron_adaln"


def rms_norm(x, gain):
    xf = x.astype(jnp.float32)
    y = xf * lax.rsqrt(jnp.mean(xf * xf, axis=-1, keepdims=True) + NORM_EPS)
    return (y * gain.astype(jnp.float32)).astype(x.dtype)


def l2norm(x):
    xf = x.astype(jnp.float32)
    return xf * lax.rsqrt(jnp.sum(xf * xf, axis=-1, keepdims=True) + NORM_EPS)


def modulate(xn, shift, scale):
    return xn * (1.0 + scale) + shift


def swiglu(x, w1, w3, w2):
    return (jax.nn.silu(x @ w1) * (x @ w3)) @ w2


def causal_depthwise_conv(x, w):
    K = w.shape[0]
    T = x.shape[1]
    xp = jnp.pad(x, ((0, 0), (K - 1, 0), (0, 0)))
    return sum(xp[:, j:j + T, :] * w[j] for j in range(K))


def gated_delta_chunked(q, k, v, g, beta):
    B, T, H, DK = q.shape
    DV = v.shape[-1]
    C = DN_CHUNK
    N = T // C
    f32 = jnp.float32

    def to_chunks(a):
        a = a.astype(f32).reshape((B, N, C, H) + a.shape[3:])
        return jnp.moveaxis(a, 3, 1)

    q, k, v, g, beta = (to_chunks(a) for a in (q, k, v, g, beta))
    q = q * (DK ** -0.5)
    gc = jnp.cumsum(g, axis=-1)
    idx = jnp.arange(C)
    incl = idx[:, None] >= idx[None, :]
    strict = idx[:, None] > idx[None, :]
    decay = jnp.exp(jnp.where(incl, gc[..., :, None] - gc[..., None, :], -jnp.inf))
    k_beta = k * beta[..., None]
    Lmat = jnp.where(strict, jnp.einsum('bhncd,bhnsd->bhncs', k_beta, k) * decay, 0.0)
    eye = jnp.eye(C, dtype=f32)
    Tm = lax.linalg.triangular_solve(eye + Lmat, jnp.broadcast_to(eye, Lmat.shape),
                                     left_side=True, lower=True, unit_diagonal=True)
    u = jnp.einsum('bhncs,bhnsd->bhncd', Tm, v * beta[..., None])
    w = jnp.einsum('bhncs,bhnsd->bhncd', Tm, k_beta * jnp.exp(gc)[..., None])
    qk = jnp.einsum('bhncd,bhnsd->bhncs', q, k) * decay
    q_dec = q * jnp.exp(gc)[..., None]
    k_dec = k * jnp.exp(gc[..., -1:] - gc)[..., None]
    g_tot = jnp.exp(gc[..., -1])

    def step(S, xs):
        qk_c, qd_c, kd_c, u_c, w_c, gt_c = xs
        v_new = u_c - jnp.einsum('bhcd,bhde->bhce', w_c, S)
        o = jnp.einsum('bhcd,bhde->bhce', qd_c, S) + jnp.einsum('bhcs,bhse->bhce', qk_c, v_new)
        S = S * gt_c[..., None, None] + jnp.einsum('bhcd,bhce->bhde', kd_c, v_new)
        return S, o

    xs = tuple(jnp.moveaxis(a, 2, 0) for a in (qk, q_dec, k_dec, u, w, g_tot))
    S0 = jnp.zeros((B, H, DK, DV), f32)
    _, o = lax.scan(step, S0, xs)
    return jnp.transpose(o, (1, 0, 3, 2, 4)).reshape(B, T, H, DV)


def t5_bucket(dist):
    max_exact = RP_BUCKETS // 2
    d = jnp.maximum(dist, 0)
    large = max_exact + (jnp.log(jnp.maximum(d, 1).astype(jnp.float32) / max_exact)
                         / math.log(RP_MAX_DIST / max_exact) * (RP_BUCKETS - max_exact)).astype(jnp.int32)
    large = jnp.minimum(large, RP_BUCKETS - 1)
    return jnp.where(d < max_exact, d, large)


def moba_attention(q, k, v, rel_bias):
    B, T, H, D = q.shape
    blk = MB_BLOCK
    nb = -(-T // blk)
    Tp = nb * blk
    f32 = jnp.float32
    q = jnp.transpose(q, (0, 2, 1, 3)).astype(f32) * (D ** -0.5)
    pad = ((0, 0), (0, 0), (0, Tp - T), (0, 0))
    kb = jnp.pad(jnp.transpose(k, (0, 2, 1, 3)).astype(f32), pad).reshape(B, H, nb, blk, D)
    vb = jnp.pad(jnp.transpose(v, (0, 2, 1, 3)).astype(f32), pad).reshape(B, H, nb, blk, D)
    k_mean = jnp.mean(kb, axis=3)
    pos = jnp.arange(T, dtype=jnp.int32)
    qblk = pos // blk
    gate = jnp.einsum('bhtd,bhjd->bhtj', q, k_mean)
    past = jnp.arange(nb)[None, :] < qblk[:, None]
    gate = jnp.where(past, gate, -jnp.inf)
    n_sel = min(MB_TOPK, nb)
    _, sel = lax.top_k(gate, n_sel)
    sel_valid = sel < qblk[:, None]
    rb = rel_bias.T.astype(f32)
    QC = MB_Q_CHUNK
    nq = T // QC

    def chunks(a):
        a = a.reshape(a.shape[:2] + (nq, QC) + a.shape[3:])
        return jnp.moveaxis(a, 2, 0)

    xs = (chunks(q), chunks(sel), chunks(sel_valid), pos.reshape(nq, QC))
    offs = jnp.arange(blk, dtype=jnp.int32)
    bi = jnp.arange(B)[:, None, None, None]
    hi = jnp.arange(H)[None, :, None, None]
    hi5 = jnp.arange(H)[None, :, None, None, None]

    def attend(args):
        qc, sc, vc, qp = args
        own = qp[0] // blk
        k_own = lax.dynamic_index_in_dim(kb, own, axis=2, keepdims=False)
        v_own = lax.dynamic_index_in_dim(vb, own, axis=2, keepdims=False)
        k_sel = kb[bi, hi, sc]
        v_sel = vb[bi, hi, sc]
        s_sel = jnp.einsum('bhqd,bhqskd->bhqsk', qc, k_sel)
        dist_sel = qp[None, None, :, None, None] - (sc[..., None] * blk + offs)
        s_sel = jnp.where(vc[..., None], s_sel + rb[hi5, t5_bucket(dist_sel)], -jnp.inf)
        dist_own = qp[:, None] - (own * blk + offs)[None, :]
        s_own = jnp.einsum('bhqd,bhkd->bhqk', qc, k_own) + rb[:, t5_bucket(dist_own)]
        s_own = jnp.where(dist_own >= 0, s_own, -jnp.inf)
        ns = sc.shape[-1] * blk
        logits = jnp.concatenate([s_sel.reshape(B, H, QC, ns), s_own], axis=-1)
        p = jax.nn.softmax(logits, axis=-1)
        p_sel = p[..., :ns].reshape(B, H, QC, sc.shape[-1], blk)
        p_own = p[..., ns:]
        return (jnp.einsum('bhqsk,bhqskd->bhqd', p_sel, v_sel)
                + jnp.einsum('bhqk,bhkd->bhqd', p_own, v_own))

    o = lax.map(attend, xs)
    o = jnp.transpose(o, (1, 0, 3, 2, 4)).reshape(B, T, H * D)
    return o


def hybrid_mixer(u, w_in, conv_w, a_log, dt_bias, dn_norm_g, q_norm_g, k_norm_g, rel_bias,
                 w_proj_a, w_proj_b, w_out):
    B, T, _ = u.shape
    f32 = jnp.float32
    proj = u @ w_in
    cuts, acc = [], 0
    for s in IN_SIZES[:-1]:
        acc += s
        cuts.append(acc)
    dn_qkv, dn_z, dn_b, dn_a, mb_q, mb_k, mb_v, gate_a, gate_b = jnp.split(proj, cuts, axis=-1)
    dn_qkv = jax.nn.silu(causal_depthwise_conv(dn_qkv, conv_w))
    q, k, v = jnp.split(dn_qkv, [DN_QK, 2 * DN_QK], axis=-1)
    q = l2norm(q.reshape(B, T, DN_HEADS, DN_DK))
    k = l2norm(k.reshape(B, T, DN_HEADS, DN_DK))
    v = v.reshape(B, T, DN_HEADS, DN_DV)
    beta = jax.nn.sigmoid(dn_b.astype(f32))
    g = -jnp.exp(a_log.astype(f32)) * jax.nn.softplus(dn_a.astype(f32) + dt_bias.astype(f32))
    o = gated_delta_chunked(q, k, v, g, beta)
    o = rms_norm(o, dn_norm_g) * jax.nn.silu(dn_z.reshape(B, T, DN_HEADS, DN_DV).astype(f32))
    y_a = o.reshape(B, T, DN_VW).astype(u.dtype)
    qm = rms_norm(mb_q.reshape(B, T, MB_HEADS, MB_HD), q_norm_g)
    km = rms_norm(mb_k.reshape(B, T, MB_HEADS, MB_HD), k_norm_g)
    vm = mb_v.reshape(B, T, MB_HEADS, MB_HD)
    y_b = moba_attention(qm, km, vm, rel_bias).astype(u.dtype)
    merged = jax.nn.sigmoid(gate_a) * (y_a @ w_proj_a) + jax.nn.sigmoid(gate_b) * (y_b @ w_proj_b)
    return merged @ w_out


def setup_inputs(seed: int = 0) -> dict:
    key = jax.random.key(seed)
    ks = jax.random.split(key, 26)
    f32 = jnp.float32
    L, D = DEPTH, D_MODEL
    conv_ch = 2 * DN_QK + DN_VW

    def nrm(k, shape, scale):
        return jax.random.normal(k, shape, f32) * scale

    def gain(k, shape):
        return 1.0 + 0.02 * jax.random.normal(k, shape, f32)

    dt = jnp.exp(jax.random.uniform(ks[12], (L, DN_HEADS), f32, math.log(1e-3), math.log(1e-1)))
    return {
        "x": nrm(ks[0], (BATCH, SEQ, D), 1.0),
        "c": nrm(ks[1], (BATCH, D), 1.0),
        "ada_w": nrm(ks[2], (L, D, N_ADA * D), 0.5 * D ** -0.5),
        "ada_b": nrm(ks[3], (L, N_ADA * D), 0.01),
        "norm1_g": gain(ks[4], (L, D)),
        "ffn1_w1": nrm(ks[5], (L, D, D_FF), D ** -0.5),
        "ffn1_w3": nrm(ks[6], (L, D, D_FF), D ** -0.5),
        "ffn1_w2": nrm(ks[7], (L, D_FF, D), D_FF ** -0.5),
        "norm2_g": gain(ks[8], (L, D)),
        "w_in": nrm(ks[9], (L, D, IN_WIDTH), D ** -0.5),
        "dn_conv_w": nrm(ks[10], (L, DN_CONV, conv_ch), 0.5),
        "dn_a_log": jnp.log(jax.random.uniform(ks[11], (L, DN_HEADS), f32, 1.0, 16.0)),
        "dn_dt_bias": dt + jnp.log(-jnp.expm1(-dt)),
        "dn_norm_g": gain(ks[13], (L, DN_DV)),
        "mb_q_norm_g": gain(ks[14], (L, MB_HD)),
        "mb_k_norm_g": gain(ks[15], (L, MB_HD)),
        "rel_bias": nrm(ks[16], (RP_BUCKETS, MB_HEADS), 0.5),
        "w_proj_a": nrm(ks[17], (L, DN_VW, D), DN_VW ** -0.5),
        "w_proj_b": nrm(ks[18], (L, MB_W, D), MB_W ** -0.5),
        "w_out": nrm(ks[19], (L, D, D), D ** -0.5),
        "norm3_g": gain(ks[20], (L, D)),
        "ffn2_w1": nrm(ks[21], (L, D, D_FF), D ** -0.5),
        "ffn2_w3": nrm(ks[22], (L, D, D_FF), D ** -0.5),
        "ffn2_w2": nrm(ks[23], (L, D_FF, D), D_FF ** -0.5),
    }


def reference(x, c, ada_w, ada_b, norm1_g, ffn1_w1, ffn1_w3, ffn1_w2, norm2_g, w_in, dn_conv_w,
              dn_a_log, dn_dt_bias, dn_norm_g, mb_q_norm_g, mb_k_norm_g, rel_bias, w_proj_a,
              w_proj_b, w_out, norm3_g, ffn2_w1, ffn2_w3, ffn2_w2):
    h = x
    for l in range(DEPTH):
        ada = jax.nn.silu(c) @ ada_w[l] + ada_b[l]
        sh1, sc1, g1, sh2, sc2, g2, sh3, sc3, g3 = jnp.split(ada[:, None, :], N_ADA, axis=-1)
        u = modulate(rms_norm(h, norm1_g[l]), sh1, sc1)
        h = h + 0.5 * g1 * swiglu(u, ffn1_w1[l], ffn1_w3[l], ffn1_w2[l])
        u = modulate(rms_norm(h, norm2_g[l]), sh2, sc2)
        h = h + g2 * hybrid_mixer(u, w_in[l], dn_conv_w[l], dn_a_log[l], dn_dt_bias[l], dn_norm_g[l],
                                  mb_q_norm_g[l], mb_k_norm_g[l], rel_bias, w_proj_a[l], w_proj_b[l],
                                  w_out[l])
        u = modulate(rms_norm(h, norm3_g[l]), sh3, sc3)
        h = h + 0.5 * g3 * swiglu(u, ffn2_w1[l], ffn2_w3[l], ffn2_w2[l])
    return h
```

```cpp
#include <hip/hip_runtime.h>
#include <hip/hip_cooperative_groups.h>
#include <cstdio>
#include <cstdint>
namespace cg = cooperative_groups;

#define LAS __attribute__((address_space(3)))
typedef unsigned short bf16_t;
typedef short bf16x8 __attribute__((ext_vector_type(8)));
typedef float f32x4 __attribute__((ext_vector_type(4)));
typedef unsigned u32x4 __attribute__((ext_vector_type(4)));
typedef unsigned u32x2 __attribute__((ext_vector_type(2)));

constexpr int M_ = 16384, D_ = 2048, FF_ = 5632, T_ = 4096;
constexpr int NIN1 = 12544, NIN2 = 6144, NADA = 18432;
constexpr float LOG2E = 1.4426950408889634f;
constexpr float QSCALE = 0.08838834764831845f;

constexpr size_t SZ_MD = (size_t)M_ * D_ * 2;
constexpr size_t WS_W13 = 0;
constexpr size_t WS_W2 = WS_W13 + (size_t)11264 * 2048 * 2;
constexpr size_t WS_WIN1 = WS_W2 + (size_t)2048 * 5632 * 2;
constexpr size_t WS_WIN2 = WS_WIN1 + (size_t)NIN1 * 2048 * 2;
constexpr size_t WS_WPAB = WS_WIN2 + (size_t)NIN2 * 2048 * 2;
constexpr size_t WS_WOUT = WS_WPAB + (size_t)2048 * 4096 * 2;
constexpr size_t WS_ADA = WS_WOUT + (size_t)2048 * 2048 * 2;
constexpr size_t WS_BT = WS_ADA + (size_t)4 * NADA * 4;
constexpr size_t WS_KMEAN = WS_BT + (size_t)16 * 4096 * 4;
constexpr size_t WS_U = WS_KMEAN + (size_t)4 * 16 * 16 * 128 * 4;
constexpr size_t WS_BIG = WS_U + SZ_MD;
constexpr size_t WS_QKV = WS_BIG;
constexpr size_t WS_MB = WS_QKV + 3 * SZ_MD;
constexpr size_t WS_BA = WS_MB + 3 * SZ_MD;
constexpr size_t WS_WDN = WS_BA + (size_t)M_ * 32 * 4;
constexpr size_t WS_QK = WS_WDN + SZ_MD;
constexpr size_t WS_XBAR = WS_QK + SZ_MD / 2;
constexpr size_t WS_END = WS_XBAR + 16384;
constexpr size_t WS_ACT = WS_BIG;
constexpr size_t WS_ADAP = WS_BIG;
constexpr size_t WS_HALO = WS_WDN;

constexpr int LDS_BYTES = 147456;

struct Params {
    const float* x; const float* c; const float* ada_w; const float* ada_b; const float* norm1_g;
    const float* f1w1; const float* f1w3; const float* f1w2; const float* norm2_g; const float* w_in;
    const float* conv_w; const float* a_log; const float* dt_bias; const float* dn_norm_g; const float* qn_g; const float* kn_g;
    const float* rel_bias; const float* wpa; const float* wpb; const float* wout; const float* norm3_g;
    const float* f2w1; const float* f2w3; const float* f2w2;
    float* out; unsigned char* ws;
};

typedef float f32x2v __attribute__((ext_vector_type(2)));
typedef __bf16 bf16x2_t __attribute__((ext_vector_type(2)));
__device__ __forceinline__ unsigned cvt_pk_bf16(float lo, float hi) { f32x2v v = {lo, hi}; bf16x2_t r = __builtin_convertvector(v, bf16x2_t); return __builtin_bit_cast(unsigned, r); }
__device__ __forceinline__ bf16_t f2bf(float f) { return (bf16_t)(cvt_pk_bf16(f, 0.f) & 0xffffu); }
__device__ __forceinline__ float bf2f(unsigned b) { return __uint_as_float(b << 16); }
__device__ __forceinline__ float bflo(unsigned w) { return __uint_as_float(w << 16); }
__device__ __forceinline__ float bfhi(unsigned w) { return __uint_as_float(w & 0xffff0000u); }
__device__ __forceinline__ float wave_sum(float v) {
#pragma unroll
    for (int o = 1; o < 64; o <<= 1) v += __shfl_xor(v, o);
    return v;
}
__device__ __forceinline__ float wave_max(float v) {
#pragma unroll
    for (int o = 1; o < 64; o <<= 1) v = fmaxf(v, __shfl_xor(v, o));
    return v;
}
__device__ __forceinline__ float sigmoidf_(float x) { return __builtin_amdgcn_rcpf(1.0f + __builtin_amdgcn_exp2f(-x * LOG2E)); }
__device__ __forceinline__ float siluf_(float x) { return x * sigmoidf_(x); }
#define LDS_WAIT() asm volatile("s_waitcnt lgkmcnt(0)" ::: "memory")
__device__ __forceinline__ int tid_opaque() { int t = threadIdx.x; asm volatile("" : "+v"(t)); return t; }

namespace pg8 {
constexpr int BM = 256, BK = 64, HALF = 128, HTB = HALF * BK * 2, STAGE_BYTES = 8 * HTB, NXCD = 8, WGM = 4;
__host__ __device__ __forceinline__ int lds_byte(int r, int c) { const int st = (r >> 4) * 2 + (c >> 5), rr = r & 15, cc = c & 31, ob = rr * 64 + cc * 2; return st * 1024 + (ob ^ (((ob >> 9) & 1) << 5)); }
__host__ __device__ __forceinline__ void stage_rc(int b, int& R, int& C) { const int st = b / 1024, sb = b % 1024, swz = sb ^ (((sb >> 9) & 1) << 5); R = (st >> 1) * 16 + swz / 64; C = (st & 1) * 32 + (swz % 64) / 2; }
__host__ __device__ __forceinline__ int perm32(int rho) { const int n = rho >> 4, i = rho & 15; return 8 * (i >> 2) + 4 * n + (i & 3); }

struct Unit { int pm, pn; };
struct Gemm { const bf16_t* A; int lda; const bf16_t* Bt; int K; };

struct StaticOrder {
    int nM, nN, nwg, G, c;
    __device__ void init(int nM_, int nN_, int G_, int c_) { nM = nM_; nN = nN_; nwg = nM * nN; G = G_; c = c_; }
    __device__ bool next(int i, Unit& u) const {
        const long L = (long)i * G + c; if (L >= nwg) return false;
        int wgid = (int)L; { const int q = nwg / NXCD, r = nwg % NXCD, xcd = wgid % NXCD, off = wgid / NXCD; wgid = (xcd < r ? xcd * (q + 1) : r * (q + 1) + (xcd - r) * q) + off; }
        const int nig = WGM * nN, gid = wgid / nig, fm = gid * WGM, gsz = (nM - fm) < WGM ? (nM - fm) : WGM;
        u.pm = fm + ((wgid % nig) % gsz); u.pn = (wgid % nig) / gsz; return true;
    }
};

typedef f32x4 Acc[2][2][4][2];

struct EpiSwiglu {
    static constexpr bool PERM = true;
    bf16_t* O;
    __device__ __forceinline__ void operator()(const Acc& acc, const Unit& u, int wr, int wc, int fr, int fq) const {
        const int row0 = u.pm * BM + wr * 64 + fr, col0 = u.pn * 128 + wc * 32 + 8 * fq;
#pragma unroll
        for (int ai = 0; ai < 2; ++ai)
#pragma unroll
            for (int m = 0; m < 4; ++m) {
                bf16_t* rowp = O + (size_t)(row0 + ai * HALF + m * 16) * FF_ + col0;
                float v[8];
#pragma unroll
                for (int n = 0; n < 2; ++n)
#pragma unroll
                    for (int j = 0; j < 4; ++j) v[n * 4 + j] = siluf_(acc[ai][0][m][n][j]) * acc[ai][1][m][n][j];
                u32x4 w; w.x = cvt_pk_bf16(v[0], v[1]); w.y = cvt_pk_bf16(v[2], v[3]); w.z = cvt_pk_bf16(v[4], v[5]); w.w = cvt_pk_bf16(v[6], v[7]);
                *(u32x4*)rowp = w;
            }
    }
};
struct EpiResid {
    static constexpr bool PERM = false;
    const float* resid; float* out; const float* gada; float scale;
    __device__ __forceinline__ void operator()(const Acc& acc, const Unit& u, int wr, int wc, int fr, int fq) const {
        const int row0 = u.pm * BM + wr * 64 + fr, col0 = u.pn * BM + wc * 32 + 4 * fq;
        const float* g = gada + (size_t)(u.pm >> 4) * NADA;
        f32x4 gv[2][2];
#pragma unroll
        for (int bj = 0; bj < 2; ++bj)
#pragma unroll
            for (int n = 0; n < 2; ++n) gv[bj][n] = *(const f32x4*)(g + col0 + bj * HALF + n * 16) * scale;
#pragma unroll
        for (int ai = 0; ai < 2; ++ai)
#pragma unroll
            for (int m = 0; m < 4; ++m) {
                const size_t off = (size_t)(row0 + ai * HALF + m * 16) * D_ + col0;
#pragma unroll
                for (int bj = 0; bj < 2; ++bj)
#pragma unroll
                    for (int n = 0; n < 2; ++n) { const f32x4 r = *(const f32x4*)(resid + off + bj * HALF + n * 16); *(f32x4*)(out + off + bj * HALF + n * 16) = r + gv[bj][n] * acc[ai][bj][m][n]; }
            }
    }
};
__device__ __forceinline__ void store_bf16_tile(const Acc& acc, bf16_t* base, int ldc, int row0, int col0) {
#pragma unroll
    for (int ai = 0; ai < 2; ++ai)
#pragma unroll
        for (int m = 0; m < 4; ++m) {
            bf16_t* rowp = base + (size_t)(row0 + ai * HALF + m * 16) * ldc + col0;
#pragma unroll
            for (int bj = 0; bj < 2; ++bj) {
                const f32x4 v0 = acc[ai][bj][m][0], v1 = acc[ai][bj][m][1];
                u32x4 w; w.x = cvt_pk_bf16(v0[0], v0[1]); w.y = cvt_pk_bf16(v0[2], v0[3]); w.z = cvt_pk_bf16(v1[0], v1[1]); w.w = cvt_pk_bf16(v1[2], v1[3]);
                *(u32x4*)(rowp + bj * HALF) = w;
            }
        }
}
struct EpiIn1 {
    static constexpr bool PERM = true;
    bf16_t* QKV; bf16_t* MB; float* BA;
    __device__ __forceinline__ void operator()(const Acc& acc, const Unit& u, int wr, int wc, int fr, int fq) const {
        const int row0 = u.pm * BM + wr * 64 + fr, pn = u.pn;
        if (pn < 48) {
            bf16_t* base; int ldc, colt;
            if (pn < 24) { base = QKV; ldc = 6144; colt = pn * 256; }
            else { const int t = (pn - 24) >> 3; base = MB + (size_t)t * M_ * D_; ldc = 2048; colt = ((pn - 24) & 7) * 256; }
            store_bf16_tile(acc, base, ldc, row0, colt + wc * 32 + 8 * fq);
        } else if (wc == 0) {
#pragma unroll
            for (int ai = 0; ai < 2; ++ai)
#pragma unroll
                for (int m = 0; m < 4; ++m) { float* pp = BA + (size_t)(row0 + ai * HALF + m * 16) * 32 + 8 * fq; *(f32x4*)pp = acc[ai][0][m][0]; *(f32x4*)(pp + 4) = acc[ai][0][m][1]; }
        }
    }
};
struct EpiIn2 {
    static constexpr bool PERM = true;
    bf16_t* QKV; bf16_t* MBK;
    __device__ __forceinline__ void operator()(const Acc& acc, const Unit& u, int wr, int wc, int fr, int fq) const {
        const int row0 = u.pm * BM + wr * 64 + fr, pn = u.pn;
        bf16_t* base; int ldc, colt;
        if (pn < 16) { base = QKV; ldc = 6144; colt = pn * 256; }
        else { base = MBK; ldc = 2048; colt = (pn - 16) * 256; }
        store_bf16_tile(acc, base, ldc, row0, colt + wc * 32 + 8 * fq);
    }
};
struct EpiProjA {
    static constexpr bool PERM = true;
    const bf16_t* GA; int ldga; bf16_t* Tm;
    __device__ __forceinline__ void operator()(const Acc& acc, const Unit& u, int wr, int wc, int fr, int fq) const {
        const int row0 = u.pm * BM + wr * 64 + fr, col0 = u.pn * BM + wc * 32 + 8 * fq;
#pragma unroll
        for (int ai = 0; ai < 2; ++ai)
#pragma unroll
            for (int m = 0; m < 4; ++m) {
                const size_t row = (size_t)(row0 + ai * HALF + m * 16);
#pragma unroll
                for (int bj = 0; bj < 2; ++bj) {
                    const u32x4 ga = *(const u32x4*)(GA + row * ldga + col0 + bj * HALF);
                    u32x4 w;
#pragma unroll
                    for (int e = 0; e < 4; ++e) {
                        const float s0 = sigmoidf_(bflo(ga[e])), s1 = sigmoidf_(bfhi(ga[e]));
                        w[e] = cvt_pk_bf16(acc[ai][bj][m][e >> 1][(e & 1) * 2] * s0, acc[ai][bj][m][e >> 1][(e & 1) * 2 + 1] * s1);
                    }
                    *(u32x4*)(Tm + row * D_ + col0 + bj * HALF) = w;
                }
            }
    }
};
struct EpiProjB {
    static constexpr bool PERM = true;
    const bf16_t* GB; int ldgb; const bf16_t* Tm; bf16_t* O;
    __device__ __forceinline__ void operator()(const Acc& acc, const Unit& u, int wr, int wc, int fr, int fq) const {
        const int row0 = u.pm * BM + wr * 64 + fr, col0 = u.pn * BM + wc * 32 + 8 * fq;
#pragma unroll
        for (int ai = 0; ai < 2; ++ai)
#pragma unroll
            for (int m = 0; m < 4; ++m) {
                const size_t row = (size_t)(row0 + ai * HALF + m * 16);
#pragma unroll
                for (int bj = 0; bj < 2; ++bj) {
                    const u32x4 gb = *(const u32x4*)(GB + row * ldgb + col0 + bj * HALF), tv = *(const u32x4*)(Tm + row * D_ + col0 + bj * HALF);
                    u32x4 w;
#pragma unroll
                    for (int e = 0; e < 4; ++e) {
                        const float s0 = sigmoidf_(bflo(gb[e])), s1 = sigmoidf_(bfhi(gb[e]));
                        w[e] = cvt_pk_bf16(bflo(tv[e]) + acc[ai][bj][m][e >> 1][(e & 1) * 2] * s0, bfhi(tv[e]) + acc[ai][bj][m][e >> 1][(e & 1) * 2 + 1] * s1);
                    }
                    *(u32x4*)(O + row * D_ + col0 + bj * HALF) = w;
                }
            }
    }
};

template <class Epi>
__device__ __forceinline__ void gemm_phase(LAS unsigned char* lds, const Gemm g, const StaticOrder& S, const Epi& E) {
    const int tid = tid_opaque(), wid = __builtin_amdgcn_readfirstlane(tid >> 6), lane = tid & 63, wr = wid >> 2, wc = wid & 3, fr = lane & 15, fq = lane >> 4;
    const int K = g.K, nt = K / BK;
    unsigned voffA[2], voffB[2];
#pragma unroll
    for (int i = 0; i < 2; ++i) { int R, C; stage_rc(tid * 16 + i * 8192, R, C); const int Rb = Epi::PERM ? ((R & ~31) + perm32(R & 31)) : R;
        voffA[i] = (unsigned)(R * g.lda + C) * 2u; voffB[i] = (unsigned)(Rb * K + C) * 2u; }
    const size_t kstep = (size_t)(BK * 2);
    const size_t hstepA = (size_t)HALF * g.lda * 2, hstepB = (size_t)HALF * K * 2;
    const unsigned ldsw = (unsigned)wid * 1024u;
    const int aoff = lds_byte(wr * 64 + fr, fq * 8), boff = lds_byte(wc * 32 + fr, fq * 8);
#define PG8_SA(b, h) (((b) * 2 + (h)) * HTB)
#define PG8_SB(b, h) ((4 + (b) * 2 + (h)) * HTB)
#define PG8_STAGE_B(bufoff, gbase) do { _Pragma("unroll") for (int _i = 0; _i < 2; ++_i) \
        __builtin_amdgcn_global_load_lds((const unsigned*)((const char*)(gbase) + voffB[_i]), (LAS unsigned*)(lds + (bufoff) + ldsw + _i * 8192), 16, 0, 0); } while (0)
#define PG8_STAGE_A(bufoff, gbase, second) do { _Pragma("unroll") for (int _i = 0; _i < 2; ++_i) \
        __builtin_amdgcn_global_load_lds((const unsigned*)((const char*)(gbase) + voffA[_i]), (LAS unsigned*)(lds + (bufoff) + ldsw + _i * 8192), 16, 0, 0); } while (0)
#define PG8_LDA(dst, b, h) do { _Pragma("unroll") for (int m = 0; m < 4; ++m) _Pragma("unroll") for (int k = 0; k < 2; ++k) dst[m][k] = *(const LAS bf16x8*)(lds + PG8_SA(b, h) + aoff + m * 2048 + k * 1024); } while (0)
#define PG8_LDB(dst, b, h) do { _Pragma("unroll") for (int n = 0; n < 2; ++n) _Pragma("unroll") for (int k = 0; k < 2; ++k) dst[n][k] = *(const LAS bf16x8*)(lds + PG8_SB(b, h) + boff + n * 2048 + k * 1024); } while (0)
#define PG8_MMA(ai, bj, At, Bt) do { __builtin_amdgcn_s_setprio(1); _Pragma("unroll") for (int m = 0; m < 4; ++m) _Pragma("unroll") for (int n = 0; n < 2; ++n) _Pragma("unroll") for (int k = 0; k < 2; ++k) \
        acc[ai][bj][m][n] = __builtin_amdgcn_mfma_f32_16x16x32_bf16(Bt[n][k], At[m][k], acc[ai][bj][m][n], 0, 0, 0); __builtin_amdgcn_s_setprio(0); } while (0)
#define PG8_WAIT_V(n) asm volatile("s_waitcnt vmcnt(" #n ")" ::: "memory")
#define PG8_WAIT_L(n) asm volatile("s_waitcnt lgkmcnt(" #n ")" ::: "memory")
#define PG8_BAR __builtin_amdgcn_s_barrier()
#define PG8_SCHED __builtin_amdgcn_sched_barrier(0)
    Unit cur, nxt; int ui = 0;
    if (!S.next(0, cur)) return;
    Acc acc;
#pragma unroll
    for (int a = 0; a < 2; ++a)
#pragma unroll
        for (int b = 0; b < 2; ++b)
#pragma unroll
            for (int m = 0; m < 4; ++m)
#pragma unroll
                for (int n = 0; n < 2; ++n) acc[a][b][m][n] = (f32x4){0.f, 0.f, 0.f, 0.f};
    bf16x8 At[4][2], B0[2][2], B1[2][2];
    const char* cA = (const char*)g.A + (size_t)cur.pm * 2 * hstepA; const char* cB = (const char*)g.Bt + (size_t)cur.pn * 2 * hstepB;
    PG8_STAGE_B(PG8_SB(0, 0), cB); PG8_STAGE_B(PG8_SB(0, 1), cB + hstepB); PG8_STAGE_A(PG8_SA(0, 0), cA, false); PG8_STAGE_A(PG8_SA(0, 1), cA + hstepA, false);
    if (wr == 1) PG8_BAR;
    PG8_WAIT_V(2); PG8_BAR;
    PG8_STAGE_B(PG8_SB(1, 0), cB + kstep); PG8_STAGE_A(PG8_SA(1, 0), cA + kstep, false); PG8_STAGE_B(PG8_SB(1, 1), cB + hstepB + kstep);
    PG8_WAIT_V(6); PG8_BAR;
    for (;;) {
        const bool has_next = S.next(ui + 1, nxt);
        const char* nA = has_next ? (const char*)g.A + (size_t)nxt.pm * 2 * hstepA : cA; const char* nB = has_next ? (const char*)g.Bt + (size_t)nxt.pn * 2 * hstepB : cB;
        for (int t = 0; t < nt; t += 2) {
            const bool last = (t == nt - 2);
            const char* a1 = cA + (size_t)(t + 1) * kstep;
            const char* a2 = last ? nA : cA + (size_t)(t + 2) * kstep; const char* a3 = a2 + kstep;
            const size_t h1 = hstepA, h2 = hstepA;
            const char* b2 = last ? nB : cB + (size_t)(t + 2) * kstep; const char* b3 = b2 + kstep;
            PG8_LDB(B0, 0, 0); PG8_LDB(B1, 0, 1); PG8_SCHED; PG8_LDA(At, 0, 0); PG8_STAGE_A(PG8_SA(1, 1), a1 + h1, false);
            PG8_WAIT_V(8); PG8_WAIT_L(0); PG8_BAR; PG8_MMA(0, 0, At, B0); PG8_MMA(0, 1, At, B1); PG8_BAR; PG8_SCHED;
            PG8_LDA(At, 0, 1); PG8_STAGE_B(PG8_SB(0, 0), b2); PG8_STAGE_B(PG8_SB(0, 1), b2 + hstepB); PG8_STAGE_A(PG8_SA(0, 0), a2, false);
            PG8_WAIT_V(8); PG8_WAIT_L(0); PG8_BAR; PG8_MMA(1, 0, At, B0); PG8_MMA(1, 1, At, B1); PG8_BAR; PG8_SCHED;
            PG8_LDB(B0, 1, 0); PG8_LDB(B1, 1, 1); PG8_SCHED; PG8_LDA(At, 1, 0); PG8_STAGE_A(PG8_SA(0, 1), a2 + h2, false);
            PG8_WAIT_V(8); PG8_WAIT_L(0); PG8_BAR; PG8_MMA(0, 0, At, B0); PG8_MMA(0, 1, At, B1); PG8_BAR; PG8_SCHED;
            PG8_LDA(At, 1, 1); PG8_STAGE_B(PG8_SB(1, 0), b3); PG8_STAGE_B(PG8_SB(1, 1), b3 + hstepB); PG8_STAGE_A(PG8_SA(1, 0), a3, false);
            PG8_WAIT_V(8); PG8_WAIT_L(0); PG8_BAR; PG8_MMA(1, 0, At, B0); PG8_MMA(1, 1, At, B1); PG8_BAR; PG8_SCHED;
        }
        if (wr == 0) PG8_BAR;
        E(acc, cur, wr, wc, fr, fq);
        if (!has_next) break;
#pragma unroll
        for (int a = 0; a < 2; ++a)
#pragma unroll
            for (int b = 0; b < 2; ++b)
#pragma unroll
                for (int m = 0; m < 4; ++m)
#pragma unroll
                    for (int n = 0; n < 2; ++n) acc[a][b][m][n] = (f32x4){0.f, 0.f, 0.f, 0.f};
        cur = nxt; cA = nA; cB = nB; ++ui;
        if (wr == 1) PG8_BAR;
    }
    PG8_WAIT_V(0);
    PG8_BAR;
#undef PG8_SA
#undef PG8_SB
#undef PG8_STAGE_A
#undef PG8_STAGE_B
#undef PG8_LDA
#undef PG8_LDB
#undef PG8_MMA
#undef PG8_WAIT_V
#undef PG8_WAIT_L
#undef PG8_BAR
#undef PG8_SCHED
}
}

__device__ __forceinline__ void tr_item(const float* __restrict__ W, int N, int k0, int n0, bf16_t* dst, int ldd, LAS float* scr, int lane) {
#pragma unroll 8
    for (int i = 0; i < 32; ++i) { const int kk = 2 * i + (lane >> 5); scr[kk * 33 + (lane & 31)] = W[(size_t)(k0 + kk) * N + n0 + (lane & 31)]; }
    LDS_WAIT();
    const int c = lane & 7;
#pragma unroll
    for (int j = 0; j < 4; ++j) { const int n = (lane >> 3) + 8 * j; const LAS float* s = scr + (8 * c) * 33 + n;
        u32x4 o; o.x = cvt_pk_bf16(s[0 * 33], s[1 * 33]); o.y = cvt_pk_bf16(s[2 * 33], s[3 * 33]); o.z = cvt_pk_bf16(s[4 * 33], s[5 * 33]); o.w = cvt_pk_bf16(s[6 * 33], s[7 * 33]);
        *(u32x4*)(dst + (size_t)n * ldd + 8 * c) = o; }
    LDS_WAIT();
}
__device__ __forceinline__ void convert_ffn(const float* w1, const float* w3, const float* w2, bf16_t* W13, bf16_t* W2, LAS float* scr, int gw, int NGW, int lane) {
    constexpr int I_UP = 32 * 176, I_DN = 88 * 64;
    for (int it = gw; it < 2 * I_UP + I_DN; it += NGW) {
        int r = it;
        if (r < 2 * I_UP) { const int which = r >= I_UP; if (which) r -= I_UP; const int kb = r / 176, nb = r % 176, n0 = nb * 32;
            tr_item(which ? w3 : w1, FF_, kb * 64, n0, W13 + (size_t)((n0 >> 7) * 256 + which * 128 + (n0 & 127)) * 2048 + kb * 64, 2048, scr, lane); }
        else { r -= 2 * I_UP; const int kb = r / 64, nb = r % 64; tr_item(w2, D_, kb * 64, nb * 32, W2 + (size_t)(nb * 32) * FF_ + kb * 64, FF_, scr, lane); }
    }
}
__device__ __forceinline__ void convert_mixer(const Params& p, LAS float* scr, int gw, int NGW, int lane) {
    bf16_t* WIN1 = (bf16_t*)(p.ws + WS_WIN1); bf16_t* WIN2 = (bf16_t*)(p.ws + WS_WIN2); bf16_t* WPAB = (bf16_t*)(p.ws + WS_WPAB); bf16_t* WOUT = (bf16_t*)(p.ws + WS_WOUT);
    constexpr int I_IN = 32 * 577, I_P = 32 * 64;
    for (int it = gw; it < I_IN + 3 * I_P; it += NGW) {
        int r = it;
        if (r < I_IN) { const int kb = r / 577, nb = r % 577, n0 = nb * 32; bf16_t* dst; int drow;
            if (n0 < 6144) { dst = WIN1; drow = n0; }
            else if (n0 < 8192) { dst = WIN2; drow = n0 - 6144; }
            else if (n0 < 8224) { dst = WIN1; drow = 12288 + (n0 - 8192); }
            else if (n0 < 10272) { dst = WIN1; drow = 6144 + (n0 - 8224); }
            else if (n0 < 12320) { dst = WIN1; drow = 8192 + (n0 - 10272); }
            else if (n0 < 14368) { dst = WIN1; drow = 10240 + (n0 - 12320); }
            else if (n0 < 16416) { dst = WIN2; drow = 2048 + (n0 - 14368); }
            else { dst = WIN2; drow = 4096 + (n0 - 16416); }
            tr_item(p.w_in, 18464, kb * 64, n0, dst + (size_t)drow * 2048 + kb * 64, 2048, scr, lane); continue; }
        r -= I_IN;
        const int which = r / I_P; r -= which * I_P; const int kb = r / 64, nb = r % 64;
        if (which == 0) tr_item(p.wpa, D_, kb * 64, nb * 32, WPAB + (size_t)(nb * 32) * 2048 + kb * 64, 2048, scr, lane);
        else if (which == 1) tr_item(p.wpb, D_, kb * 64, nb * 32, WPAB + (size_t)2048 * 2048 + (size_t)(nb * 32) * 2048 + kb * 64, 2048, scr, lane);
        else tr_item(p.wout, D_, kb * 64, nb * 32, WOUT + (size_t)(nb * 32) * 2048 + kb * 64, 2048, scr, lane);
    }
}

__device__ __forceinline__ void phase0(const Params& p, LAS unsigned char* lds) {
    const int tid = tid_opaque(), lane = tid & 63, wave = tid >> 6;
    const int gw = blockIdx.x * 8 + wave, NGW = gridDim.x * 8;
    const int gt = blockIdx.x * 512 + tid, NGT = gridDim.x * 512;
    {
        LAS float* sil = (LAS float*)lds;
        float* ADAP = (float*)(p.ws + WS_ADAP);
        for (int item = blockIdx.x; item < 9 * 32; item += gridDim.x) {
            const int cb = item % 9, ks = item / 9;
            if (tid < 256) { const int b = tid >> 6, kk = tid & 63; sil[tid] = siluf_(p.c[b * D_ + ks * 64 + kk]); }
            __syncthreads();
            const int col = cb * 2048 + tid * 4;
            f32x4 a0 = {0, 0, 0, 0}, a1 = a0, a2 = a0, a3 = a0;
#pragma unroll 4
            for (int kk = 0; kk < 64; ++kk) { const f32x4 w = *(const f32x4*)(p.ada_w + (size_t)(ks * 64 + kk) * NADA + col);
                a0 += sil[kk] * w; a1 += sil[64 + kk] * w; a2 += sil[128 + kk] * w; a3 += sil[192 + kk] * w; }
            *(f32x4*)(ADAP + (size_t)(ks * 4 + 0) * NADA + col) = a0; *(f32x4*)(ADAP + (size_t)(ks * 4 + 1) * NADA + col) = a1;
            *(f32x4*)(ADAP + (size_t)(ks * 4 + 2) * NADA + col) = a2; *(f32x4*)(ADAP + (size_t)(ks * 4 + 3) * NADA + col) = a3;
            __syncthreads();
        }
    }
    LAS float* scr = (LAS float*)(lds + wave * 8448);
    convert_ffn(p.f1w1, p.f1w3, p.f1w2, (bf16_t*)(p.ws + WS_W13), (bf16_t*)(p.ws + WS_W2), scr, gw, NGW, lane);
    convert_mixer(p, scr, gw, NGW, lane);
    { u32x4* z = (u32x4*)(p.ws + WS_WIN1 + (size_t)12320 * 2048 * 2); for (int i = gt; i < 224 * 2048 * 2 / 16; i += NGT) z[i] = (u32x4){0u, 0u, 0u, 0u}; }
    { float* BT = (float*)(p.ws + WS_BT);
      for (int i = gt; i < 16 * 4096; i += NGT) { const int h = i >> 12, d = i & 4095; int bucket;
          if (d < 16) bucket = d; else { const double dd = (double)d, d2 = dd * dd, d4 = d2 * d2, d8 = d4 * d4; int k = 0; double thr = 34359738368.0  ;
              for (int q = 1; q <= 15; ++q) { if (d8 >= thr) k = q; thr *= 8.0; } bucket = 16 + k; if (bucket > 31) bucket = 31; }
          BT[i] = p.rel_bias[bucket * 16 + h] * LOG2E; } }
}
__device__ __forceinline__ void phase_ada_reduce(const Params& p) {
    const int gt = blockIdx.x * 512 + tid_opaque(), NGT = gridDim.x * 512;
    const float* ADAP = (const float*)(p.ws + WS_ADAP); float* ada = (float*)(p.ws + WS_ADA);
    for (int i = gt; i < 4 * NADA; i += NGT) { const int b = i / NADA, n = i - b * NADA; float s = p.ada_b[n];
        for (int ks = 0; ks < 32; ++ks) s += ADAP[(size_t)(ks * 4 + b) * NADA + n];
        ada[i] = s; }
}
__device__ __forceinline__ void phase_normmod(const float* src, const float* gain, const float* ada, int shoff, int scoff, bf16_t* dst) {
    const int tid_ = tid_opaque(); const int lane = tid_ & 63, wave = tid_ >> 6;
    const int gw = blockIdx.x * 8 + wave, NGW = gridDim.x * 8;
    for (int m = gw; m < M_; m += NGW) {
        const f32x4* xr = (const f32x4*)(src + (size_t)m * D_) + lane;
        f32x4 v[8]; float ss = 0.f;
#pragma unroll
        for (int j = 0; j < 8; ++j) { v[j] = xr[64 * j]; ss += (v[j][0] * v[j][0] + v[j][1] * v[j][1]) + (v[j][2] * v[j][2] + v[j][3] * v[j][3]); }
        ss = wave_sum(ss);
        const float rstd = rsqrtf(ss * (1.0f / D_) + 1e-6f);
        const float* ab = ada + (size_t)(m >> 12) * NADA;
#pragma unroll
        for (int j = 0; j < 8; ++j) { const int col = 4 * (lane + 64 * j);
            const f32x4 g = *(const f32x4*)(gain + col), sh = *(const f32x4*)(ab + shoff + col), sc = *(const f32x4*)(ab + scoff + col);
            const f32x4 y = v[j] * rstd * g * (sc + 1.0f) + sh;
            u32x2 w; w.x = cvt_pk_bf16(y[0], y[1]); w.y = cvt_pk_bf16(y[2], y[3]);
            *(u32x2*)(dst + (size_t)m * D_ + col) = w; }
    }
}
__device__ __forceinline__ void phase_halo(const Params& p) {
    const int tid_ = tid_opaque(); const int lane = tid_ & 63, wave = tid_ >> 6;
    const int gw = blockIdx.x * 8 + wave, NGW = gridDim.x * 8;
    const bf16_t* QKV = (const bf16_t*)(p.ws + WS_QKV); bf16_t* HALO = (bf16_t*)(p.ws + WS_HALO);
    for (int r = gw; r < 4 * 16 * 3; r += NGW) {
        const int j = r % 3, tile = (r / 3) & 15, b = r / 48;
        u32x4* d = (u32x4*)(HALO + (size_t)r * 6144);
        if (tile == 0) { for (int i = lane; i < 768; i += 64) d[i] = (u32x4){0u, 0u, 0u, 0u}; }
        else { const u32x4* s = (const u32x4*)(QKV + ((size_t)b * T_ + tile * 256 - 3 + j) * 6144); for (int i = lane; i < 768; i += 64) d[i] = s[i]; }
    }
}
__device__ __forceinline__ void unpack8(const u32x4 w, float* f) {
#pragma unroll
    for (int e = 0; e < 4; ++e) { f[2 * e] = bflo(w[e]); f[2 * e + 1] = bfhi(w[e]); }
}
__device__ __forceinline__ void phase_postproc(const Params& p, LAS unsigned char* lds) {
    const int tid = tid_opaque(), ti = tid >> 3, cg8 = tid & 7, lane = tid & 63, wave = tid >> 6;
    bf16_t* QKV = (bf16_t*)(p.ws + WS_QKV); const bf16_t* HALO = (const bf16_t*)(p.ws + WS_HALO); bf16_t* MB = (bf16_t*)(p.ws + WS_MB); float* BA = (float*)(p.ws + WS_BA);
    float* KM = (float*)(p.ws + WS_KMEAN);
    for (int item = blockIdx.x; item < 4 * 16 * 48; item += gridDim.x) {
        const int s = item % 48, tile = (item / 48) & 15, b = item / 768;
        const int c0 = s * 128 + cg8 * 16; const size_t row0 = (size_t)b * T_ + tile * 256 + ti * 4;
        u32x4 xr[7][2];
#pragma unroll
        for (int j = 0; j < 7; ++j) {
            const bf16_t* src = (ti > 0 || j >= 3) ? QKV + (row0 - 3 + j) * 6144 + c0 : HALO + ((size_t)((b * 16 + tile) * 3) + j) * 6144 + c0;
            xr[j][0] = *(const u32x4*)src; xr[j][1] = *(const u32x4*)(src + 8);
        }
        f32x4 w[4][4];
#pragma unroll
        for (int j = 0; j < 4; ++j)
#pragma unroll
            for (int q = 0; q < 4; ++q) w[j][q] = *(const f32x4*)(p.conv_w + j * 6144 + c0 + 4 * q);
        u32x4 o[4][2];
#pragma unroll
        for (int r = 0; r < 4; ++r) {
            float y[16];
#pragma unroll
            for (int i = 0; i < 16; ++i) y[i] = 0.f;
#pragma unroll
            for (int j = 0; j < 4; ++j) { float xf[16]; unpack8(xr[r + j][0], xf); unpack8(xr[r + j][1], xf + 8);
#pragma unroll
                for (int q = 0; q < 4; ++q)
#pragma unroll
                    for (int e = 0; e < 4; ++e) y[4 * q + e] += w[j][q][e] * xf[4 * q + e]; }
            float ss = 0.f;
#pragma unroll
            for (int i = 0; i < 16; ++i) { y[i] = siluf_(y[i]); ss += y[i] * y[i]; }
            ss += __shfl_xor(ss, 1); ss += __shfl_xor(ss, 2); ss += __shfl_xor(ss, 4);
            float sc = 1.0f;
            if (s < 32) { sc = rsqrtf(ss + 1e-6f); if (s < 16) sc *= QSCALE; }
#pragma unroll
            for (int e = 0; e < 4; ++e) { o[r][0][e] = cvt_pk_bf16(y[2 * e] * sc, y[2 * e + 1] * sc); o[r][1][e] = cvt_pk_bf16(y[8 + 2 * e] * sc, y[8 + 2 * e + 1] * sc); }
        }
        __syncthreads();
#pragma unroll
        for (int r = 0; r < 4; ++r) { bf16_t* dp = QKV + (row0 + r) * 6144 + c0; *(u32x4*)dp = o[r][0]; *(u32x4*)(dp + 8) = o[r][1]; }
    }
    LAS float* red = (LAS float*)lds;
    for (int item = blockIdx.x; item < 4 * 16 * 32; item += gridDim.x) {
        const int hh = item & 31, tile = (item >> 5) & 15, b = item >> 9; const int which = hh >> 4, h = hh & 15;
        bf16_t* dp = MB + (size_t)which * M_ * D_ + ((size_t)b * T_ + tile * 256 + ti * 4) * D_ + h * 128 + cg8 * 16;
        u32x4 xr[4][2];
#pragma unroll
        for (int r = 0; r < 4; ++r) { xr[r][0] = *(const u32x4*)(dp + (size_t)r * D_); xr[r][1] = *(const u32x4*)(dp + (size_t)r * D_ + 8); }
        const float* gp = (which == 0 ? p.qn_g : p.kn_g) + cg8 * 16;
        float gn[16];
#pragma unroll
        for (int i = 0; i < 16; ++i) gn[i] = gp[i] * (which == 0 ? QSCALE * LOG2E : 1.0f);
        float ks[16];
#pragma unroll
        for (int i = 0; i < 16; ++i) ks[i] = 0.f;
#pragma unroll
        for (int r = 0; r < 4; ++r) {
            float xf[16]; unpack8(xr[r][0], xf); unpack8(xr[r][1], xf + 8);
            float ss = 0.f;
#pragma unroll
            for (int i = 0; i < 16; ++i) ss += xf[i] * xf[i];
            ss += __shfl_xor(ss, 1); ss += __shfl_xor(ss, 2); ss += __shfl_xor(ss, 4);
            const float rs = rsqrtf(ss * (1.0f / 128.0f) + 1e-6f);
            u32x4 o0, o1;
#pragma unroll
            for (int i = 0; i < 16; ++i) { xf[i] = xf[i] * rs * gn[i]; ks[i] += xf[i]; }
#pragma unroll
            for (int e = 0; e < 4; ++e) { o0[e] = cvt_pk_bf16(xf[2 * e], xf[2 * e + 1]); o1[e] = cvt_pk_bf16(xf[8 + 2 * e], xf[8 + 2 * e + 1]); }
            *(u32x4*)(dp + (size_t)r * D_) = o0; *(u32x4*)(dp + (size_t)r * D_ + 8) = o1;
        }
        if (which == 1) {
#pragma unroll
            for (int i = 0; i < 16; ++i) { float v = ks[i]; v += __shfl_xor(v, 8); v += __shfl_xor(v, 16); v += __shfl_xor(v, 32); ks[i] = v; }
            if (lane < 8) {
#pragma unroll
                for (int i = 0; i < 16; ++i) red[wave * 128 + lane * 16 + i] = ks[i]; }
            __syncthreads();
            if (tid < 128) { float t = 0.f;
#pragma unroll
                for (int w8 = 0; w8 < 8; ++w8) t += red[w8 * 128 + tid];
                KM[((size_t)((b * 16 + h) * 16 + tile)) * 128 + tid] = t * (1.0f / 256.0f); }
            __syncthreads();
        }
    }
    {
        const int gt = blockIdx.x * 512 + tid, NGT = gridDim.x * 512;
        for (int i = gt; i < M_ * 16; i += NGT) { const int h = i & 15; const size_t r = (size_t)(i >> 4) * 32;
            const float bv = BA[r + h], av = BA[r + 16 + h] + p.dt_bias[h];
            const float sp = fmaxf(av, 0.f) + log1pf(expf(-fabsf(av)));
            BA[r + h] = 1.0f / (1.0f + expf(-bv)); BA[r + 16 + h] = -expf(p.a_log[h]) * sp; }
    }
}

typedef float f32x16 __attribute__((ext_vector_type(16)));
__device__ __forceinline__ unsigned pkbf(float a, float b) { return cvt_pk_bf16(a, b); }
#define MFMA32(a, b, c) __builtin_amdgcn_mfma_f32_32x32x16_bf16((a), (b), (c), 0, 0, 0)
template <int OFF, int ROWQ, int COLT> __device__ __forceinline__ void tr8(unsigned addr, u32x2 (&v)[8]) {
    asm volatile(
        "ds_read_b64_tr_b16 %0, %8 offset:%9\n\t"
        "ds_read_b64_tr_b16 %1, %8 offset:%10\n\t"
        "ds_read_b64_tr_b16 %2, %8 offset:%11\n\t"
        "ds_read_b64_tr_b16 %3, %8 offset:%12\n\t"
        "ds_read_b64_tr_b16 %4, %8 offset:%13\n\t"
        "ds_read_b64_tr_b16 %5, %8 offset:%14\n\t"
        "ds_read_b64_tr_b16 %6, %8 offset:%15\n\t"
        "ds_read_b64_tr_b16 %7, %8 offset:%16\n\t"
        "s_waitcnt lgkmcnt(0)"
        : "=&v"(v[0]), "=&v"(v[1]), "=&v"(v[2]), "=&v"(v[3]), "=&v"(v[4]), "=&v"(v[5]), "=&v"(v[6]), "=&v"(v[7])
        : "v"(addr), "n"(OFF), "n"(OFF + ROWQ), "n"(OFF + COLT), "n"(OFF + COLT + ROWQ), "n"(OFF + 2 * COLT), "n"(OFF + 2 * COLT + ROWQ), "n"(OFF + 3 * COLT), "n"(OFF + 3 * COLT + ROWQ)
        : "memory");
}
__device__ __forceinline__ bf16x8 frag2(const u32x2 a, const u32x2 b) { u32x4 w = {a.x, a.y, b.x, b.y}; return __builtin_bit_cast(bf16x8, w); }
__device__ __forceinline__ bf16x8 pack8(const f32x16& x, int s) {
    u32x4 w = {pkbf(x[8 * s], x[8 * s + 1]), pkbf(x[8 * s + 2], x[8 * s + 3]), pkbf(x[8 * s + 4], x[8 * s + 5]), pkbf(x[8 * s + 6], x[8 * s + 7])};
    return __builtin_bit_cast(bf16x8, w);
}

__device__ __forceinline__ void phase_moba_mfma(const Params& p, LAS unsigned char* lds, unsigned lds_base) {
    constexpr int KST = 272, VST = 320;
    constexpr int OFF_K = 0, OFF_V = 2 * 64 * KST, OFF_KM = OFF_V + 2 * 64 * VST, OFF_BT = OFF_KM + 32 * KST, OFF_UM = OFF_BT + 4096;
    const int tid = tid_opaque(), lane = tid & 63, wave = __builtin_amdgcn_readfirstlane(tid >> 6);
    const int i32 = lane & 31, hh = lane >> 5;
    bf16_t* MBQ = (bf16_t*)(p.ws + WS_MB); const bf16_t* MBK = MBQ + (size_t)M_ * D_; const bf16_t* MBV = MBK + (size_t)M_ * D_;
    const float* KM = (const float*)(p.ws + WS_KMEAN); const float* BT = (const float*)(p.ws + WS_BT);
    const int G = gridDim.x, cblk = blockIdx.x;
    const int lrow = tid >> 3, lc = tid & 7;
    const unsigned vbase = lds_base + OFF_V + (4 * hh + ((lane & 15) >> 2)) * VST + (16 * ((lane >> 4) & 1) + 4 * (lane & 3)) * 2;
    const float NINF = -__builtin_inff();
    for (int k = 0;; ++k) {
        const int it = k * G + ((k & 1) ? (G - 1 - cblk) : cblk);
        if (it >= 1024) break;
        const int qb = 15 - (it >> 6), bh = it & 63, b = bh >> 4, h = bh & 15;
        const size_t rowb = (size_t)b * T_;
        __syncthreads();
        { const int r = tid >> 5, c4 = (tid & 31) * 4; const f32x4 kv = *(const f32x4*)(KM + ((size_t)(bh * 16 + r)) * 128 + c4);
          u32x2 w = {pkbf(kv[0], kv[1]), pkbf(kv[2], kv[3])}; *(LAS u32x2*)(lds + OFF_KM + r * KST + c4 * 2) = w; *(LAS u32x2*)(lds + OFF_KM + (r + 16) * KST + c4 * 2) = (u32x2){0u, 0u}; }
        { LAS float* bts = (LAS float*)(lds + OFF_BT); bts[tid] = BT[h * 4096 + tid]; bts[tid + 512] = BT[h * 4096 + tid + 512]; }
        const float c31 = BT[h * 4096 + 1023];
        const int q0 = qb * 256 + 32 * wave;
        bf16_t* qptr = MBQ + (rowb + q0 + i32) * D_ + h * 128;
        bf16x8 qf[8];
#pragma unroll
        for (int kc = 0; kc < 8; ++kc) qf[kc] = *(const bf16x8*)(qptr + 16 * kc + 8 * hh);
        __syncthreads();
        unsigned sel = 0;
        {
            f32x16 g;
#pragma unroll
            for (int r = 0; r < 16; ++r) g[r] = 0.f;
#pragma unroll
            for (int kc = 0; kc < 8; ++kc) { const bf16x8 a = *(const LAS bf16x8*)(lds + OFF_KM + i32 * KST + (16 * kc + 8 * hh) * 2); g = MFMA32(a, qf[kc], g); }
            float gate[16];
#pragma unroll
            for (int j = 0; j < 16; ++j) { const int half = (j >> 2) & 1, r = (j & 3) + 4 * (j >> 3); const float og = __shfl_xor(g[r], 32); gate[j] = (hh == half) ? g[r] : og; }
#pragma unroll
            for (int rep = 0; rep < 3; ++rep) { float best = NINF; int bi = -1;
#pragma unroll
                for (int j = 0; j < 16; ++j) if (j < qb && !((sel >> j) & 1u) && gate[j] > best) { best = gate[j]; bi = j; }
                if (bi >= 0) sel |= 1u << bi; }
        }
        { unsigned wsel = sel;
#pragma unroll
          for (int o = 1; o < 64; o <<= 1) wsel |= (unsigned)__shfl_xor((int)wsel, o);
          if (lane == 0) ((LAS unsigned*)(lds + OFF_UM))[wave] = wsel; }
        __syncthreads();
        unsigned um = 0;
#pragma unroll
        for (int w = 0; w < 8; ++w) um |= ((const LAS unsigned*)(lds + OFF_UM))[w];
        um = __builtin_amdgcn_readfirstlane(um);

        f32x16 O[4];
#pragma unroll
        for (int dt = 0; dt < 4; ++dt)
#pragma unroll
            for (int r = 0; r < 16; ++r) O[dt][r] = 0.f;
        float m = NINF, l = 0.f;
        int j = qb, kt = 0, buf = 0;
        u32x4 rk0, rk1, rv0, rv1;
#define MOBA_LOAD(jj, kk) do { const size_t r_ = (rowb + (jj) * 256 + (kk) * 64 + lrow) * D_ + h * 128 + lc * 16; rk0 = *(const u32x4*)(MBK + r_); rk1 = *(const u32x4*)(MBK + r_ + 8); rv0 = *(const u32x4*)(MBV + r_); rv1 = *(const u32x4*)(MBV + r_ + 8); } while (0)
#define MOBA_STORE(bb) do { LAS unsigned char* kd = lds + OFF_K + (bb) * 64 * KST + lrow * KST + lc * 32; *(LAS u32x4*)kd = rk0; *(LAS u32x4*)(kd + 16) = rk1; \
        LAS unsigned char* vd = lds + OFF_V + (bb) * 64 * VST + lrow * VST + lc * 32; *(LAS u32x4*)vd = rv0; *(LAS u32x4*)(vd + 16) = rv1; } while (0)
        MOBA_LOAD(j, kt); MOBA_STORE(0); __syncthreads();
        while (j >= 0) {
            int nj = j, nkt = kt + 1;
            if (nkt == 4) { nkt = 0; do { --nj; } while (nj >= 0 && !((um >> nj) & 1u)); }
            if (nj >= 0) MOBA_LOAD(nj, nkt);
            const bool own = (j == qb);
            bool need;
            if (own) need = (kt * 64 <= 32 * wave + 31); else need = (__ballot((sel >> j) & 1u) != 0ull);
            if (need) {
                const LAS unsigned char* Ks = lds + OFF_K + buf * 64 * KST + i32 * KST + 16 * hh;
                f32x16 s0, s1;
#pragma unroll
                for (int r = 0; r < 16; ++r) { s0[r] = 0.f; s1[r] = 0.f; }
#pragma unroll
                for (int kc = 0; kc < 8; ++kc) { const bf16x8 a0 = *(const LAS bf16x8*)(Ks + 32 * kc), a1 = *(const LAS bf16x8*)(Ks + 32 * KST + 32 * kc);
                    s0 = MFMA32(a0, qf[kc], s0); s1 = MFMA32(a1, qf[kc], s1); }
                const int tq = q0 + i32, kbase = j * 256 + kt * 64;
                const bool far = (q0 - (kbase + 63)) >= 790;
                const bool diag = own && (kbase + 63 > q0);
                const bool lsel = own || ((sel >> j) & 1u);
                const int db = tq - kbase - 4 * hh;
                if (far) {
#pragma unroll
                    for (int r = 0; r < 16; ++r) { s0[r] += c31; s1[r] += c31; }
                } else {
                    const LAS float* bp = (const LAS float*)(lds + OFF_BT) + db;
                    float b0[16], b1[16];
#pragma unroll
                    for (int r = 0; r < 16; ++r) { b0[r] = bp[-(8 * (r >> 2) + (r & 3))]; b1[r] = bp[-(32 + 8 * (r >> 2) + (r & 3))]; }
#pragma unroll
                    for (int r = 0; r < 16; ++r) { s0[r] += b0[r]; s1[r] += b1[r]; }
                }
                if (diag) {
#pragma unroll
                    for (int r = 0; r < 16; ++r) { const int d0 = db - (8 * (r >> 2) + (r & 3)); if (d0 < 0) s0[r] = NINF; if (d0 < 32) s1[r] = NINF; }
                }
                float mx = NINF;
#pragma unroll
                for (int r = 0; r < 16; ++r) { if (!lsel) { s0[r] = NINF; s1[r] = NINF; } mx = fmaxf(mx, fmaxf(s0[r], s1[r])); }
                mx = fmaxf(mx, __shfl_xor(mx, 32));
                const float mnew = fmaxf(m, mx);
                const float alpha = __builtin_amdgcn_exp2f(m - mnew);
                float ps = 0.f;
#pragma unroll
                for (int r = 0; r < 16; ++r) { s0[r] = __builtin_amdgcn_exp2f(s0[r] - mnew); s1[r] = __builtin_amdgcn_exp2f(s1[r] - mnew); ps += s0[r] + s1[r]; }
                l = l * alpha + ps; m = mnew;
                if (__ballot(alpha != 1.0f) != 0ull) {
#pragma unroll
                    for (int dt = 0; dt < 4; ++dt)
#pragma unroll
                        for (int r = 0; r < 16; ++r) O[dt][r] *= alpha;
                }
                const unsigned va = vbase + buf * 64 * VST;
                u32x2 v[8];
                { const bf16x8 pf = pack8(s0, 0); tr8<0, 8 * VST, 64>(va, v);
#pragma unroll
                  for (int dt = 0; dt < 4; ++dt) O[dt] = MFMA32(frag2(v[2 * dt], v[2 * dt + 1]), pf, O[dt]); }
                { const bf16x8 pf = pack8(s0, 1); tr8<16 * VST, 8 * VST, 64>(va, v);
#pragma unroll
                  for (int dt = 0; dt < 4; ++dt) O[dt] = MFMA32(frag2(v[2 * dt], v[2 * dt + 1]), pf, O[dt]); }
                { const bf16x8 pf = pack8(s1, 0); tr8<32 * VST, 8 * VST, 64>(va, v);
#pragma unroll
                  for (int dt = 0; dt < 4; ++dt) O[dt] = MFMA32(frag2(v[2 * dt], v[2 * dt + 1]), pf, O[dt]); }
                { const bf16x8 pf = pack8(s1, 1); tr8<48 * VST, 8 * VST, 64>(va, v);
#pragma unroll
                  for (int dt = 0; dt < 4; ++dt) O[dt] = MFMA32(frag2(v[2 * dt], v[2 * dt + 1]), pf, O[dt]); }
            }
            if (nj >= 0) MOBA_STORE(buf ^ 1);
            __syncthreads();
            j = nj; kt = nkt; buf ^= 1;
        }
#undef MOBA_LOAD
#undef MOBA_STORE
        l += __shfl_xor(l, 32);
        const float inv = 1.0f / l;
#pragma unroll
        for (int dt = 0; dt < 4; ++dt)
#pragma unroll
            for (int r4 = 0; r4 < 4; ++r4) {
                u32x2 w = {pkbf(O[dt][4 * r4] * inv, O[dt][4 * r4 + 1] * inv), pkbf(O[dt][4 * r4 + 2] * inv, O[dt][4 * r4 + 3] * inv)};
                *(u32x2*)(qptr + 32 * dt + 4 * hh + 8 * r4) = w;
            }
    }
}


#define MFMA16(a, b, c) __builtin_amdgcn_mfma_f32_16x16x32_bf16((a), (b), (c), 0, 0, 0)
__device__ __forceinline__ void phase_dn_local(const Params& p, LAS unsigned char* lds) {
    const int tid = tid_opaque(), lane = tid & 63, wave = __builtin_amdgcn_readfirstlane(tid >> 6), i32 = lane & 31, hh = lane >> 5;
    LAS unsigned char* wl = lds + wave * 18432;
    LAS float* Am = (LAS float*)wl; LAS bf16_t* Tb = (LAS bf16_t*)wl; LAS bf16_t* Tb2 = (LAS bf16_t*)(wl + 8192);
    LAS float* gcs = (LAS float*)(wl + 16384); LAS float* bes = gcs + 64;
    bf16_t* QKV = (bf16_t*)(p.ws + WS_QKV); float* BA = (float*)(p.ws + WS_BA); bf16_t* WDN = (bf16_t*)(p.ws + WS_WDN); bf16_t* QKb = (bf16_t*)(p.ws + WS_QK);
    const int gw = blockIdx.x * 8 + wave, NGW = gridDim.x * 8;
    const unsigned fo6 = (unsigned)(i32 * 6144 + 8 * hh);
    const unsigned go6 = (unsigned)(8 * hh * 6144 + i32);
    const unsigned so6 = (unsigned)(4 * hh * 6144 + i32);
    const unsigned so2 = (unsigned)(4 * hh * D_ + i32);
    const unsigned soq = (unsigned)(4 * hh * 64 + i32);
    for (int ch = gw; ch < 4096; ch += NGW) {
        const int n = ch & 63, bh = ch >> 6, b = bh >> 4, h = bh & 15;
        const size_t r0 = (size_t)b * T_ + n * 64;
        float* bap = BA + r0 * 32 + h;
        const float be = bap[lane * 32];
        float gc = bap[lane * 32 + 16];
        { int ln = lane; asm volatile("" : "+v"(ln));
#pragma unroll
          for (int o = 1; o < 64; o <<= 1) { const float t = __shfl(gc, (ln - o) & 63); if (ln >= o) gc += t; } }
        gcs[lane] = gc; bes[lane] = be;
        bf16_t* kslab = QKV + r0 * 6144 + 2048 + h * 128;
        bf16_t* vslab = QKV + r0 * 6144 + 4096 + h * 128;
        const bf16_t* qslab = QKV + r0 * 6144 + h * 128;
        LDS_WAIT();
        const float gcj0 = gcs[i32], gcj1 = gcs[32 + i32];
        {
            f32x16 a00, a10, a11;
#pragma unroll
            for (int r = 0; r < 16; ++r) { a00[r] = 0.f; a10[r] = 0.f; a11[r] = 0.f; }
#pragma unroll
            for (int kc = 0; kc < 8; ++kc) { const bf16x8 k0 = *(const bf16x8*)(kslab + 16 * kc + fo6), k1 = *(const bf16x8*)(kslab + 32 * 6144 + 16 * kc + fo6);
                a00 = MFMA32(k0, k0, a00); a10 = MFMA32(k1, k0, a10); a11 = MFMA32(k1, k1, a11); }
            const LAS float* gcl = gcs + 4 * hh; const LAS float* bel = bes + 4 * hh; LAS float* aml = Am + soq;
#pragma unroll
            for (int r = 0; r < 16; ++r) {
                const int ic = (r & 3) + 8 * (r >> 2);
                const float gi0 = gcl[ic], gi1 = gcl[32 + ic], bi0 = bel[ic], bi1 = bel[32 + ic];
                aml[ic * 64] = bi0 * a00[r] * __expf(fminf(gi0 - gcj0, 0.f));
                aml[(32 + ic) * 64] = bi1 * a10[r] * __expf(fminf(gi1 - gcj0, 0.f));
                aml[(32 + ic) * 64 + 32] = bi1 * a11[r] * __expf(fminf(gi1 - gcj1, 0.f));
            }
        }
        LDS_WAIT();
        {
            float T[64];
            f32x4 ra[16];
#define DN_LOADROW(i_, buf_) do { _Pragma("unroll") for (int j4 = 0; j4 < ((i_) + 3) / 4; ++j4) buf_[j4] = *(const LAS f32x4*)(Am + (i_) * 64 + 4 * j4); } while (0)
#define DN_ROW(i_, buf_) do { float c0 = 0.f, c1 = 0.f, c2 = 0.f, c3 = 0.f; \
                _Pragma("unroll") for (int j4 = 0; j4 < ((i_) + 3) / 4; ++j4) { \
                    if (4 * j4 + 0 < (i_)) c0 += buf_[j4][0] * T[4 * j4 + 0]; if (4 * j4 + 1 < (i_)) c1 += buf_[j4][1] * T[4 * j4 + 1]; \
                    if (4 * j4 + 2 < (i_)) c2 += buf_[j4][2] * T[4 * j4 + 2]; if (4 * j4 + 3 < (i_)) c3 += buf_[j4][3] * T[4 * j4 + 3]; } \
                T[i_] = ((lane == (i_)) ? 1.0f : 0.0f) - ((c0 + c1) + (c2 + c3)); } while (0)
#pragma unroll
            for (int i = 0; i < 64; ++i) {
                DN_LOADROW(i, ra); asm volatile("" ::: "memory");
                DN_ROW(i, ra);
                asm volatile("" ::: "memory");
            }
#undef DN_LOADROW
#undef DN_ROW
            LDS_WAIT();
            const float eg = __expf(gc);
#pragma unroll
            for (int i = 0; i < 64; ++i) { const float tp = T[i] * be; Tb[i * 64 + lane] = f2bf(tp); Tb2[i * 64 + lane] = f2bf(tp * eg); }
        }
        LDS_WAIT();
#define DN_TMUL(TBUF, SRC, DST, DSTLD, SOFF) do { \
            _Pragma("unroll 1") for (int dt = 0; dt < 4; ++dt) { \
                f32x16 u0, u1; \
                _Pragma("unroll") for (int r = 0; r < 16; ++r) { u0[r] = 0.f; u1[r] = 0.f; } \
                unsigned short rw[4][8]; \
                _Pragma("unroll") for (int jc = 0; jc < 4; ++jc) _Pragma("unroll") for (int e = 0; e < 8; ++e) rw[jc][e] = ((SRC) + (16 * jc + e) * 6144 + 32 * dt)[go6]; \
                __builtin_amdgcn_sched_barrier(0);     \
                _Pragma("unroll") for (int jc = 0; jc < 4; ++jc) { \
                    bf16x8 vb; \
                    _Pragma("unroll") for (int e = 0; e < 8; ++e) vb[e] = (short)rw[jc][e]; \
                    const bf16x8 ta0 = *(const LAS bf16x8*)((const LAS unsigned char*)(TBUF) + ((i32) * 64 + 16 * jc + 8 * hh) * 2); \
                    const bf16x8 ta1 = *(const LAS bf16x8*)((const LAS unsigned char*)(TBUF) + ((32 + i32) * 64 + 16 * jc + 8 * hh) * 2); \
                    u0 = MFMA32(ta0, vb, u0); u1 = MFMA32(ta1, vb, u1); } \
                asm volatile("" ::: "memory"); \
                _Pragma("unroll") for (int r = 0; r < 16; ++r) { \
                    ((DST) + ((r & 3) + 8 * (r >> 2)) * (DSTLD) + 32 * dt)[SOFF] = f2bf(u0[r]); \
                    ((DST) + (32 + (r & 3) + 8 * (r >> 2)) * (DSTLD) + 32 * dt)[SOFF] = f2bf(u1[r]); } \
                asm volatile("" ::: "memory"); } } while (0)
        DN_TMUL(Tb, vslab, vslab, 6144, so6);
        { bf16_t* wslab = WDN + r0 * D_ + h * 128; DN_TMUL(Tb2, kslab, wslab, D_, so2); }
#undef DN_TMUL
        {
            bf16x8 kf[2][8];
#pragma unroll
            for (int it = 0; it < 2; ++it)
#pragma unroll
                for (int kc = 0; kc < 8; ++kc) kf[it][kc] = *(const bf16x8*)(kslab + 32 * it * 6144 + 16 * kc + fo6);
            f32x16 q00, q10, q11;
#pragma unroll
            for (int r = 0; r < 16; ++r) { q00[r] = 0.f; q10[r] = 0.f; q11[r] = 0.f; }
#pragma unroll
            for (int kc = 0; kc < 8; ++kc) {
                const bf16x8 qa0 = *(const bf16x8*)(qslab + 16 * kc + fo6), qa1 = *(const bf16x8*)(qslab + 32 * 6144 + 16 * kc + fo6);
                q00 = MFMA32(qa0, kf[0][kc], q00); q10 = MFMA32(qa1, kf[0][kc], q10); q11 = MFMA32(qa1, kf[1][kc], q11);
            }
            asm volatile("" ::: "memory");
            bf16_t* qkc = QKb + (size_t)ch * 4096;
            const LAS float* gcl = gcs + 4 * hh;
#pragma unroll
            for (int r = 0; r < 16; ++r) {
                const int ic = (r & 3) + 8 * (r >> 2);
                const float gi0 = gcl[ic], gi1 = gcl[32 + ic];
                const bool low = (ic + 4 * hh >= i32);
                (qkc + ic * 64)[soq] = f2bf(low ? q00[r] * __expf(fminf(gi0 - gcj0, 0.f)) : 0.f);
                (qkc + ic * 64 + 32)[soq] = (bf16_t)0;
                (qkc + (32 + ic) * 64)[soq] = f2bf(q10[r] * __expf(fminf(gi1 - gcj0, 0.f)));
                (qkc + (32 + ic) * 64 + 32)[soq] = f2bf(low ? q11[r] * __expf(fminf(gi1 - gcj1, 0.f)) : 0.f);
            }
            asm volatile("" ::: "memory");
#pragma unroll
            for (int it = 0; it < 2; ++it)
#pragma unroll
                for (int kc = 0; kc < 8; ++kc) {
#pragma unroll
                    for (int e = 0; e < 8; ++e) (kslab + (8 * kc + (e >> 1)) * 6144 + (e & 1) * 64 + 32 * it)[so6] = (bf16_t)kf[it][kc][e];
                    asm volatile("" ::: "memory"); }
        }
        bap[lane * 32 + 16] = gc;
        LDS_WAIT();
    }
}
__device__ __forceinline__ bf16x8 pack44(const f32x4 a, const f32x4 b) { u32x4 w = {pkbf(a[0], a[1]), pkbf(a[2], a[3]), pkbf(b[0], b[1]), pkbf(b[2], b[3])}; return __builtin_bit_cast(bf16x8, w); }

__device__ __forceinline__ bf16x8 ldl44(const LAS unsigned char* p0) { const u32x2 a = *(const LAS u32x2*)p0, b = *(const LAS u32x2*)(p0 + 32); u32x4 w = {a.x, a.y, b.x, b.y}; return __builtin_bit_cast(bf16x8, w); }
#define SC_BAR() do { asm volatile("s_waitcnt lgkmcnt(0)" ::: "memory"); __builtin_amdgcn_s_barrier(); asm volatile("" ::: "memory"); } while (0)
__device__ __forceinline__ void phase_dn_scan3(const Params& p, LAS unsigned char* lds) {
    constexpr int WP = 272, KP = 144, QP = 144, UP = 80;
    constexpr int O_W = 0, O_Q = O_W + 64 * WP, O_KT = O_Q + 64 * WP, O_QK = O_KT + 128 * KP, O_U = O_QK + 64 * QP, O_GC = O_U + 64 * UP, BUF = O_GC + 256;
    static_assert(2 * BUF <= LDS_BYTES, "scan LDS image");
    const int tid = tid_opaque(), lane = tid & 63, wave = __builtin_amdgcn_readfirstlane(tid >> 6), i16 = lane & 15, g4 = lane >> 4;
    bf16_t* QKV = (bf16_t*)(p.ws + WS_QKV); const float* BA = (const float*)(p.ws + WS_BA); const bf16_t* WDN = (const bf16_t*)(p.ws + WS_WDN); const bf16_t* QKb = (const bf16_t*)(p.ws + WS_QK);
    for (int item = blockIdx.x; item < 256; item += gridDim.x) {
        const int xc = item & 7, sl = item >> 3, dvq = sl & 3, bh = (sl >> 2) * 8 + xc, b = bh >> 4, h = bh & 15;
        const size_t rowb = (size_t)b * T_;
        __syncthreads();
        if (wave >= 2) {
            const int lt = tid - 128;
            const int p0 = lt, p1 = lt + 384, p2 = (lt + 768 < 1024) ? lt + 768 : lt, q1 = (lt + 384 < 512) ? lt + 384 : lt, pu = lt & 255;
            const unsigned gw0 = (unsigned)((p0 >> 4) * (D_ * 2) + (p0 & 15) * 16), gw1 = (unsigned)((p1 >> 4) * (D_ * 2) + (p1 & 15) * 16), gw2 = (unsigned)((p2 >> 4) * (D_ * 2) + (p2 & 15) * 16);
            const unsigned g60 = (unsigned)((p0 >> 4) * 12288 + (p0 & 15) * 16), g61 = (unsigned)((p1 >> 4) * 12288 + (p1 & 15) * 16), g62 = (unsigned)((p2 >> 4) * 12288 + (p2 & 15) * 16);
            const unsigned lw0 = (unsigned)((p0 >> 4) * WP + (p0 & 15) * 16), lw1 = (unsigned)((p1 >> 4) * WP + (p1 & 15) * 16), lw2 = (unsigned)((p2 >> 4) * WP + (p2 & 15) * 16);
            const unsigned lk0 = (unsigned)((2 * (p0 >> 4) + ((p0 >> 3) & 1)) * KP + (p0 & 7) * 16), lk1 = (unsigned)((2 * (p1 >> 4) + ((p1 >> 3) & 1)) * KP + (p1 & 7) * 16), lk2 = (unsigned)((2 * (p2 >> 4) + ((p2 >> 3) & 1)) * KP + (p2 & 7) * 16);
            const unsigned gq0 = (unsigned)(p0 * 16), gq1 = (unsigned)(q1 * 16);
            const unsigned lq0 = (unsigned)((p0 >> 3) * QP + (p0 & 7) * 16), lq1 = (unsigned)((q1 >> 3) * QP + (q1 & 7) * 16);
            const unsigned gu0 = (unsigned)((pu >> 2) * 12288 + (pu & 3) * 16), lu0 = (unsigned)((pu >> 2) * UP + (pu & 3) * 16);
            const char* Wg = (const char*)(WDN + rowb * D_ + h * 128);
            const char* Qg = (const char*)(QKV + rowb * 6144 + h * 128);
            const char* Kg = (const char*)(QKV + rowb * 6144 + 2048 + h * 128);
            const char* Ug = (const char*)(QKV + rowb * 6144 + 4096 + h * 128 + dvq * 32);
            const char* QKg = (const char*)(QKb + (size_t)(bh * 64) * 4096);
            const float* gcp = BA + (rowb + (lt & 63)) * 32 + 16 + h;
            u32x4 dA[12], dB[12], dC[12]; float gA = 0.f, gB = 0.f, gC = 0.f;
#define SC_LOAD(D, GV, n) do { const char* w_ = Wg + (size_t)(n) * (64 * D_ * 2); const char* q_ = Qg + (size_t)(n) * (64 * 12288); const char* k_ = Kg + (size_t)(n) * (64 * 12288); \
                const char* u_ = Ug + (size_t)(n) * (64 * 12288); const char* qk_ = QKg + (size_t)(n) * 8192; \
                D[0] = *(const u32x4*)(w_ + gw0); D[1] = *(const u32x4*)(w_ + gw1); D[2] = *(const u32x4*)(w_ + gw2); \
                D[3] = *(const u32x4*)(q_ + g60); D[4] = *(const u32x4*)(q_ + g61); D[5] = *(const u32x4*)(q_ + g62); \
                D[6] = *(const u32x4*)(k_ + g60); D[7] = *(const u32x4*)(k_ + g61); D[8] = *(const u32x4*)(k_ + g62); \
                D[9] = *(const u32x4*)(qk_ + gq0); D[10] = *(const u32x4*)(qk_ + gq1); D[11] = *(const u32x4*)(u_ + gu0); \
                GV = gcp[(size_t)(n) * 2048]; } while (0)
#define SC_STORE(D, GV, bb) do { LAS unsigned char* bp = lds + (bb) * BUF; \
                *(LAS u32x4*)(bp + O_W + lw0) = D[0]; *(LAS u32x4*)(bp + O_W + lw1) = D[1]; *(LAS u32x4*)(bp + O_W + lw2) = D[2]; \
                *(LAS u32x4*)(bp + O_Q + lw0) = D[3]; *(LAS u32x4*)(bp + O_Q + lw1) = D[4]; *(LAS u32x4*)(bp + O_Q + lw2) = D[5]; \
                *(LAS u32x4*)(bp + O_KT + lk0) = D[6]; *(LAS u32x4*)(bp + O_KT + lk1) = D[7]; *(LAS u32x4*)(bp + O_KT + lk2) = D[8]; \
                *(LAS u32x4*)(bp + O_QK + lq0) = D[9]; *(LAS u32x4*)(bp + O_QK + lq1) = D[10]; *(LAS u32x4*)(bp + O_U + lu0) = D[11]; \
                ((LAS float*)(bp + O_GC))[lt & 63] = GV; } while (0)
#define SC_CL(n) ((n) < 64 ? (n) : 63)
#define SC_STEP(D, GV, t, bb) do { if ((t) < 64) { if ((t) + 1 < 64) SC_STORE(D, GV, bb); SC_LOAD(D, GV, SC_CL((t) + 4)); SC_BAR(); } } while (0)
            SC_LOAD(dA, gA, 0); SC_STORE(dA, gA, 0);
            SC_LOAD(dA, gA, 1); SC_LOAD(dB, gB, 2); SC_LOAD(dC, gC, 3);
            SC_BAR();
#pragma unroll 1
            for (int n = 0; n < 64; n += 6) {
                SC_STEP(dA, gA, n, 1); SC_STEP(dB, gB, n + 1, 0); SC_STEP(dC, gC, n + 2, 1);
                SC_STEP(dA, gA, n + 3, 0); SC_STEP(dB, gB, n + 4, 1); SC_STEP(dC, gC, n + 5, 0);
            }
#undef SC_STEP
#undef SC_CL
#undef SC_LOAD
#undef SC_STORE
        } else {
            f32x4 S[8];
#pragma unroll
            for (int dt = 0; dt < 8; ++dt) S[dt] = (f32x4){0.f, 0.f, 0.f, 0.f};
            SC_BAR();
#pragma unroll 1
            for (int n = 0; n < 64; ++n) {
                const LAS unsigned char* bp = lds + (n & 1) * BUF;
                const LAS unsigned char* wr_ = bp + O_W + i16 * WP + 8 * g4;
                const LAS unsigned char* qr_ = bp + O_Q + i16 * WP + 8 * g4;
                const LAS unsigned char* qkr = bp + O_QK + i16 * QP + 8 * g4;
                const LAS unsigned char* ktr = bp + O_KT + i16 * KP + 8 * g4;
                const LAS unsigned char* ur = bp + O_U + (4 * g4) * UP + (wave * 16 + i16) * 2;
                const LAS float* gcl = (const LAS float*)(bp + O_GC) + 4 * g4;
                const float gl = ((const LAS float*)(bp + O_GC))[63];
                bf16_t* uo = QKV + (rowb + n * 64 + 4 * g4) * 6144 + 4096 + h * 128 + dvq * 32 + wave * 16 + i16;
                bf16x8 wf[4][4], qf4[4][4];
#pragma unroll
                for (int mt = 0; mt < 4; ++mt)
#pragma unroll
                    for (int kc = 0; kc < 4; ++kc) { wf[mt][kc] = ldl44(wr_ + 16 * mt * WP + 64 * kc); qf4[mt][kc] = ldl44(qr_ + 16 * mt * WP + 64 * kc); }
                asm volatile("" ::: "memory");
                bf16x8 sb[4];
#pragma unroll
                for (int kc = 0; kc < 4; ++kc) sb[kc] = pack44(S[2 * kc], S[2 * kc + 1]);
                f32x4 ws4[4], qs4[4];
#pragma unroll
                for (int mt = 0; mt < 4; ++mt) { ws4[mt] = (f32x4){0.f, 0.f, 0.f, 0.f}; qs4[mt] = ws4[mt]; }
#pragma unroll
                for (int kc = 0; kc < 4; ++kc)
#pragma unroll
                    for (int mt = 0; mt < 4; ++mt) { ws4[mt] = MFMA16(wf[mt][kc], sb[kc], ws4[mt]); qs4[mt] = MFMA16(qf4[mt][kc], sb[kc], qs4[mt]); }
                bf16x8 qkf[4][2], ktf[8][2];
#pragma unroll
                for (int mt = 0; mt < 4; ++mt) { qkf[mt][0] = ldl44(qkr + 16 * mt * QP); qkf[mt][1] = ldl44(qkr + 16 * mt * QP + 64); }
#pragma unroll
                for (int dt = 0; dt < 8; ++dt) { ktf[dt][0] = ldl44(ktr + 16 * dt * KP); ktf[dt][1] = ldl44(ktr + 16 * dt * KP + 64); }
                float gcv[4][4], uu[4][4];
#pragma unroll
                for (int mt = 0; mt < 4; ++mt)
#pragma unroll
                    for (int r = 0; r < 4; ++r) { gcv[mt][r] = gcl[16 * mt + r]; uu[mt][r] = bf2f(*(const LAS bf16_t*)(ur + (16 * mt + r) * UP)); }
                asm volatile("" ::: "memory");
                f32x4 vn[4], vs[4], eg[4];
#pragma unroll
                for (int mt = 0; mt < 4; ++mt)
#pragma unroll
                    for (int r = 0; r < 4; ++r) { eg[mt][r] = __expf(gcv[mt][r]); vn[mt][r] = uu[mt][r] - ws4[mt][r]; vs[mt][r] = vn[mt][r] * __expf(gl - gcv[mt][r]); }
                const bf16x8 vb10 = pack44(vn[0], vn[1]), vb11 = pack44(vn[2], vn[3]), vb20 = pack44(vs[0], vs[1]), vb21 = pack44(vs[2], vs[3]);
#pragma unroll
                for (int mt = 0; mt < 4; ++mt) { f32x4 o = qs4[mt] * eg[mt];
                    o = MFMA16(qkf[mt][0], vb10, o); o = MFMA16(qkf[mt][1], vb11, o);
#pragma unroll
                    for (int r = 0; r < 4; ++r) uo[(size_t)(16 * mt + r) * 6144] = f2bf(o[r]); }
                const float egl = __expf(gl);
#pragma unroll
                for (int dt = 0; dt < 8; ++dt) { f32x4 sn = S[dt] * egl; sn = MFMA16(ktf[dt][0], vb20, sn); sn = MFMA16(ktf[dt][1], vb21, sn); S[dt] = sn; }
                SC_BAR();
            }
        }
    }
}


__device__ __forceinline__ void phase_ba(const Params& p, LAS unsigned char* lds) {
    const int tid = tid_opaque(), lane = tid & 63, wave = __builtin_amdgcn_readfirstlane(tid >> 6), i32 = lane & 31, hh = lane >> 5;
    const bf16_t* U = (const bf16_t*)(p.ws + WS_U); const bf16_t* Wb = (const bf16_t*)(p.ws + WS_WIN1) + (size_t)12288 * 2048; float* BA = (float*)(p.ws + WS_BA);
    LAS float* red = (LAS float*)lds;
    for (int item = blockIdx.x; item < 256; item += gridDim.x) {
        const size_t row0 = (size_t)item * 64;
        f32x16 a0, a1;
#pragma unroll
        for (int r = 0; r < 16; ++r) { a0[r] = 0.f; a1[r] = 0.f; }
        const bf16_t* bp = Wb + (size_t)i32 * 2048 + 256 * wave + 8 * hh;
        const bf16_t* ap = U + (row0 + i32) * D_ + 256 * wave + 8 * hh;
#pragma unroll
        for (int ks = 0; ks < 16; ++ks) { const bf16x8 bfr = *(const bf16x8*)(bp + 16 * ks), af0 = *(const bf16x8*)(ap + 16 * ks), af1 = *(const bf16x8*)(ap + (size_t)32 * D_ + 16 * ks);
            a0 = MFMA32(af0, bfr, a0); a1 = MFMA32(af1, bfr, a1); }
        __syncthreads();
#pragma unroll
        for (int r = 0; r < 16; ++r) { red[((wave * 2 + 0) * 16 + r) * 64 + lane] = a0[r]; red[((wave * 2 + 1) * 16 + r) * 64 + lane] = a1[r]; }
        __syncthreads();
#pragma unroll
        for (int q = 0; q < 4; ++q) { const int idx = tid + 512 * q, mt = idx >> 10, r = (idx >> 6) & 15, ln = idx & 63; float t = 0.f;
#pragma unroll
            for (int w8 = 0; w8 < 8; ++w8) t += red[((w8 * 2 + mt) * 16 + r) * 64 + ln];
            BA[(row0 + 32 * mt + (r & 3) + 8 * (r >> 2) + 4 * (ln >> 5)) * 32 + (ln & 31)] = t; }
    }
}

__device__ __forceinline__ void phase_ya(const Params& p) {
    const int tid_ = tid_opaque(); const int lane = tid_ & 63, wave = tid_ >> 6;
    const int gw = blockIdx.x * 8 + wave, NGW = gridDim.x * 8;
    bf16_t* QKV = (bf16_t*)(p.ws + WS_QKV);
    const int e8 = lane & 15;
    float gn[8];
#pragma unroll
    for (int i = 0; i < 8; ++i) gn[i] = p.dn_norm_g[e8 * 8 + i];
    for (int it = gw; it < M_ * 16 / 4; it += 2 * NGW) {
        const int it2 = it + NGW; const bool v2 = it2 < M_ * 16 / 4;
        const int pairA = it * 4 + (lane >> 4), pairB = (v2 ? it2 : it) * 4 + (lane >> 4);
        bf16_t* opA = QKV + (size_t)(pairA >> 4) * 6144 + 4096 + (pairA & 15) * 128 + e8 * 8; const bf16_t* zpA = opA - 4096;
        bf16_t* opB = QKV + (size_t)(pairB >> 4) * 6144 + 4096 + (pairB & 15) * 128 + e8 * 8; const bf16_t* zpB = opB - 4096;
        const u32x4 oA = *(const u32x4*)opA, zA = *(const u32x4*)zpA, oB = *(const u32x4*)opB, zB = *(const u32x4*)zpB;
#pragma unroll
        for (int half = 0; half < 2; ++half) {
            float of[8], zf[8]; unpack8(half ? oB : oA, of); unpack8(half ? zB : zA, zf);
            float ss = 0.f;
#pragma unroll
            for (int i = 0; i < 8; ++i) ss += of[i] * of[i];
            ss += __shfl_xor(ss, 1); ss += __shfl_xor(ss, 2); ss += __shfl_xor(ss, 4); ss += __shfl_xor(ss, 8);
            const float rs = rsqrtf(ss * (1.0f / 128.0f) + 1e-6f);
            u32x4 w;
#pragma unroll
            for (int e = 0; e < 4; ++e) w[e] = cvt_pk_bf16(of[2 * e] * rs * gn[2 * e] * siluf_(zf[2 * e]), of[2 * e + 1] * rs * gn[2 * e + 1] * siluf_(zf[2 * e + 1]));
            if (half == 0) *(u32x4*)opA = w; else if (v2) *(u32x4*)opB = w;
        }
    }
}


#define XB_TMO      128
#define XB_XCNT(j)  (256  + 64 * (j))
#define XB_XSUB(j)  (1280 + 64 * (j))
#define XB_XGEN(j)  (2304 + 64 * (j))
#define XB_TOP      3328
#define XB_TOPGEN   3392
#define XCD_BAR_WORDS 3456
#define XB_SPIN_CAP (1u << 18)
__device__ __forceinline__ unsigned xb_ld(unsigned* p)              { return __hip_atomic_load(p, __ATOMIC_RELAXED, __HIP_MEMORY_SCOPE_AGENT); }
__device__ __forceinline__ unsigned xb_add(unsigned* p, unsigned v) { return __hip_atomic_fetch_add(p, v, __ATOMIC_RELAXED, __HIP_MEMORY_SCOPE_AGENT); }
__device__ __forceinline__ unsigned xb_xcc_id() { return (unsigned)__builtin_amdgcn_s_getreg((3 << 11) | 20) & 0xFu; }
#define XB_SPIN(cond, bar) do { unsigned _sp = 0; while (cond) { __builtin_amdgcn_s_sleep(1); \
    if ((++_sp & 255u) == 0u) { if (xb_ld(&(bar)[XB_TMO])) break; if (_sp > XB_SPIN_CAP) { atomicAdd(&(bar)[XB_TMO], 1u); break; } } } } while (0)
struct XcdBarrier { unsigned* bar; unsigned x; volatile LAS unsigned* st; };
__device__ __forceinline__ XcdBarrier xcd_barrier_post(unsigned* bar, volatile LAS unsigned* st) {
    XcdBarrier b; b.bar = bar; b.x = xb_xcc_id(); b.st = st;
    if (threadIdx.x == 0) (void)xb_add(&bar[XB_XCNT(b.x)], 1u);
    return b;
}
__device__ __forceinline__ void xcd_barrier_complete(unsigned* bar, unsigned x, unsigned& nloc, unsigned& nx) {
    const unsigned G = gridDim.x * gridDim.y * gridDim.z;
    unsigned sum, cnt, mine, sp = 0u;
    for (;;) {
        sum = 0u; cnt = 0u; mine = 0u;
#pragma unroll
        for (unsigned j = 0; j < 16; ++j) { const unsigned c = xb_ld(&bar[XB_XCNT(j)]); sum += c; cnt += (c > 0u) ? 1u : 0u; mine = (j == x) ? c : mine; }
        if (sum == G) break;
        __builtin_amdgcn_s_sleep(1);
        if ((++sp & 255u) == 0u) { if (xb_ld(&bar[XB_TMO])) break; if (sp > XB_SPIN_CAP) { atomicAdd(&bar[XB_TMO], 1u); break; } }
    }
    nloc = mine > 0u ? mine : 1u; nx = cnt > 0u ? cnt : 1u;
}
__device__ __forceinline__ void xcd_barrier(const XcdBarrier& b) {
    asm volatile("s_waitcnt vmcnt(0)" ::: "memory");
    __syncthreads();
    if (threadIdx.x == 0) {
        unsigned* bar = b.bar;
        __builtin_amdgcn_s_waitcnt(0);
        unsigned nloc = b.st[0], nx = b.st[1];
        if (nloc == 0u) { xcd_barrier_complete(bar, b.x, nloc, nx); b.st[0] = nloc; b.st[1] = nx; }
        const unsigned old = xb_add(&bar[XB_XSUB(b.x)], 1u);
        const unsigned gen = old / nloc;
        if (old + 1u == (gen + 1u) * nloc) {
            __builtin_amdgcn_fence(__ATOMIC_RELEASE, "agent");
            asm volatile("s_waitcnt vmcnt(0)" ::: "memory");
            const unsigned og = xb_add(&bar[XB_TOP], 1u);
            const unsigned tg = og / nx;
            if (og + 1u == (tg + 1u) * nx) xb_add(&bar[XB_TOPGEN], 1u);
            else XB_SPIN(xb_ld(&bar[XB_TOPGEN]) == tg, bar);
            __builtin_amdgcn_fence(__ATOMIC_ACQUIRE, "agent");
            xb_add(&bar[XB_XGEN(b.x)], 1u);
            asm volatile("s_waitcnt vmcnt(0)" ::: "memory");
        } else {
            XB_SPIN(xb_ld(&bar[XB_XGEN(b.x)]) == gen, bar);
            __builtin_amdgcn_fence(__ATOMIC_ACQUIRE, "agent");
            asm volatile("s_waitcnt vmcnt(0)" ::: "memory");
        }
    }
    __syncthreads();
}

__global__ void __launch_bounds__(512, 2) fwd_megakernel(Params p) {
    extern __shared__ __attribute__((aligned(16))) unsigned char lds_raw[];
    LAS unsigned char* lds = (LAS unsigned char*)lds_raw;
    cg::grid_group grid = cg::this_grid();
    __shared__ unsigned xb_st[2];
    if (threadIdx.x == 0) { xb_st[0] = 0u; xb_st[1] = 0u; }
    __syncthreads();
    const XcdBarrier xbar = xcd_barrier_post((unsigned*)(p.ws + WS_XBAR), (volatile LAS unsigned*)xb_st);
#define GRID_SYNC() xcd_barrier(xbar)
    const int G = gridDim.x, bid = blockIdx.x;
    unsigned char* ws = p.ws;
    bf16_t* U = (bf16_t*)(ws + WS_U); bf16_t* ACT = (bf16_t*)(ws + WS_ACT); bf16_t* QKV = (bf16_t*)(ws + WS_QKV); bf16_t* MB = (bf16_t*)(ws + WS_MB);
    const float* ada = (const float*)(ws + WS_ADA);
    const bf16_t* W13 = (const bf16_t*)(ws + WS_W13); const bf16_t* W2 = (const bf16_t*)(ws + WS_W2);

    phase0(p, lds);
    grid.sync();
    phase_ada_reduce(p);
    GRID_SYNC();
    phase_normmod(p.x, p.norm1_g, ada, 0 * D_, 1 * D_, U);
    GRID_SYNC();
    { pg8::Gemm g{U, D_, W13, D_}; pg8::StaticOrder S; S.init(64, 44, G, bid); pg8::EpiSwiglu E{ACT}; pg8::gemm_phase(lds, g, S, E); }
    GRID_SYNC();
    { pg8::Gemm g{ACT, FF_, W2, FF_}; pg8::StaticOrder S; S.init(64, 8, G, bid); pg8::EpiResid E{p.x, p.out, ada + 2 * D_, 0.5f}; pg8::gemm_phase(lds, g, S, E); }
    GRID_SYNC();
#ifndef PROBE_N
#define PROBE_N 0
#endif
    for (int pass = (PROBE_N > 0 ? 0 : 1); pass < 2; ++pass) {
    const int lim = (pass == 0) ? PROBE_N : 99;
    if (lim >= 1) { phase_normmod(p.out, p.norm2_g, ada, 3 * D_, 4 * D_, U); GRID_SYNC(); }
    if (lim >= 2) { pg8::Gemm g{U, D_, (const bf16_t*)(ws + WS_WIN1), D_}; pg8::StaticOrder S; S.init(64, 48, G, bid); pg8::EpiIn1 E{QKV, MB, (float*)(ws + WS_BA)}; pg8::gemm_phase(lds, g, S, E); phase_ba(p, lds); GRID_SYNC(); }
    if (lim >= 3) { phase_halo(p); GRID_SYNC(); }
    if (lim >= 4) { phase_postproc(p, lds); GRID_SYNC(); }
    if (lim >= 6) { phase_dn_local(p, lds); GRID_SYNC(); }
    if (lim >= 7) { phase_dn_scan3(p, lds); __syncthreads(); }
    if (lim >= 8) { phase_moba_mfma(p, lds, (unsigned)(size_t)lds_raw); }
    if (lim >= 7) GRID_SYNC();
    if (lim >= 9) { pg8::Gemm g{U, D_, (const bf16_t*)(ws + WS_WIN2), D_}; pg8::StaticOrder S; S.init(64, 24, G, bid); pg8::EpiIn2 E{QKV, MB + (size_t)M_ * D_}; pg8::gemm_phase(lds, g, S, E); GRID_SYNC(); }
    if (lim >= 10) { phase_ya(p); GRID_SYNC(); }
    if (lim >= 11) {
      { pg8::Gemm g{QKV + 4096, 6144, (const bf16_t*)(ws + WS_WPAB), D_}; pg8::StaticOrder S; S.init(64, 8, G, bid);
        pg8::EpiProjA E{QKV + 2048, 6144, MB + 2 * (size_t)M_ * D_}; pg8::gemm_phase(lds, g, S, E); }
      { pg8::Gemm g{MB, D_, (const bf16_t*)(ws + WS_WPAB) + (size_t)2048 * 2048, D_}; pg8::StaticOrder S; S.init(64, 8, G, bid);
        pg8::EpiProjB E{MB + (size_t)M_ * D_, D_, MB + 2 * (size_t)M_ * D_, U}; pg8::gemm_phase(lds, g, S, E); }
      GRID_SYNC(); }
    }
    { pg8::Gemm g{U, D_, (const bf16_t*)(ws + WS_WOUT), D_}; pg8::StaticOrder S; S.init(64, 8, G, bid); pg8::EpiResid E{p.out, p.out, ada + 5 * D_, 1.0f}; pg8::gemm_phase(lds, g, S, E); }
    GRID_SYNC();
    phase_normmod(p.out, p.norm3_g, ada, 6 * D_, 7 * D_, U);
    { const int tid_ = tid_opaque(); const int lane = tid_ & 63, wave = tid_ >> 6; __syncthreads();
      convert_ffn(p.f2w1, p.f2w3, p.f2w2, (bf16_t*)(ws + WS_W13), (bf16_t*)(ws + WS_W2), (LAS float*)(lds + wave * 8448), bid * 8 + wave, G * 8, lane); }
    GRID_SYNC();
    { pg8::Gemm g{U, D_, W13, D_}; pg8::StaticOrder S; S.init(64, 44, G, bid); pg8::EpiSwiglu E{ACT}; pg8::gemm_phase(lds, g, S, E); }
    GRID_SYNC();
    { pg8::Gemm g{ACT, FF_, W2, FF_}; pg8::StaticOrder S; S.init(64, 8, G, bid); pg8::EpiResid E{p.out, p.out, ada + 8 * D_, 0.5f}; pg8::gemm_phase(lds, g, S, E); }
}

extern "C" void kernel_launch(void* const* d_in, const int* in_sizes, int n_in, void* d_out, int out_size, void* d_ws, size_t ws_size, hipStream_t stream) {
    static int grid_blocks = 0;
    if (grid_blocks == 0) {
        if (n_in != 24 || ws_size < WS_END) { fprintf(stderr, "kernel_launch: unexpected n_in %d or ws_size %zu (< %zu)\n", n_in, ws_size, (size_t)WS_END); grid_blocks = -1; return; }
        int dev = 0, cus = 0, per_cu = 0;
        hipGetDevice(&dev);
        hipDeviceGetAttribute(&cus, hipDeviceAttributeMultiprocessorCount, dev);
        hipFuncSetAttribute((const void*)fwd_megakernel, hipFuncAttributeMaxDynamicSharedMemorySize, LDS_BYTES);
        hipOccupancyMaxActiveBlocksPerMultiprocessor(&per_cu, (const void*)fwd_megakernel, 512, LDS_BYTES);
        if (per_cu < 1) { fprintf(stderr, "kernel_launch: occupancy query says %d blocks per CU\n", per_cu); per_cu = 1; }
        (void)hipGetLastError();
        grid_blocks = cus;
        if (grid_blocks > 256) grid_blocks = 256;
    }
    if (grid_blocks < 0) return;
    Params p{};
    const float** pp = (const float**)&p;
    for (int i = 0; i < 24; ++i) pp[i] = (const float*)d_in[i];
    p.out = (float*)d_out; p.ws = (unsigned char*)d_ws;
    (void)hipMemsetAsync((char*)d_ws + WS_XBAR, 0, 16384, stream);
    void* args[] = {&p};
    hipError_t e = hipLaunchCooperativeKernel((const void*)fwd_megakernel, dim3(grid_blocks), dim3(512), args, LDS_BYTES, stream);
    if (e != hipSuccess) fprintf(stderr, "cooperative launch failed: %s (grid %d)\n", hipGetErrorString(e), grid_blocks);
}
```

```cpp
#include <hip/hip_runtime.h>
#include <hip/hip_cooperative_groups.h>
#include <cstdio>
#include <cstdint>
namespace cg = cooperative_groups;

#define LAS __attribute__((address_space(3)))
typedef unsigned short bf16_t;
typedef short bf16x8 __attribute__((ext_vector_type(8)));
typedef float f32x4 __attribute__((ext_vector_type(4)));
typedef unsigned u32x4 __attribute__((ext_vector_type(4)));
typedef unsigned u32x2 __attribute__((ext_vector_type(2)));

constexpr int M_ = 16384, D_ = 2048, FF_ = 5632, T_ = 4096;
constexpr int NIN1 = 12544, NIN2 = 6144, NADA = 18432;
constexpr float LOG2E = 1.4426950408889634f;
constexpr float QSCALE = 0.08838834764831845f;

constexpr size_t SZ_MD = (size_t)M_ * D_ * 2;
constexpr size_t WS_W13 = 0;
constexpr size_t WS_W2 = WS_W13 + (size_t)11264 * 2048 * 2;
constexpr size_t WS_WIN1 = WS_W2 + (size_t)2048 * 5632 * 2;
constexpr size_t WS_WIN2 = WS_WIN1 + (size_t)NIN1 * 2048 * 2;
constexpr size_t WS_WPAB = WS_WIN2 + (size_t)NIN2 * 2048 * 2;
constexpr size_t WS_WOUT = WS_WPAB + (size_t)2048 * 4096 * 2;
constexpr size_t WS_ADA = WS_WOUT + (size_t)2048 * 2048 * 2;
constexpr size_t WS_BT = WS_ADA + (size_t)4 * NADA * 4;
constexpr size_t WS_KMEAN = WS_BT + (size_t)16 * 4096 * 4;
constexpr size_t WS_U = WS_KMEAN + (size_t)4 * 16 * 16 * 128 * 4;
constexpr size_t WS_BIG = WS_U + SZ_MD;
constexpr size_t WS_QKV = WS_BIG;
constexpr size_t WS_MB = WS_QKV + 3 * SZ_MD;
constexpr size_t WS_BA = WS_MB + 3 * SZ_MD;
constexpr size_t WS_WDN = WS_BA + (size_t)M_ * 32 * 4;
constexpr size_t WS_QK = WS_WDN + SZ_MD;
constexpr size_t WS_XBAR = WS_QK + SZ_MD / 2;
constexpr size_t WS_END = WS_XBAR + 16384;
constexpr size_t WS_ACT = WS_BIG;
constexpr size_t WS_ADAP = WS_BIG;
constexpr size_t WS_HALO = WS_WDN;

constexpr int LDS_BYTES = 147456;

struct Params {
    const float* x; const float* c; const float* ada_w; const float* ada_b; const float* norm1_g;
    const float* f1w1; const float* f1w3; const float* f1w2; const float* norm2_g; const float* w_in;
    const float* conv_w; const float* a_log; const float* dt_bias; const float* dn_norm_g; const float* qn_g; const float* kn_g;
    const float* rel_bias; const float* wpa; const float* wpb; const float* wout; const float* norm3_g;
    const float* f2w1; const float* f2w3; const float* f2w2;
    float* out; unsigned char* ws;
};

typedef float f32x2v __attribute__((ext_vector_type(2)));
typedef __bf16 bf16x2_t __attribute__((ext_vector_type(2)));
__device__ __forceinline__ unsigned cvt_pk_bf16(float lo, float hi) { f32x2v v = {lo, hi}; bf16x2_t r = __builtin_convertvector(v, bf16x2_t); return __builtin_bit_cast(unsigned, r); }
__device__ __forceinline__ bf16_t f2bf(float f) { return (bf16_t)(cvt_pk_bf16(f, 0.f) & 0xffffu); }
__device__ __forceinline__ float bf2f(unsigned b) { return __uint_as_float(b << 16); }
__device__ __forceinline__ float bflo(unsigned w) { return __uint_as_float(w << 16); }
__device__ __forceinline__ float bfhi(unsigned w) { return __uint_as_float(w & 0xffff0000u); }
__device__ __forceinline__ float wave_sum(float v) {
#pragma unroll
    for (int o = 1; o < 64; o <<= 1) v += __shfl_xor(v, o);
    return v;
}
__device__ __forceinline__ float wave_max(float v) {
#pragma unroll
    for (int o = 1; o < 64; o <<= 1) v = fmaxf(v, __shfl_xor(v, o));
    return v;
}
__device__ __forceinline__ float sigmoidf_(float x) { return __builtin_amdgcn_rcpf(1.0f + __builtin_amdgcn_exp2f(-x * LOG2E)); }
__device__ __forceinline__ float siluf_(float x) { return x * sigmoidf_(x); }
#define LDS_WAIT() asm volatile("s_waitcnt lgkmcnt(0)" ::: "memory")
__device__ __forceinline__ int tid_opaque() { int t = threadIdx.x; asm volatile("" : "+v"(t)); return t; }

namespace pg8 {
constexpr int BM = 256, BK = 64, HALF = 128, HTB = HALF * BK * 2, STAGE_BYTES = 8 * HTB, NXCD = 8, WGM = 4;
__host__ __device__ __forceinline__ int lds_byte(int r, int c) { const int st = (r >> 4) * 2 + (c >> 5), rr = r & 15, cc = c & 31, ob = rr * 64 + cc * 2; return st * 1024 + (ob ^ (((ob >> 9) & 1) << 5)); }
__host__ __device__ __forceinline__ void stage_rc(int b, int& R, int& C) { const int st = b / 1024, sb = b % 1024, swz = sb ^ (((sb >> 9) & 1) << 5); R = (st >> 1) * 16 + swz / 64; C = (st & 1) * 32 + (swz % 64) / 2; }
__host__ __device__ __forceinline__ int perm32(int rho) { const int n = rho >> 4, i = rho & 15; return 8 * (i >> 2) + 4 * n + (i & 3); }

struct Unit { int pm, pn; };
struct Gemm { const bf16_t* A; int lda; const bf16_t* Bt; int K; };

struct StaticOrder {
    int nM, nN, nwg, G, c;
    __device__ void init(int nM_, int nN_, int G_, int c_) { nM = nM_; nN = nN_; nwg = nM * nN; G = G_; c = c_; }
    __device__ bool next(int i, Unit& u) const {
        const long L = (long)i * G + c; if (L >= nwg) return false;
        int wgid = (int)L; { const int q = nwg / NXCD, r = nwg % NXCD, xcd = wgid % NXCD, off = wgid / NXCD; wgid = (xcd < r ? xcd * (q + 1) : r * (q + 1) + (xcd - r) * q) + off; }
        const int nig = WGM * nN, gid = wgid / nig, fm = gid * WGM, gsz = (nM - fm) < WGM ? (nM - fm) : WGM;
        u.pm = fm + ((wgid % nig) % gsz); u.pn = (wgid % nig) / gsz; return true;
    }
};

typedef f32x4 Acc[2][2][4][2];

struct EpiSwiglu {
    static constexpr bool PERM = true;
    bf16_t* O;
    __device__ __forceinline__ void operator()(const Acc& acc, const Unit& u, int wr, int wc, int fr, int fq) const {
        const int row0 = u.pm * BM + wr * 64 + fr, col0 = u.pn * 128 + wc * 32 + 8 * fq;
#pragma unroll
        for (int ai = 0; ai < 2; ++ai)
#pragma unroll
            for (int m = 0; m < 4; ++m) {
                bf16_t* rowp = O + (size_t)(row0 + ai * HALF + m * 16) * FF_ + col0;
                float v[8];
#pragma unroll
                for (int n = 0; n < 2; ++n)
#pragma unroll
                    for (int j = 0; j < 4; ++j) v[n * 4 + j] = siluf_(acc[ai][0][m][n][j]) * acc[ai][1][m][n][j];
                u32x4 w; w.x = cvt_pk_bf16(v[0], v[1]); w.y = cvt_pk_bf16(v[2], v[3]); w.z = cvt_pk_bf16(v[4], v[5]); w.w = cvt_pk_bf16(v[6], v[7]);
                *(u32x4*)rowp = w;
            }
    }
};
struct EpiResid {
    static constexpr bool PERM = false;
    const float* resid; float* out; const float* gada; float scale;
    __device__ __forceinline__ void operator()(const Acc& acc, const Unit& u, int wr, int wc, int fr, int fq) const {
        const int row0 = u.pm * BM + wr * 64 + fr, col0 = u.pn * BM + wc * 32 + 4 * fq;
        const float* g = gada + (size_t)(u.pm >> 4) * NADA;
        f32x4 gv[2][2];
#pragma unroll
        for (int bj = 0; bj < 2; ++bj)
#pragma unroll
            for (int n = 0; n < 2; ++n) gv[bj][n] = *(const f32x4*)(g + col0 + bj * HALF + n * 16) * scale;
#pragma unroll
        for (int ai = 0; ai < 2; ++ai) {
            f32x4 rr[4][2][2];
#pragma unroll
            for (int m = 0; m < 4; ++m)
#pragma unroll
                for (int bj = 0; bj < 2; ++bj)
#pragma unroll
                    for (int n = 0; n < 2; ++n) rr[m][bj][n] = *(const f32x4*)(resid + (size_t)(row0 + ai * HALF + m * 16) * D_ + col0 + bj * HALF + n * 16);
#pragma unroll
            for (int m = 0; m < 4; ++m)
#pragma unroll
                for (int bj = 0; bj < 2; ++bj)
#pragma unroll
                    for (int n = 0; n < 2; ++n) *(f32x4*)(out + (size_t)(row0 + ai * HALF + m * 16) * D_ + col0 + bj * HALF + n * 16) = rr[m][bj][n] + gv[bj][n] * acc[ai][bj][m][n];
        }
    }
};
__device__ __forceinline__ void store_bf16_tile(const Acc& acc, bf16_t* base, int ldc, int row0, int col0) {
#pragma unroll
    for (int ai = 0; ai < 2; ++ai)
#pragma unroll
        for (int m = 0; m < 4; ++m) {
            bf16_t* rowp = base + (size_t)(row0 + ai * HALF + m * 16) * ldc + col0;
#pragma unroll
            for (int bj = 0; bj < 2; ++bj) {
                const f32x4 v0 = acc[ai][bj][m][0], v1 = acc[ai][bj][m][1];
                u32x4 w; w.x = cvt_pk_bf16(v0[0], v0[1]); w.y = cvt_pk_bf16(v0[2], v0[3]); w.z = cvt_pk_bf16(v1[0], v1[1]); w.w = cvt_pk_bf16(v1[2], v1[3]);
                *(u32x4*)(rowp + bj * HALF) = w;
            }
        }
}
struct EpiIn1 {
    static constexpr bool PERM = true;
    bf16_t* QKV; bf16_t* MB; float* BA;
    __device__ __forceinline__ void operator()(const Acc& acc, const Unit& u, int wr, int wc, int fr, int fq) const {
        const int row0 = u.pm * BM + wr * 64 + fr, pn = u.pn;
        if (pn < 48) {
            bf16_t* base; int ldc, colt;
            if (pn < 24) { base = QKV; ldc = 6144; colt = pn * 256; }
            else { const int t = (pn - 24) >> 3; base = MB + (size_t)t * M_ * D_; ldc = 2048; colt = ((pn - 24) & 7) * 256; }
            store_bf16_tile(acc, base, ldc, row0, colt + wc * 32 + 8 * fq);
        } else if (wc == 0) {
#pragma unroll
            for (int ai = 0; ai < 2; ++ai)
#pragma unroll
                for (int m = 0; m < 4; ++m) { float* pp = BA + (size_t)(row0 + ai * HALF + m * 16) * 32 + 8 * fq; *(f32x4*)pp = acc[ai][0][m][0]; *(f32x4*)(pp + 4) = acc[ai][0][m][1]; }
        }
    }
};
struct EpiIn2 {
    static constexpr bool PERM = true;
    bf16_t* QKV; bf16_t* MBK;
    __device__ __forceinline__ void operator()(const Acc& acc, const Unit& u, int wr, int wc, int fr, int fq) const {
        const int row0 = u.pm * BM + wr * 64 + fr, pn = u.pn;
        bf16_t* base; int ldc, colt;
        if (pn < 16) { base = QKV; ldc = 6144; colt = pn * 256; }
        else { base = MBK; ldc = 2048; colt = (pn - 16) * 256; }
        store_bf16_tile(acc, base, ldc, row0, colt + wc * 32 + 8 * fq);
    }
};
struct EpiProjA {
    static constexpr bool PERM = true;
    const bf16_t* GA; int ldga; bf16_t* Tm;
    __device__ __forceinline__ void operator()(const Acc& acc, const Unit& u, int wr, int wc, int fr, int fq) const {
        const int row0 = u.pm * BM + wr * 64 + fr, col0 = u.pn * BM + wc * 32 + 8 * fq;
#pragma unroll
        for (int ai = 0; ai < 2; ++ai) {
            u32x4 ga[4][2];
#pragma unroll
            for (int m = 0; m < 4; ++m)
#pragma unroll
                for (int bj = 0; bj < 2; ++bj) ga[m][bj] = *(const u32x4*)(GA + (size_t)(row0 + ai * HALF + m * 16) * ldga + col0 + bj * HALF);
#pragma unroll
            for (int m = 0; m < 4; ++m)
#pragma unroll
                for (int bj = 0; bj < 2; ++bj) {
                    u32x4 w;
#pragma unroll
                    for (int e = 0; e < 4; ++e) {
                        const float s0 = sigmoidf_(bflo(ga[m][bj][e])), s1 = sigmoidf_(bfhi(ga[m][bj][e]));
                        w[e] = cvt_pk_bf16(acc[ai][bj][m][e >> 1][(e & 1) * 2] * s0, acc[ai][bj][m][e >> 1][(e & 1) * 2 + 1] * s1);
                    }
                    *(u32x4*)(Tm + (size_t)(row0 + ai * HALF + m * 16) * D_ + col0 + bj * HALF) = w;
                }
        }
    }
};
struct EpiProjB {
    static constexpr bool PERM = true;
    const bf16_t* GB; int ldgb; const bf16_t* Tm; bf16_t* O;
    __device__ __forceinline__ void operator()(const Acc& acc, const Unit& u, int wr, int wc, int fr, int fq) const {
        const int row0 = u.pm * BM + wr * 64 + fr, col0 = u.pn * BM + wc * 32 + 8 * fq;
#pragma unroll
        for (int ai = 0; ai < 2; ++ai) {
            u32x4 gb[4][2], tv[4][2];
#pragma unroll
            for (int m = 0; m < 4; ++m)
#pragma unroll
                for (int bj = 0; bj < 2; ++bj) { const size_t row = (size_t)(row0 + ai * HALF + m * 16);
                    gb[m][bj] = *(const u32x4*)(GB + row * ldgb + col0 + bj * HALF); tv[m][bj] = *(const u32x4*)(Tm + row * D_ + col0 + bj * HALF); }
#pragma unroll
            for (int m = 0; m < 4; ++m)
#pragma unroll
                for (int bj = 0; bj < 2; ++bj) {
                    u32x4 w;
#pragma unroll
                    for (int e = 0; e < 4; ++e) {
                        const float s0 = sigmoidf_(bflo(gb[m][bj][e])), s1 = sigmoidf_(bfhi(gb[m][bj][e]));
                        w[e] = cvt_pk_bf16(bflo(tv[m][bj][e]) + acc[ai][bj][m][e >> 1][(e & 1) * 2] * s0, bfhi(tv[m][bj][e]) + acc[ai][bj][m][e >> 1][(e & 1) * 2 + 1] * s1);
                    }
                    *(u32x4*)(O + (size_t)(row0 + ai * HALF + m * 16) * D_ + col0 + bj * HALF) = w;
                }
        }
    }
};

template <class Epi>
__device__ __forceinline__ void gemm_phase(LAS unsigned char* lds, const Gemm g, const StaticOrder& S, const Epi& E) {
    const int tid = tid_opaque(), wid = __builtin_amdgcn_readfirstlane(tid >> 6), lane = tid & 63, wr = wid >> 2, wc = wid & 3, fr = lane & 15, fq = lane >> 4;
    const int K = g.K, nt = K / BK;
    unsigned voffA[2], voffB[2];
#pragma unroll
    for (int i = 0; i < 2; ++i) { int R, C; stage_rc(tid * 16 + i * 8192, R, C); const int Rb = Epi::PERM ? ((R & ~31) + perm32(R & 31)) : R;
        voffA[i] = (unsigned)(R * g.lda + C) * 2u; voffB[i] = (unsigned)(Rb * K + C) * 2u; }
    const size_t kstep = (size_t)(BK * 2);
    const size_t hstepA = (size_t)HALF * g.lda * 2, hstepB = (size_t)HALF * K * 2;
    const unsigned ldsw = (unsigned)wid * 1024u;
    const int aoff = lds_byte(wr * 64 + fr, fq * 8), boff = lds_byte(wc * 32 + fr, fq * 8);
#define PG8_SA(b, h) (((b) * 2 + (h)) * HTB)
#define PG8_SB(b, h) ((4 + (b) * 2 + (h)) * HTB)
#define PG8_STAGE_B(bufoff, gbase) do { _Pragma("unroll") for (int _i = 0; _i < 2; ++_i) \
        __builtin_amdgcn_global_load_lds((const unsigned*)((const char*)(gbase) + voffB[_i]), (LAS unsigned*)(lds + (bufoff) + ldsw + _i * 8192), 16, 0, 0); } while (0)
#define PG8_STAGE_A(bufoff, gbase, second) do { _Pragma("unroll") for (int _i = 0; _i < 2; ++_i) \
        __builtin_amdgcn_global_load_lds((const unsigned*)((const char*)(gbase) + voffA[_i]), (LAS unsigned*)(lds + (bufoff) + ldsw + _i * 8192), 16, 0, 0); } while (0)
#define PG8_LDA(dst, b, h) do { _Pragma("unroll") for (int m = 0; m < 4; ++m) _Pragma("unroll") for (int k = 0; k < 2; ++k) dst[m][k] = *(const LAS bf16x8*)(lds + PG8_SA(b, h) + aoff + m * 2048 + k * 1024); } while (0)
#define PG8_LDB(dst, b, h) do { _Pragma("unroll") for (int n = 0; n < 2; ++n) _Pragma("unroll") for (int k = 0; k < 2; ++k) dst[n][k] = *(const LAS bf16x8*)(lds + PG8_SB(b, h) + boff + n * 2048 + k * 1024); } while (0)
#define PG8_MMA(ai, bj, At, Bt) do { __builtin_amdgcn_s_setprio(1); _Pragma("unroll") for (int m = 0; m < 4; ++m) _Pragma("unroll") for (int n = 0; n < 2; ++n) _Pragma("unroll") for (int k = 0; k < 2; ++k) \
        acc[ai][bj][m][n] = __builtin_amdgcn_mfma_f32_16x16x32_bf16(Bt[n][k], At[m][k], acc[ai][bj][m][n], 0, 0, 0); __builtin_amdgcn_s_setprio(0); } while (0)
#define PG8_WAIT_V(n) asm volatile("s_waitcnt vmcnt(" #n ")" ::: "memory")
#define PG8_WAIT_L(n) asm volatile("s_waitcnt lgkmcnt(" #n ")" ::: "memory")
#define PG8_BAR __builtin_amdgcn_s_barrier()
#define PG8_SCHED __builtin_amdgcn_sched_barrier(0)
    Unit cur, nxt; int ui = 0;
    if (!S.next(0, cur)) return;
    Acc acc;
#pragma unroll
    for (int a = 0; a < 2; ++a)
#pragma unroll
        for (int b = 0; b < 2; ++b)
#pragma unroll
            for (int m = 0; m < 4; ++m)
#pragma unroll
                for (int n = 0; n < 2; ++n) acc[a][b][m][n] = (f32x4){0.f, 0.f, 0.f, 0.f};
    bf16x8 At[4][2], B0[2][2], B1[2][2];
    const char* cA = (const char*)g.A + (size_t)cur.pm * 2 * hstepA; const char* cB = (const char*)g.Bt + (size_t)cur.pn * 2 * hstepB;
    PG8_STAGE_B(PG8_SB(0, 0), cB); PG8_STAGE_B(PG8_SB(0, 1), cB + hstepB); PG8_STAGE_A(PG8_SA(0, 0), cA, false); PG8_STAGE_A(PG8_SA(0, 1), cA + hstepA, false);
    if (wr == 1) PG8_BAR;
    PG8_WAIT_V(2); PG8_BAR;
    PG8_STAGE_B(PG8_SB(1, 0), cB + kstep); PG8_STAGE_A(PG8_SA(1, 0), cA + kstep, false); PG8_STAGE_B(PG8_SB(1, 1), cB + hstepB + kstep);
    PG8_WAIT_V(6); PG8_BAR;
    for (;;) {
        const bool has_next = S.next(ui + 1, nxt);
        const char* nA = has_next ? (const char*)g.A + (size_t)nxt.pm * 2 * hstepA : cA; const char* nB = has_next ? (const char*)g.Bt + (size_t)nxt.pn * 2 * hstepB : cB;
        for (int t = 0; t < nt; t += 2) {
            const bool last = (t == nt - 2);
            const char* a1 = cA + (size_t)(t + 1) * kstep;
            const char* a2 = last ? nA : cA + (size_t)(t + 2) * kstep; const char* a3 = a2 + kstep;
            const size_t h1 = hstepA, h2 = hstepA;
            const char* b2 = last ? nB : cB + (size_t)(t + 2) * kstep; const char* b3 = b2 + kstep;
            PG8_LDB(B0, 0, 0); PG8_LDB(B1, 0, 1); PG8_SCHED; PG8_LDA(At, 0, 0); PG8_STAGE_A(PG8_SA(1, 1), a1 + h1, false);
            PG8_WAIT_V(8); PG8_WAIT_L(0); PG8_BAR; PG8_MMA(0, 0, At, B0); PG8_MMA(0, 1, At, B1); PG8_BAR; PG8_SCHED;
            PG8_LDA(At, 0, 1); PG8_STAGE_B(PG8_SB(0, 0), b2); PG8_STAGE_B(PG8_SB(0, 1), b2 + hstepB); PG8_STAGE_A(PG8_SA(0, 0), a2, false);
            PG8_WAIT_V(8); PG8_WAIT_L(0); PG8_BAR; PG8_MMA(1, 0, At, B0); PG8_MMA(1, 1, At, B1); PG8_BAR; PG8_SCHED;
            PG8_LDB(B0, 1, 0); PG8_LDB(B1, 1, 1); PG8_SCHED; PG8_LDA(At, 1, 0); PG8_STAGE_A(PG8_SA(0, 1), a2 + h2, false);
            PG8_WAIT_V(8); PG8_WAIT_L(0); PG8_BAR; PG8_MMA(0, 0, At, B0); PG8_MMA(0, 1, At, B1); PG8_BAR; PG8_SCHED;
            PG8_LDA(At, 1, 1); PG8_STAGE_B(PG8_SB(1, 0), b3); PG8_STAGE_B(PG8_SB(1, 1), b3 + hstepB); PG8_STAGE_A(PG8_SA(1, 0), a3, false);
            PG8_WAIT_V(8); PG8_WAIT_L(0); PG8_BAR; PG8_MMA(1, 0, At, B0); PG8_MMA(1, 1, At, B1); PG8_BAR; PG8_SCHED;
        }
        if (wr == 0) PG8_BAR;
        E(acc, cur, wr, wc, fr, fq);
        if (!has_next) break;
#pragma unroll
        for (int a = 0; a < 2; ++a)
#pragma unroll
            for (int b = 0; b < 2; ++b)
#pragma unroll
                for (int m = 0; m < 4; ++m)
#pragma unroll
                    for (int n = 0; n < 2; ++n) acc[a][b][m][n] = (f32x4){0.f, 0.f, 0.f, 0.f};
        cur = nxt; cA = nA; cB = nB; ++ui;
        if (wr == 1) PG8_BAR;
    }
    PG8_WAIT_V(0);
    PG8_BAR;
#undef PG8_SA
#undef PG8_SB
#undef PG8_STAGE_A
#undef PG8_STAGE_B
#undef PG8_LDA
#undef PG8_LDB
#undef PG8_MMA
#undef PG8_WAIT_V
#undef PG8_WAIT_L
#undef PG8_BAR
#undef PG8_SCHED
}
}

__device__ __forceinline__ void tr_item(const float* __restrict__ W, int N, int k0, int n0, bf16_t* dst, int ldd, LAS float* scr, int lane) {
#pragma unroll 8
    for (int i = 0; i < 32; ++i) { const int kk = 2 * i + (lane >> 5); scr[kk * 33 + (lane & 31)] = W[(size_t)(k0 + kk) * N + n0 + (lane & 31)]; }
    LDS_WAIT();
    const int c = lane & 7;
#pragma unroll
    for (int j = 0; j < 4; ++j) { const int n = (lane >> 3) + 8 * j; const LAS float* s = scr + (8 * c) * 33 + n;
        u32x4 o; o.x = cvt_pk_bf16(s[0 * 33], s[1 * 33]); o.y = cvt_pk_bf16(s[2 * 33], s[3 * 33]); o.z = cvt_pk_bf16(s[4 * 33], s[5 * 33]); o.w = cvt_pk_bf16(s[6 * 33], s[7 * 33]);
        *(u32x4*)(dst + (size_t)n * ldd + 8 * c) = o; }
    LDS_WAIT();
}
__device__ __forceinline__ void convert_ffn(const float* w1, const float* w3, const float* w2, bf16_t* W13, bf16_t* W2, LAS float* scr, int gw, int NGW, int lane) {
    constexpr int I_UP = 32 * 176, I_DN = 88 * 64;
    for (int it = gw; it < 2 * I_UP + I_DN; it += NGW) {
        int r = it;
        if (r < 2 * I_UP) { const int which = r >= I_UP; if (which) r -= I_UP; const int kb = r / 176, nb = r % 176, n0 = nb * 32;
            tr_item(which ? w3 : w1, FF_, kb * 64, n0, W13 + (size_t)((n0 >> 7) * 256 + which * 128 + (n0 & 127)) * 2048 + kb * 64, 2048, scr, lane); }
        else { r -= 2 * I_UP; const int kb = r / 64, nb = r % 64; tr_item(w2, D_, kb * 64, nb * 32, W2 + (size_t)(nb * 32) * FF_ + kb * 64, FF_, scr, lane); }
    }
}
__device__ __forceinline__ void convert_mixer(const Params& p, LAS float* scr, int gw, int NGW, int lane) {
    bf16_t* WIN1 = (bf16_t*)(p.ws + WS_WIN1); bf16_t* WIN2 = (bf16_t*)(p.ws + WS_WIN2); bf16_t* WPAB = (bf16_t*)(p.ws + WS_WPAB); bf16_t* WOUT = (bf16_t*)(p.ws + WS_WOUT);
    constexpr int I_IN = 32 * 577, I_P = 32 * 64;
    for (int it = gw; it < I_IN + 3 * I_P; it += NGW) {
        int r = it;
        if (r < I_IN) { const int kb = r / 577, nb = r % 577, n0 = nb * 32; bf16_t* dst; int drow;
            if (n0 < 6144) { dst = WIN1; drow = n0; }
            else if (n0 < 8192) { dst = WIN2; drow = n0 - 6144; }
            else if (n0 < 8224) { dst = WIN1; drow = 12288 + (n0 - 8192); }
            else if (n0 < 10272) { dst = WIN1; drow = 6144 + (n0 - 8224); }
            else if (n0 < 12320) { dst = WIN1; drow = 8192 + (n0 - 10272); }
            else if (n0 < 14368) { dst = WIN1; drow = 10240 + (n0 - 12320); }
            else if (n0 < 16416) { dst = WIN2; drow = 2048 + (n0 - 14368); }
            else { dst = WIN2; drow = 4096 + (n0 - 16416); }
            tr_item(p.w_in, 18464, kb * 64, n0, dst + (size_t)drow * 2048 + kb * 64, 2048, scr, lane); continue; }
        r -= I_IN;
        const int which = r / I_P; r -= which * I_P; const int kb = r / 64, nb = r % 64;
        if (which == 0) tr_item(p.wpa, D_, kb * 64, nb * 32, WPAB + (size_t)(nb * 32) * 2048 + kb * 64, 2048, scr, lane);
        else if (which == 1) tr_item(p.wpb, D_, kb * 64, nb * 32, WPAB + (size_t)2048 * 2048 + (size_t)(nb * 32) * 2048 + kb * 64, 2048, scr, lane);
        else tr_item(p.wout, D_, kb * 64, nb * 32, WOUT + (size_t)(nb * 32) * 2048 + kb * 64, 2048, scr, lane);
    }
}

__device__ __forceinline__ void phase0(const Params& p, LAS unsigned char* lds) {
    const int tid = tid_opaque(), lane = tid & 63, wave = tid >> 6;
    const int gw = blockIdx.x * 8 + wave, NGW = gridDim.x * 8;
    const int gt = blockIdx.x * 512 + tid, NGT = gridDim.x * 512;
    {
        LAS float* sil = (LAS float*)lds;
        float* ADAP = (float*)(p.ws + WS_ADAP);
        for (int item = blockIdx.x; item < 9 * 32; item += gridDim.x) {
            const int cb = item % 9, ks = item / 9;
            if (tid < 256) { const int b = tid >> 6, kk = tid & 63; sil[tid] = siluf_(p.c[b * D_ + ks * 64 + kk]); }
            __syncthreads();
            const int col = cb * 2048 + tid * 4;
            f32x4 a0 = {0, 0, 0, 0}, a1 = a0, a2 = a0, a3 = a0;
#pragma unroll 4
            for (int kk = 0; kk < 64; ++kk) { const f32x4 w = *(const f32x4*)(p.ada_w + (size_t)(ks * 64 + kk) * NADA + col);
                a0 += sil[kk] * w; a1 += sil[64 + kk] * w; a2 += sil[128 + kk] * w; a3 += sil[192 + kk] * w; }
            *(f32x4*)(ADAP + (size_t)(ks * 4 + 0) * NADA + col) = a0; *(f32x4*)(ADAP + (size_t)(ks * 4 + 1) * NADA + col) = a1;
            *(f32x4*)(ADAP + (size_t)(ks * 4 + 2) * NADA + col) = a2; *(f32x4*)(ADAP + (size_t)(ks * 4 + 3) * NADA + col) = a3;
            __syncthreads();
        }
    }
    LAS float* scr = (LAS float*)(lds + wave * 8448);
    convert_ffn(p.f1w1, p.f1w3, p.f1w2, (bf16_t*)(p.ws + WS_W13), (bf16_t*)(p.ws + WS_W2), scr, gw, NGW, lane);
    convert_mixer(p, scr, gw, NGW, lane);
    { u32x4* z = (u32x4*)(p.ws + WS_WIN1 + (size_t)12320 * 2048 * 2); for (int i = gt; i < 224 * 2048 * 2 / 16; i += NGT) z[i] = (u32x4){0u, 0u, 0u, 0u}; }
    { float* BT = (float*)(p.ws + WS_BT);
      for (int i = gt; i < 16 * 4096; i += NGT) { const int h = i >> 12, d = i & 4095; int bucket;
          if (d < 16) bucket = d; else { const double dd = (double)d, d2 = dd * dd, d4 = d2 * d2, d8 = d4 * d4; int k = 0; double thr = 34359738368.0  ;
              for (int q = 1; q <= 15; ++q) { if (d8 >= thr) k = q; thr *= 8.0; } bucket = 16 + k; if (bucket > 31) bucket = 31; }
          BT[i] = p.rel_bias[bucket * 16 + h] * LOG2E; } }
}
__device__ __forceinline__ void phase_ada_reduce(const Params& p) {
    const int gt = blockIdx.x * 512 + tid_opaque(), NGT = gridDim.x * 512;
    const float* ADAP = (const float*)(p.ws + WS_ADAP); float* ada = (float*)(p.ws + WS_ADA);
    for (int i = gt; i < 4 * NADA; i += NGT) { const int b = i / NADA, n = i - b * NADA; float s = p.ada_b[n];
        for (int ks = 0; ks < 32; ++ks) s += ADAP[(size_t)(ks * 4 + b) * NADA + n];
        ada[i] = s; }
}
__device__ __forceinline__ void phase_normmod(const float* src, const float* gain, const float* ada, int shoff, int scoff, bf16_t* dst) {
    const int tid_ = tid_opaque(); const int lane = tid_ & 63, wave = tid_ >> 6;
    const int gw = blockIdx.x * 8 + wave, NGW = gridDim.x * 8;
    for (int m = gw; m < M_; m += NGW) {
        const f32x4* xr = (const f32x4*)(src + (size_t)m * D_) + lane;
        f32x4 v[8]; float ss = 0.f;
#pragma unroll
        for (int j = 0; j < 8; ++j) { v[j] = xr[64 * j]; ss += (v[j][0] * v[j][0] + v[j][1] * v[j][1]) + (v[j][2] * v[j][2] + v[j][3] * v[j][3]); }
        ss = wave_sum(ss);
        const float rstd = rsqrtf(ss * (1.0f / D_) + 1e-6f);
        const float* ab = ada + (size_t)(m >> 12) * NADA;
#pragma unroll
        for (int j = 0; j < 8; ++j) { const int col = 4 * (lane + 64 * j);
            const f32x4 g = *(const f32x4*)(gain + col), sh = *(const f32x4*)(ab + shoff + col), sc = *(const f32x4*)(ab + scoff + col);
            const f32x4 y = v[j] * rstd * g * (sc + 1.0f) + sh;
            u32x2 w; w.x = cvt_pk_bf16(y[0], y[1]); w.y = cvt_pk_bf16(y[2], y[3]);
            *(u32x2*)(dst + (size_t)m * D_ + col) = w; }
    }
}
__device__ __forceinline__ void phase_halo(const Params& p) {
    const int tid_ = tid_opaque(); const int lane = tid_ & 63, wave = tid_ >> 6;
    const int gw = blockIdx.x * 8 + wave, NGW = gridDim.x * 8;
    const bf16_t* QKV = (const bf16_t*)(p.ws + WS_QKV); bf16_t* HALO = (bf16_t*)(p.ws + WS_HALO);
    for (int r = gw; r < 4 * 16 * 3; r += NGW) {
        const int j = r % 3, tile = (r / 3) & 15, b = r / 48;
        u32x4* d = (u32x4*)(HALO + (size_t)r * 6144);
        if (tile == 0) { for (int i = lane; i < 768; i += 64) d[i] = (u32x4){0u, 0u, 0u, 0u}; }
        else { const u32x4* s = (const u32x4*)(QKV + ((size_t)b * T_ + tile * 256 - 3 + j) * 6144); for (int i = lane; i < 768; i += 64) d[i] = s[i]; }
    }
}
__device__ __forceinline__ void unpack8(const u32x4 w, float* f) {
#pragma unroll
    for (int e = 0; e < 4; ++e) { f[2 * e] = bflo(w[e]); f[2 * e + 1] = bfhi(w[e]); }
}
__device__ __forceinline__ void phase_postproc(const Params& p, LAS unsigned char* lds) {
    const int tid = tid_opaque(), ti = tid >> 3, cg8 = tid & 7, lane = tid & 63, wave = tid >> 6;
    bf16_t* QKV = (bf16_t*)(p.ws + WS_QKV); const bf16_t* HALO = (const bf16_t*)(p.ws + WS_HALO); bf16_t* MB = (bf16_t*)(p.ws + WS_MB); float* BA = (float*)(p.ws + WS_BA);
    float* KM = (float*)(p.ws + WS_KMEAN);
    for (int item = blockIdx.x; item < 4 * 16 * 48; item += gridDim.x) {
        const int s = item % 48, tile = (item / 48) & 15, b = item / 768;
        const int c0 = s * 128 + cg8 * 16; const size_t row0 = (size_t)b * T_ + tile * 256 + ti * 4;
        u32x4 xr[7][2];
#pragma unroll
        for (int j = 0; j < 7; ++j) {
            const bf16_t* src = (ti > 0 || j >= 3) ? QKV + (row0 - 3 + j) * 6144 + c0 : HALO + ((size_t)((b * 16 + tile) * 3) + j) * 6144 + c0;
            xr[j][0] = *(const u32x4*)src; xr[j][1] = *(const u32x4*)(src + 8);
        }
        f32x4 w[4][4];
#pragma unroll
        for (int j = 0; j < 4; ++j)
#pragma unroll
            for (int q = 0; q < 4; ++q) w[j][q] = *(const f32x4*)(p.conv_w + j * 6144 + c0 + 4 * q);
        u32x4 o[4][2];
#pragma unroll
        for (int r = 0; r < 4; ++r) {
            float y[16];
#pragma unroll
            for (int i = 0; i < 16; ++i) y[i] = 0.f;
#pragma unroll
            for (int j = 0; j < 4; ++j) { float xf[16]; unpack8(xr[r + j][0], xf); unpack8(xr[r + j][1], xf + 8);
#pragma unroll
                for (int q = 0; q < 4; ++q)
#pragma unroll
                    for (int e = 0; e < 4; ++e) y[4 * q + e] += w[j][q][e] * xf[4 * q + e]; }
            float ss = 0.f;
#pragma unroll
            for (int i = 0; i < 16; ++i) { y[i] = siluf_(y[i]); ss += y[i] * y[i]; }
            ss += __shfl_xor(ss, 1); ss += __shfl_xor(ss, 2); ss += __shfl_xor(ss, 4);
            float sc = 1.0f;
            if (s < 32) { sc = rsqrtf(ss + 1e-6f); if (s < 16) sc *= QSCALE; }
#pragma unroll
            for (int e = 0; e < 4; ++e) { o[r][0][e] = cvt_pk_bf16(y[2 * e] * sc, y[2 * e + 1] * sc); o[r][1][e] = cvt_pk_bf16(y[8 + 2 * e] * sc, y[8 + 2 * e + 1] * sc); }
        }
        __syncthreads();
#pragma unroll
        for (int r = 0; r < 4; ++r) { bf16_t* dp = QKV + (row0 + r) * 6144 + c0; *(u32x4*)dp = o[r][0]; *(u32x4*)(dp + 8) = o[r][1]; }
    }
    LAS float* red = (LAS float*)lds;
    for (int item = blockIdx.x; item < 4 * 16 * 32; item += gridDim.x) {
        const int hh = item & 31, tile = (item >> 5) & 15, b = item >> 9; const int which = hh >> 4, h = hh & 15;
        bf16_t* dp = MB + (size_t)which * M_ * D_ + ((size_t)b * T_ + tile * 256 + ti * 4) * D_ + h * 128 + cg8 * 16;
        u32x4 xr[4][2];
#pragma unroll
        for (int r = 0; r < 4; ++r) { xr[r][0] = *(const u32x4*)(dp + (size_t)r * D_); xr[r][1] = *(const u32x4*)(dp + (size_t)r * D_ + 8); }
        const float* gp = (which == 0 ? p.qn_g : p.kn_g) + cg8 * 16;
        float gn[16];
#pragma unroll
        for (int i = 0; i < 16; ++i) gn[i] = gp[i] * (which == 0 ? QSCALE * LOG2E : 1.0f);
        float ks[16];
#pragma unroll
        for (int i = 0; i < 16; ++i) ks[i] = 0.f;
#pragma unroll
        for (int r = 0; r < 4; ++r) {
            float xf[16]; unpack8(xr[r][0], xf); unpack8(xr[r][1], xf + 8);
            float ss = 0.f;
#pragma unroll
            for (int i = 0; i < 16; ++i) ss += xf[i] * xf[i];
            ss += __shfl_xor(ss, 1); ss += __shfl_xor(ss, 2); ss += __shfl_xor(ss, 4);
            const float rs = rsqrtf(ss * (1.0f / 128.0f) + 1e-6f);
            u32x4 o0, o1;
#pragma unroll
            for (int i = 0; i < 16; ++i) { xf[i] = xf[i] * rs * gn[i]; ks[i] += xf[i]; }
#pragma unroll
            for (int e = 0; e < 4; ++e) { o0[e] = cvt_pk_bf16(xf[2 * e], xf[2 * e + 1]); o1[e] = cvt_pk_bf16(xf[8 + 2 * e], xf[8 + 2 * e + 1]); }
            *(u32x4*)(dp + (size_t)r * D_) = o0; *(u32x4*)(dp + (size_t)r * D_ + 8) = o1;
        }
        if (which == 1) {
#pragma unroll
            for (int i = 0; i < 16; ++i) { float v = ks[i]; v += __shfl_xor(v, 8); v += __shfl_xor(v, 16); v += __shfl_xor(v, 32); ks[i] = v; }
            if (lane < 8) {
#pragma unroll
                for (int i = 0; i < 16; ++i) red[wave * 128 + lane * 16 + i] = ks[i]; }
            __syncthreads();
            if (tid < 128) { float t = 0.f;
#pragma unroll
                for (int w8 = 0; w8 < 8; ++w8) t += red[w8 * 128 + tid];
                KM[((size_t)((b * 16 + h) * 16 + tile)) * 128 + tid] = t * (1.0f / 256.0f); }
            __syncthreads();
        }
    }
    {
        const int gt = blockIdx.x * 512 + tid, NGT = gridDim.x * 512;
        for (int i = gt; i < M_ * 16; i += NGT) { const int h = i & 15; const size_t r = (size_t)(i >> 4) * 32;
            const float bv = BA[r + h], av = BA[r + 16 + h] + p.dt_bias[h];
            const float sp = fmaxf(av, 0.f) + log1pf(expf(-fabsf(av)));
            BA[r + h] = 1.0f / (1.0f + expf(-bv)); BA[r + 16 + h] = -expf(p.a_log[h]) * sp; }
    }
}

typedef float f32x16 __attribute__((ext_vector_type(16)));
__device__ __forceinline__ unsigned pkbf(float a, float b) { return cvt_pk_bf16(a, b); }
#define MFMA32(a, b, c) __builtin_amdgcn_mfma_f32_32x32x16_bf16((a), (b), (c), 0, 0, 0)
template <int OFF, int ROWQ, int COLT> __device__ __forceinline__ void tr8(unsigned addr, u32x2 (&v)[8]) {
    asm volatile(
        "ds_read_b64_tr_b16 %0, %8 offset:%9\n\t"
        "ds_read_b64_tr_b16 %1, %8 offset:%10\n\t"
        "ds_read_b64_tr_b16 %2, %8 offset:%11\n\t"
        "ds_read_b64_tr_b16 %3, %8 offset:%12\n\t"
        "ds_read_b64_tr_b16 %4, %8 offset:%13\n\t"
        "ds_read_b64_tr_b16 %5, %8 offset:%14\n\t"
        "ds_read_b64_tr_b16 %6, %8 offset:%15\n\t"
        "ds_read_b64_tr_b16 %7, %8 offset:%16\n\t"
        "s_waitcnt lgkmcnt(0)"
        : "=&v"(v[0]), "=&v"(v[1]), "=&v"(v[2]), "=&v"(v[3]), "=&v"(v[4]), "=&v"(v[5]), "=&v"(v[6]), "=&v"(v[7])
        : "v"(addr), "n"(OFF), "n"(OFF + ROWQ), "n"(OFF + COLT), "n"(OFF + COLT + ROWQ), "n"(OFF + 2 * COLT), "n"(OFF + 2 * COLT + ROWQ), "n"(OFF + 3 * COLT), "n"(OFF + 3 * COLT + ROWQ)
        : "memory");
}
__device__ __forceinline__ bf16x8 frag2(const u32x2 a, const u32x2 b) { u32x4 w = {a.x, a.y, b.x, b.y}; return __builtin_bit_cast(bf16x8, w); }
__device__ __forceinline__ bf16x8 pack8(const f32x16& x, int s) {
    u32x4 w = {pkbf(x[8 * s], x[8 * s + 1]), pkbf(x[8 * s + 2], x[8 * s + 3]), pkbf(x[8 * s + 4], x[8 * s + 5]), pkbf(x[8 * s + 6], x[8 * s + 7])};
    return __builtin_bit_cast(bf16x8, w);
}

__device__ __forceinline__ void phase_moba_mfma(const Params& p, LAS unsigned char* lds, unsigned lds_base) {
    constexpr int KST = 272, VST = 320;
    constexpr int OFF_K = 0, OFF_V = 2 * 64 * KST, OFF_KM = OFF_V + 2 * 64 * VST, OFF_BT = OFF_KM + 32 * KST, OFF_UM = OFF_BT + 4096;
    const int tid = tid_opaque(), lane = tid & 63, wave = __builtin_amdgcn_readfirstlane(tid >> 6);
    const int i32 = lane & 31, hh = lane >> 5;
    bf16_t* MBQ = (bf16_t*)(p.ws + WS_MB); const bf16_t* MBK = MBQ + (size_t)M_ * D_; const bf16_t* MBV = MBK + (size_t)M_ * D_;
    const float* KM = (const float*)(p.ws + WS_KMEAN); const float* BT = (const float*)(p.ws + WS_BT);
    const int G = gridDim.x, cblk = blockIdx.x;
    const int lrow = tid >> 3, lc = tid & 7;
    const unsigned vbase = lds_base + OFF_V + (4 * hh + ((lane & 15) >> 2)) * VST + (16 * ((lane >> 4) & 1) + 4 * (lane & 3)) * 2;
    const float NINF = -__builtin_inff();
    for (int k = 0;; ++k) {
        const int it = k * G + ((k & 1) ? (G - 1 - cblk) : cblk);
        if (it >= 1024) break;
        const int qb = 15 - (it >> 6), bh = it & 63, b = bh >> 4, h = bh & 15;
        const size_t rowb = (size_t)b * T_;
        __syncthreads();
        { const int r = tid >> 5, c4 = (tid & 31) * 4; const f32x4 kv = *(const f32x4*)(KM + ((size_t)(bh * 16 + r)) * 128 + c4);
          u32x2 w = {pkbf(kv[0], kv[1]), pkbf(kv[2], kv[3])}; *(LAS u32x2*)(lds + OFF_KM + r * KST + c4 * 2) = w; *(LAS u32x2*)(lds + OFF_KM + (r + 16) * KST + c4 * 2) = (u32x2){0u, 0u}; }
        { LAS float* bts = (LAS float*)(lds + OFF_BT); bts[tid] = BT[h * 4096 + tid]; bts[tid + 512] = BT[h * 4096 + tid + 512]; }
        const float c31 = BT[h * 4096 + 1023];
        const int q0 = qb * 256 + 32 * wave;
        bf16_t* qptr = MBQ + (rowb + q0 + i32) * D_ + h * 128;
        bf16x8 qf[8];
#pragma unroll
        for (int kc = 0; kc < 8; ++kc) qf[kc] = *(const bf16x8*)(qptr + 16 * kc + 8 * hh);
        __syncthreads();
        unsigned sel = 0;
        {
            f32x16 g;
#pragma unroll
            for (int r = 0; r < 16; ++r) g[r] = 0.f;
#pragma unroll
            for (int kc = 0; kc < 8; ++kc) { const bf16x8 a = *(const LAS bf16x8*)(lds + OFF_KM + i32 * KST + (16 * kc + 8 * hh) * 2); g = MFMA32(a, qf[kc], g); }
            float gate[16];
#pragma unroll
            for (int j = 0; j < 16; ++j) { const int half = (j >> 2) & 1, r = (j & 3) + 4 * (j >> 3); const float og = __shfl_xor(g[r], 32); gate[j] = (hh == half) ? g[r] : og; }
#pragma unroll
            for (int rep = 0; rep < 3; ++rep) { float best = NINF; int bi = -1;
#pragma unroll
                for (int j = 0; j < 16; ++j) if (j < qb && !((sel >> j) & 1u) && gate[j] > best) { best = gate[j]; bi = j; }
                if (bi >= 0) sel |= 1u << bi; }
        }
        { unsigned wsel = sel;
#pragma unroll
          for (int o = 1; o < 64; o <<= 1) wsel |= (unsigned)__shfl_xor((int)wsel, o);
          if (lane == 0) ((LAS unsigned*)(lds + OFF_UM))[wave] = wsel; }
        __syncthreads();
        unsigned um = 0;
#pragma unroll
        for (int w = 0; w < 8; ++w) um |= ((const LAS unsigned*)(lds + OFF_UM))[w];
        um = __builtin_amdgcn_readfirstlane(um);

        f32x16 O[4];
#pragma unroll
        for (int dt = 0; dt < 4; ++dt)
#pragma unroll
            for (int r = 0; r < 16; ++r) O[dt][r] = 0.f;
        float m = NINF, l = 0.f;
        int j = qb, kt = 0, buf = 0;
        u32x4 rk0, rk1, rv0, rv1;
#define MOBA_LOAD(jj, kk) do { const size_t r_ = (rowb + (jj) * 256 + (kk) * 64 + lrow) * D_ + h * 128 + lc * 16; rk0 = *(const u32x4*)(MBK + r_); rk1 = *(const u32x4*)(MBK + r_ + 8); rv0 = *(const u32x4*)(MBV + r_); rv1 = *(const u32x4*)(MBV + r_ + 8); } while (0)
#define MOBA_STORE(bb) do { LAS unsigned char* kd = lds + OFF_K + (bb) * 64 * KST + lrow * KST + lc * 32; *(LAS u32x4*)kd = rk0; *(LAS u32x4*)(kd + 16) = rk1; \
        LAS unsigned char* vd = lds + OFF_V + (bb) * 64 * VST + lrow * VST + lc * 32; *(LAS u32x4*)vd = rv0; *(LAS u32x4*)(vd + 16) = rv1; } while (0)
        MOBA_LOAD(j, kt); MOBA_STORE(0); __syncthreads();
        while (j >= 0) {
            int nj = j, nkt = kt + 1;
            if (nkt == 4) { nkt = 0; do { --nj; } while (nj >= 0 && !((um >> nj) & 1u)); }
            if (nj >= 0) MOBA_LOAD(nj, nkt);
            const bool own = (j == qb);
            bool need;
            if (own) need = (kt * 64 <= 32 * wave + 31); else need = (__ballot((sel >> j) & 1u) != 0ull);
            if (need) {
                const LAS unsigned char* Ks = lds + OFF_K + buf * 64 * KST + i32 * KST + 16 * hh;
                f32x16 s0, s1;
#pragma unroll
                for (int r = 0; r < 16; ++r) { s0[r] = 0.f; s1[r] = 0.f; }
#pragma unroll
                for (int kc = 0; kc < 8; ++kc) { const bf16x8 a0 = *(const LAS bf16x8*)(Ks + 32 * kc), a1 = *(const LAS bf16x8*)(Ks + 32 * KST + 32 * kc);
                    s0 = MFMA32(a0, qf[kc], s0); s1 = MFMA32(a1, qf[kc], s1); }
                const int tq = q0 + i32, kbase = j * 256 + kt * 64;
                const bool far = (q0 - (kbase + 63)) >= 790;
                const bool diag = own && (kbase + 63 > q0);
                const bool lsel = own || ((sel >> j) & 1u);
                const int db = tq - kbase - 4 * hh;
                if (far) {
#pragma unroll
                    for (int r = 0; r < 16; ++r) { s0[r] += c31; s1[r] += c31; }
                } else {
                    const LAS float* bp = (const LAS float*)(lds + OFF_BT) + db;
                    float b0[16], b1[16];
#pragma unroll
                    for (int r = 0; r < 16; ++r) { b0[r] = bp[-(8 * (r >> 2) + (r & 3))]; b1[r] = bp[-(32 + 8 * (r >> 2) + (r & 3))]; }
#pragma unroll
                    for (int r = 0; r < 16; ++r) { s0[r] += b0[r]; s1[r] += b1[r]; }
                }
                if (diag) {
#pragma unroll
                    for (int r = 0; r < 16; ++r) { const int d0 = db - (8 * (r >> 2) + (r & 3)); if (d0 < 0) s0[r] = NINF; if (d0 < 32) s1[r] = NINF; }
                }
                float mx = NINF;
#pragma unroll
                for (int r = 0; r < 16; ++r) { if (!lsel) { s0[r] = NINF; s1[r] = NINF; } mx = fmaxf(mx, fmaxf(s0[r], s1[r])); }
                mx = fmaxf(mx, __shfl_xor(mx, 32));
                const float mnew = fmaxf(m, mx);
                const float alpha = __builtin_amdgcn_exp2f(m - mnew);
                float ps = 0.f;
#pragma unroll
                for (int r = 0; r < 16; ++r) { s0[r] = __builtin_amdgcn_exp2f(s0[r] - mnew); s1[r] = __builtin_amdgcn_exp2f(s1[r] - mnew); ps += s0[r] + s1[r]; }
                l = l * alpha + ps; m = mnew;
                if (__ballot(alpha != 1.0f) != 0ull) {
#pragma unroll
                    for (int dt = 0; dt < 4; ++dt)
#pragma unroll
                        for (int r = 0; r < 16; ++r) O[dt][r] *= alpha;
                }
                const unsigned va = vbase + buf * 64 * VST;
                u32x2 v[8];
                { const bf16x8 pf = pack8(s0, 0); tr8<0, 8 * VST, 64>(va, v);
#pragma unroll
                  for (int dt = 0; dt < 4; ++dt) O[dt] = MFMA32(frag2(v[2 * dt], v[2 * dt + 1]), pf, O[dt]); }
                { const bf16x8 pf = pack8(s0, 1); tr8<16 * VST, 8 * VST, 64>(va, v);
#pragma unroll
                  for (int dt = 0; dt < 4; ++dt) O[dt] = MFMA32(frag2(v[2 * dt], v[2 * dt + 1]), pf, O[dt]); }
                { const bf16x8 pf = pack8(s1, 0); tr8<32 * VST, 8 * VST, 64>(va, v);
#pragma unroll
                  for (int dt = 0; dt < 4; ++dt) O[dt] = MFMA32(frag2(v[2 * dt], v[2 * dt + 1]), pf, O[dt]); }
                { const bf16x8 pf = pack8(s1, 1); tr8<48 * VST, 8 * VST, 64>(va, v);
#pragma unroll
                  for (int dt = 0; dt < 4; ++dt) O[dt] = MFMA32(frag2(v[2 * dt], v[2 * dt + 1]), pf, O[dt]); }
            }
            if (nj >= 0) MOBA_STORE(buf ^ 1);
            __syncthreads();
            j = nj; kt = nkt; buf ^= 1;
        }
#undef MOBA_LOAD
#undef MOBA_STORE
        l += __shfl_xor(l, 32);
        const float inv = 1.0f / l;
#pragma unroll
        for (int dt = 0; dt < 4; ++dt)
#pragma unroll
            for (int r4 = 0; r4 < 4; ++r4) {
                u32x2 w = {pkbf(O[dt][4 * r4] * inv, O[dt][4 * r4 + 1] * inv), pkbf(O[dt][4 * r4 + 2] * inv, O[dt][4 * r4 + 3] * inv)};
                *(u32x2*)(qptr + 32 * dt + 4 * hh + 8 * r4) = w;
            }
    }
}


#define MFMA16(a, b, c) __builtin_amdgcn_mfma_f32_16x16x32_bf16((a), (b), (c), 0, 0, 0)
__device__ __forceinline__ void phase_dn_local(const Params& p, LAS unsigned char* lds) {
    const int tid = tid_opaque(), lane = tid & 63, wave = __builtin_amdgcn_readfirstlane(tid >> 6), i32 = lane & 31, hh = lane >> 5;
    LAS unsigned char* wl = lds + wave * 18432;
    LAS float* Am = (LAS float*)wl; LAS bf16_t* Tb = (LAS bf16_t*)wl; LAS bf16_t* Tb2 = (LAS bf16_t*)(wl + 8192);
    LAS float* gcs = (LAS float*)(wl + 16384); LAS float* bes = gcs + 64;
    bf16_t* QKV = (bf16_t*)(p.ws + WS_QKV); float* BA = (float*)(p.ws + WS_BA); bf16_t* WDN = (bf16_t*)(p.ws + WS_WDN); bf16_t* QKb = (bf16_t*)(p.ws + WS_QK);
    const int gw = blockIdx.x * 8 + wave, NGW = gridDim.x * 8;
    const unsigned fo6 = (unsigned)(i32 * 6144 + 8 * hh);
    const unsigned go6 = (unsigned)(8 * hh * 6144 + i32);
    const unsigned so6 = (unsigned)(4 * hh * 6144 + i32);
    const unsigned so2 = (unsigned)(4 * hh * D_ + i32);
    const unsigned soq = (unsigned)(4 * hh * 64 + i32);
    for (int ch = gw; ch < 4096; ch += NGW) {
        const int n = ch & 63, bh = ch >> 6, b = bh >> 4, h = bh & 15;
        const size_t r0 = (size_t)b * T_ + n * 64;
        float* bap = BA + r0 * 32 + h;
        const float be = bap[lane * 32];
        float gc = bap[lane * 32 + 16];
        { int ln = lane; asm volatile("" : "+v"(ln));
#pragma unroll
          for (int o = 1; o < 64; o <<= 1) { const float t = __shfl(gc, (ln - o) & 63); if (ln >= o) gc += t; } }
        gcs[lane] = gc; bes[lane] = be;
        bf16_t* kslab = QKV + r0 * 6144 + 2048 + h * 128;
        bf16_t* vslab = QKV + r0 * 6144 + 4096 + h * 128;
        const bf16_t* qslab = QKV + r0 * 6144 + h * 128;
        LDS_WAIT();
        const float gcj0 = gcs[i32], gcj1 = gcs[32 + i32];
        {
            f32x16 a00, a10, a11;
#pragma unroll
            for (int r = 0; r < 16; ++r) { a00[r] = 0.f; a10[r] = 0.f; a11[r] = 0.f; }
#pragma unroll
            for (int kc = 0; kc < 8; ++kc) { const bf16x8 k0 = *(const bf16x8*)(kslab + 16 * kc + fo6), k1 = *(const bf16x8*)(kslab + 32 * 6144 + 16 * kc + fo6);
                a00 = MFMA32(k0, k0, a00); a10 = MFMA32(k1, k0, a10); a11 = MFMA32(k1, k1, a11); }
            const LAS float* gcl = gcs + 4 * hh; const LAS float* bel = bes + 4 * hh; LAS float* aml = Am + soq;
#pragma unroll
            for (int r = 0; r < 16; ++r) {
                const int ic = (r & 3) + 8 * (r >> 2);
                const float gi0 = gcl[ic], gi1 = gcl[32 + ic], bi0 = bel[ic], bi1 = bel[32 + ic];
                aml[ic * 64] = bi0 * a00[r] * __expf(fminf(gi0 - gcj0, 0.f));
                aml[(32 + ic) * 64] = bi1 * a10[r] * __expf(fminf(gi1 - gcj0, 0.f));
                aml[(32 + ic) * 64 + 32] = bi1 * a11[r] * __expf(fminf(gi1 - gcj1, 0.f));
            }
        }
        LDS_WAIT();
        {
            float T[64];
            f32x4 ra[16];
#define DN_LOADROW(i_, buf_) do { _Pragma("unroll") for (int j4 = 0; j4 < ((i_) + 3) / 4; ++j4) buf_[j4] = *(const LAS f32x4*)(Am + (i_) * 64 + 4 * j4); } while (0)
#define DN_ROW(i_, buf_) do { float c0 = 0.f, c1 = 0.f, c2 = 0.f, c3 = 0.f; \
                _Pragma("unroll") for (int j4 = 0; j4 < ((i_) + 3) / 4; ++j4) { \
                    if (4 * j4 + 0 < (i_)) c0 += buf_[j4][0] * T[4 * j4 + 0]; if (4 * j4 + 1 < (i_)) c1 += buf_[j4][1] * T[4 * j4 + 1]; \
                    if (4 * j4 + 2 < (i_)) c2 += buf_[j4][2] * T[4 * j4 + 2]; if (4 * j4 + 3 < (i_)) c3 += buf_[j4][3] * T[4 * j4 + 3]; } \
                T[i_] = ((lane == (i_)) ? 1.0f : 0.0f) - ((c0 + c1) + (c2 + c3)); } while (0)
#pragma unroll
            for (int i = 0; i < 64; ++i) {
                DN_LOADROW(i, ra); asm volatile("" ::: "memory");
                DN_ROW(i, ra);
                asm volatile("" ::: "memory");
            }
#undef DN_LOADROW
#undef DN_ROW
            LDS_WAIT();
            const float eg = __expf(gc);
#pragma unroll
            for (int i = 0; i < 64; ++i) { const float tp = T[i] * be; Tb[i * 64 + lane] = f2bf(tp); Tb2[i * 64 + lane] = f2bf(tp * eg); }
        }
        LDS_WAIT();
#define DN_TMUL(TBUF, SRC, DST, DSTLD, SOFF) do { \
            _Pragma("unroll 1") for (int dt = 0; dt < 4; ++dt) { \
                f32x16 u0, u1; \
                _Pragma("unroll") for (int r = 0; r < 16; ++r) { u0[r] = 0.f; u1[r] = 0.f; } \
                unsigned short rw[4][8]; \
                _Pragma("unroll") for (int jc = 0; jc < 4; ++jc) _Pragma("unroll") for (int e = 0; e < 8; ++e) rw[jc][e] = ((SRC) + (16 * jc + e) * 6144 + 32 * dt)[go6]; \
                __builtin_amdgcn_sched_barrier(0);     \
                _Pragma("unroll") for (int jc = 0; jc < 4; ++jc) { \
                    bf16x8 vb; \
                    _Pragma("unroll") for (int e = 0; e < 8; ++e) vb[e] = (short)rw[jc][e]; \
                    const bf16x8 ta0 = *(const LAS bf16x8*)((const LAS unsigned char*)(TBUF) + ((i32) * 64 + 16 * jc + 8 * hh) * 2); \
                    const bf16x8 ta1 = *(const LAS bf16x8*)((const LAS unsigned char*)(TBUF) + ((32 + i32) * 64 + 16 * jc + 8 * hh) * 2); \
                    u0 = MFMA32(ta0, vb, u0); u1 = MFMA32(ta1, vb, u1); } \
                asm volatile("" ::: "memory"); \
                _Pragma("unroll") for (int r = 0; r < 16; ++r) { \
                    ((DST) + ((r & 3) + 8 * (r >> 2)) * (DSTLD) + 32 * dt)[SOFF] = f2bf(u0[r]); \
                    ((DST) + (32 + (r & 3) + 8 * (r >> 2)) * (DSTLD) + 32 * dt)[SOFF] = f2bf(u1[r]); } \
                asm volatile("" ::: "memory"); } } while (0)
        DN_TMUL(Tb, vslab, vslab, 6144, so6);
        { bf16_t* wslab = WDN + r0 * D_ + h * 128; DN_TMUL(Tb2, kslab, wslab, D_, so2); }
#undef DN_TMUL
        {
            bf16x8 kf[2][8];
#pragma unroll
            for (int it = 0; it < 2; ++it)
#pragma unroll
                for (int kc = 0; kc < 8; ++kc) kf[it][kc] = *(const bf16x8*)(kslab + 32 * it * 6144 + 16 * kc + fo6);
            f32x16 q00, q10, q11;
#pragma unroll
            for (int r = 0; r < 16; ++r) { q00[r] = 0.f; q10[r] = 0.f; q11[r] = 0.f; }
#pragma unroll
            for (int kc = 0; kc < 8; ++kc) {
                const bf16x8 qa0 = *(const bf16x8*)(qslab + 16 * kc + fo6), qa1 = *(const bf16x8*)(qslab + 32 * 6144 + 16 * kc + fo6);
                q00 = MFMA32(qa0, kf[0][kc], q00); q10 = MFMA32(qa1, kf[0][kc], q10); q11 = MFMA32(qa1, kf[1][kc], q11);
            }
            asm volatile("" ::: "memory");
            bf16_t* qkc = QKb + (size_t)ch * 4096;
            const LAS float* gcl = gcs + 4 * hh;
#pragma unroll
            for (int r = 0; r < 16; ++r) {
                const int ic = (r & 3) + 8 * (r >> 2);
                const float gi0 = gcl[ic], gi1 = gcl[32 + ic];
                const bool low = (ic + 4 * hh >= i32);
                (qkc + ic * 64)[soq] = f2bf(low ? q00[r] * __expf(fminf(gi0 - gcj0, 0.f)) : 0.f);
                (qkc + ic * 64 + 32)[soq] = (bf16_t)0;
                (qkc + (32 + ic) * 64)[soq] = f2bf(q10[r] * __expf(fminf(gi1 - gcj0, 0.f)));
                (qkc + (32 + ic) * 64 + 32)[soq] = f2bf(low ? q11[r] * __expf(fminf(gi1 - gcj1, 0.f)) : 0.f);
            }
            asm volatile("" ::: "memory");
#pragma unroll
            for (int it = 0; it < 2; ++it)
#pragma unroll
                for (int kc = 0; kc < 8; ++kc) {
#pragma unroll
                    for (int e = 0; e < 8; ++e) (kslab + (8 * kc + (e >> 1)) * 6144 + (e & 1) * 64 + 32 * it)[so6] = (bf16_t)kf[it][kc][e];
                    asm volatile("" ::: "memory"); }
        }
        bap[lane * 32 + 16] = gc;
        LDS_WAIT();
    }
}
__device__ __forceinline__ bf16x8 pack44(const f32x4 a, const f32x4 b) { u32x4 w = {pkbf(a[0], a[1]), pkbf(a[2], a[3]), pkbf(b[0], b[1]), pkbf(b[2], b[3])}; return __builtin_bit_cast(bf16x8, w); }

__device__ __forceinline__ bf16x8 ldl44(const LAS unsigned char* p0) { const u32x2 a = *(const LAS u32x2*)p0, b = *(const LAS u32x2*)(p0 + 32); u32x4 w = {a.x, a.y, b.x, b.y}; return __builtin_bit_cast(bf16x8, w); }
#define SC_BAR() do { asm volatile("s_waitcnt lgkmcnt(0)" ::: "memory"); __builtin_amdgcn_s_barrier(); asm volatile("" ::: "memory"); } while (0)
__device__ __forceinline__ void phase_dn_scan3(const Params& p, LAS unsigned char* lds) {
    constexpr int WP = 272, KP = 144, QP = 144, UP = 80;
    constexpr int O_W = 0, O_Q = O_W + 64 * WP, O_KT = O_Q + 64 * WP, O_QK = O_KT + 128 * KP, O_U = O_QK + 64 * QP, O_GC = O_U + 64 * UP, BUF = O_GC + 256;
    static_assert(2 * BUF <= LDS_BYTES, "scan LDS image");
    const int tid = tid_opaque(), lane = tid & 63, wave = __builtin_amdgcn_readfirstlane(tid >> 6), i16 = lane & 15, g4 = lane >> 4;
    bf16_t* QKV = (bf16_t*)(p.ws + WS_QKV); const float* BA = (const float*)(p.ws + WS_BA); const bf16_t* WDN = (const bf16_t*)(p.ws + WS_WDN); const bf16_t* QKb = (const bf16_t*)(p.ws + WS_QK);
    for (int item = blockIdx.x; item < 256; item += gridDim.x) {
        const int xc = item & 7, sl = item >> 3, dvq = sl & 3, bh = (sl >> 2) * 8 + xc, b = bh >> 4, h = bh & 15;
        const size_t rowb = (size_t)b * T_;
        __syncthreads();
        if (wave >= 2) {
            const int lt = tid - 128;
            const int p0 = lt, p1 = lt + 384, p2 = (lt + 768 < 1024) ? lt + 768 : lt, q1 = (lt + 384 < 512) ? lt + 384 : lt, pu = lt & 255;
            const unsigned gw0 = (unsigned)((p0 >> 4) * (D_ * 2) + (p0 & 15) * 16), gw1 = (unsigned)((p1 >> 4) * (D_ * 2) + (p1 & 15) * 16), gw2 = (unsigned)((p2 >> 4) * (D_ * 2) + (p2 & 15) * 16);
            const unsigned g60 = (unsigned)((p0 >> 4) * 12288 + (p0 & 15) * 16), g61 = (unsigned)((p1 >> 4) * 12288 + (p1 & 15) * 16), g62 = (unsigned)((p2 >> 4) * 12288 + (p2 & 15) * 16);
            const unsigned lw0 = (unsigned)((p0 >> 4) * WP + (p0 & 15) * 16), lw1 = (unsigned)((p1 >> 4) * WP + (p1 & 15) * 16), lw2 = (unsigned)((p2 >> 4) * WP + (p2 & 15) * 16);
            const unsigned lk0 = (unsigned)((2 * (p0 >> 4) + ((p0 >> 3) & 1)) * KP + (p0 & 7) * 16), lk1 = (unsigned)((2 * (p1 >> 4) + ((p1 >> 3) & 1)) * KP + (p1 & 7) * 16), lk2 = (unsigned)((2 * (p2 >> 4) + ((p2 >> 3) & 1)) * KP + (p2 & 7) * 16);
            const unsigned gq0 = (unsigned)(p0 * 16), gq1 = (unsigned)(q1 * 16);
            const unsigned lq0 = (unsigned)((p0 >> 3) * QP + (p0 & 7) * 16), lq1 = (unsigned)((q1 >> 3) * QP + (q1 & 7) * 16);
            const unsigned gu0 = (unsigned)((pu >> 2) * 12288 + (pu & 3) * 16), lu0 = (unsigned)((pu >> 2) * UP + (pu & 3) * 16);
            const char* Wg = (const char*)(WDN + rowb * D_ + h * 128);
            const char* Qg = (const char*)(QKV + rowb * 6144 + h * 128);
            const char* Kg = (const char*)(QKV + rowb * 6144 + 2048 + h * 128);
            const char* Ug = (const char*)(QKV + rowb * 6144 + 4096 + h * 128 + dvq * 32);
            const char* QKg = (const char*)(QKb + (size_t)(bh * 64) * 4096);
            const float* gcp = BA + (rowb + (lt & 63)) * 32 + 16 + h;
            u32x4 dA[12], dB[12], dC[12]; float gA = 0.f, gB = 0.f, gC = 0.f;
#define SC_LOAD(D, GV, n) do { const char* w_ = Wg + (size_t)(n) * (64 * D_ * 2); const char* q_ = Qg + (size_t)(n) * (64 * 12288); const char* k_ = Kg + (size_t)(n) * (64 * 12288); \
                const char* u_ = Ug + (size_t)(n) * (64 * 12288); const char* qk_ = QKg + (size_t)(n) * 8192; \
                D[0] = *(const u32x4*)(w_ + gw0); D[1] = *(const u32x4*)(w_ + gw1); D[2] = *(const u32x4*)(w_ + gw2); \
                D[3] = *(const u32x4*)(q_ + g60); D[4] = *(const u32x4*)(q_ + g61); D[5] = *(const u32x4*)(q_ + g62); \
                D[6] = *(const u32x4*)(k_ + g60); D[7] = *(const u32x4*)(k_ + g61); D[8] = *(const u32x4*)(k_ + g62); \
                D[9] = *(const u32x4*)(qk_ + gq0); D[10] = *(const u32x4*)(qk_ + gq1); D[11] = *(const u32x4*)(u_ + gu0); \
                GV = gcp[(size_t)(n) * 2048]; } while (0)
#define SC_STORE(D, GV, bb) do { LAS unsigned char* bp = lds + (bb) * BUF; \
                *(LAS u32x4*)(bp + O_W + lw0) = D[0]; *(LAS u32x4*)(bp + O_W + lw1) = D[1]; *(LAS u32x4*)(bp + O_W + lw2) = D[2]; \
                *(LAS u32x4*)(bp + O_Q + lw0) = D[3]; *(LAS u32x4*)(bp + O_Q + lw1) = D[4]; *(LAS u32x4*)(bp + O_Q + lw2) = D[5]; \
                *(LAS u32x4*)(bp + O_KT + lk0) = D[6]; *(LAS u32x4*)(bp + O_KT + lk1) = D[7]; *(LAS u32x4*)(bp + O_KT + lk2) = D[8]; \
                *(LAS u32x4*)(bp + O_QK + lq0) = D[9]; *(LAS u32x4*)(bp + O_QK + lq1) = D[10]; *(LAS u32x4*)(bp + O_U + lu0) = D[11]; \
                ((LAS float*)(bp + O_GC))[lt & 63] = GV; } while (0)
#define SC_CL(n) ((n) < 64 ? (n) : 63)
#define SC_STEP(D, GV, t, bb) do { if ((t) < 64) { if ((t) + 1 < 64) SC_STORE(D, GV, bb); SC_LOAD(D, GV, SC_CL((t) + 4)); SC_BAR(); } } while (0)
            SC_LOAD(dA, gA, 0); SC_STORE(dA, gA, 0);
            SC_LOAD(dA, gA, 1); SC_LOAD(dB, gB, 2); SC_LOAD(dC, gC, 3);
            SC_BAR();
#pragma unroll 1
            for (int n = 0; n < 64; n += 6) {
                SC_STEP(dA, gA, n, 1); SC_STEP(dB, gB, n + 1, 0); SC_STEP(dC, gC, n + 2, 1);
                SC_STEP(dA, gA, n + 3, 0); SC_STEP(dB, gB, n + 4, 1); SC_STEP(dC, gC, n + 5, 0);
            }
#undef SC_STEP
#undef SC_CL
#undef SC_LOAD
#undef SC_STORE
        } else {
            f32x4 S[8];
#pragma unroll
            for (int dt = 0; dt < 8; ++dt) S[dt] = (f32x4){0.f, 0.f, 0.f, 0.f};
            SC_BAR();
#pragma unroll 1
            for (int n = 0; n < 64; ++n) {
                const LAS unsigned char* bp = lds + (n & 1) * BUF;
                const LAS unsigned char* wr_ = bp + O_W + i16 * WP + 8 * g4;
                const LAS unsigned char* qr_ = bp + O_Q + i16 * WP + 8 * g4;
                const LAS unsigned char* qkr = bp + O_QK + i16 * QP + 8 * g4;
                const LAS unsigned char* ktr = bp + O_KT + i16 * KP + 8 * g4;
                const LAS unsigned char* ur = bp + O_U + (4 * g4) * UP + (wave * 16 + i16) * 2;
                const LAS float* gcl = (const LAS float*)(bp + O_GC) + 4 * g4;
                const float gl = ((const LAS float*)(bp + O_GC))[63];
                bf16_t* uo = QKV + (rowb + n * 64 + 4 * g4) * 6144 + 4096 + h * 128 + dvq * 32 + wave * 16 + i16;
                bf16x8 wf[4][4], qf4[4][4];
#pragma unroll
                for (int mt = 0; mt < 4; ++mt)
#pragma unroll
                    for (int kc = 0; kc < 4; ++kc) { wf[mt][kc] = ldl44(wr_ + 16 * mt * WP + 64 * kc); qf4[mt][kc] = ldl44(qr_ + 16 * mt * WP + 64 * kc); }
                asm volatile("" ::: "memory");
                bf16x8 sb[4];
#pragma unroll
                for (int kc = 0; kc < 4; ++kc) sb[kc] = pack44(S[2 * kc], S[2 * kc + 1]);
                f32x4 ws4[4], qs4[4];
#pragma unroll
                for (int mt = 0; mt < 4; ++mt) { ws4[mt] = (f32x4){0.f, 0.f, 0.f, 0.f}; qs4[mt] = ws4[mt]; }
#pragma unroll
                for (int kc = 0; kc < 4; ++kc)
#pragma unroll
                    for (int mt = 0; mt < 4; ++mt) { ws4[mt] = MFMA16(wf[mt][kc], sb[kc], ws4[mt]); qs4[mt] = MFMA16(qf4[mt][kc], sb[kc], qs4[mt]); }
                bf16x8 qkf[4][2], ktf[8][2];
#pragma unroll
                for (int mt = 0; mt < 4; ++mt) { qkf[mt][0] = ldl44(qkr + 16 * mt * QP); qkf[mt][1] = ldl44(qkr + 16 * mt * QP + 64); }
#pragma unroll
                for (int dt = 0; dt < 8; ++dt) { ktf[dt][0] = ldl44(ktr + 16 * dt * KP); ktf[dt][1] = ldl44(ktr + 16 * dt * KP + 64); }
                float gcv[4][4], uu[4][4];
#pragma unroll
                for (int mt = 0; mt < 4; ++mt)
#pragma unroll
                    for (int r = 0; r < 4; ++r) { gcv[mt][r] = gcl[16 * mt + r]; uu[mt][r] = bf2f(*(const LAS bf16_t*)(ur + (16 * mt + r) * UP)); }
                asm volatile("" ::: "memory");
                f32x4 vn[4], vs[4], eg[4];
#pragma unroll
                for (int mt = 0; mt < 4; ++mt)
#pragma unroll
                    for (int r = 0; r < 4; ++r) { eg[mt][r] = __expf(gcv[mt][r]); vn[mt][r] = uu[mt][r] - ws4[mt][r]; vs[mt][r] = vn[mt][r] * __expf(gl - gcv[mt][r]); }
                const bf16x8 vb10 = pack44(vn[0], vn[1]), vb11 = pack44(vn[2], vn[3]), vb20 = pack44(vs[0], vs[1]), vb21 = pack44(vs[2], vs[3]);
#pragma unroll
                for (int mt = 0; mt < 4; ++mt) { f32x4 o = qs4[mt] * eg[mt];
                    o = MFMA16(qkf[mt][0], vb10, o); o = MFMA16(qkf[mt][1], vb11, o);
#pragma unroll
                    for (int r = 0; r < 4; ++r) uo[(size_t)(16 * mt + r) * 6144] = f2bf(o[r]); }
                const float egl = __expf(gl);
#pragma unroll
                for (int dt = 0; dt < 8; ++dt) { f32x4 sn = S[dt] * egl; sn = MFMA16(ktf[dt][0], vb20, sn); sn = MFMA16(ktf[dt][1], vb21, sn); S[dt] = sn; }
                SC_BAR();
            }
        }
    }
}


__device__ __forceinline__ void phase_ba(const Params& p, LAS unsigned char* lds) {
    const int tid = tid_opaque(), lane = tid & 63, wave = __builtin_amdgcn_readfirstlane(tid >> 6), i32 = lane & 31, hh = lane >> 5;
    const bf16_t* U = (const bf16_t*)(p.ws + WS_U); const bf16_t* Wb = (const bf16_t*)(p.ws + WS_WIN1) + (size_t)12288 * 2048; float* BA = (float*)(p.ws + WS_BA);
    LAS float* red = (LAS float*)lds;
    for (int item = blockIdx.x; item < 256; item += gridDim.x) {
        const size_t row0 = (size_t)item * 64;
        f32x16 a0, a1;
#pragma unroll
        for (int r = 0; r < 16; ++r) { a0[r] = 0.f; a1[r] = 0.f; }
        const bf16_t* bp = Wb + (size_t)i32 * 2048 + 256 * wave + 8 * hh;
        const bf16_t* ap = U + (row0 + i32) * D_ + 256 * wave + 8 * hh;
#pragma unroll
        for (int ks = 0; ks < 16; ++ks) { const bf16x8 bfr = *(const bf16x8*)(bp + 16 * ks), af0 = *(const bf16x8*)(ap + 16 * ks), af1 = *(const bf16x8*)(ap + (size_t)32 * D_ + 16 * ks);
            a0 = MFMA32(af0, bfr, a0); a1 = MFMA32(af1, bfr, a1); }
        __syncthreads();
#pragma unroll
        for (int r = 0; r < 16; ++r) { red[((wave * 2 + 0) * 16 + r) * 64 + lane] = a0[r]; red[((wave * 2 + 1) * 16 + r) * 64 + lane] = a1[r]; }
        __syncthreads();
#pragma unroll
        for (int q = 0; q < 4; ++q) { const int idx = tid + 512 * q, mt = idx >> 10, r = (idx >> 6) & 15, ln = idx & 63; float t = 0.f;
#pragma unroll
            for (int w8 = 0; w8 < 8; ++w8) t += red[((w8 * 2 + mt) * 16 + r) * 64 + ln];
            BA[(row0 + 32 * mt + (r & 3) + 8 * (r >> 2) + 4 * (ln >> 5)) * 32 + (ln & 31)] = t; }
    }
}

__device__ __forceinline__ void phase_ya(const Params& p) {
    const int tid_ = tid_opaque(); const int lane = tid_ & 63, wave = tid_ >> 6;
    const int gw = blockIdx.x * 8 + wave, NGW = gridDim.x * 8;
    bf16_t* QKV = (bf16_t*)(p.ws + WS_QKV);
    const int e8 = lane & 15;
    float gn[8];
#pragma unroll
    for (int i = 0; i < 8; ++i) gn[i] = p.dn_norm_g[e8 * 8 + i];
    for (int it = gw; it < M_ * 16 / 4; it += 2 * NGW) {
        const int it2 = it + NGW; const bool v2 = it2 < M_ * 16 / 4;
        const int pairA = it * 4 + (lane >> 4), pairB = (v2 ? it2 : it) * 4 + (lane >> 4);
        bf16_t* opA = QKV + (size_t)(pairA >> 4) * 6144 + 4096 + (pairA & 15) * 128 + e8 * 8; const bf16_t* zpA = opA - 4096;
        bf16_t* opB = QKV + (size_t)(pairB >> 4) * 6144 + 4096 + (pairB & 15) * 128 + e8 * 8; const bf16_t* zpB = opB - 4096;
        const u32x4 oA = *(const u32x4*)opA, zA = *(const u32x4*)zpA, oB = *(const u32x4*)opB, zB = *(const u32x4*)zpB;
#pragma unroll
        for (int half = 0; half < 2; ++half) {
            float of[8], zf[8]; unpack8(half ? oB : oA, of); unpack8(half ? zB : zA, zf);
            float ss = 0.f;
#pragma unroll
            for (int i = 0; i < 8; ++i) ss += of[i] * of[i];
            ss += __shfl_xor(ss, 1); ss += __shfl_xor(ss, 2); ss += __shfl_xor(ss, 4); ss += __shfl_xor(ss, 8);
            const float rs = rsqrtf(ss * (1.0f / 128.0f) + 1e-6f);
            u32x4 w;
#pragma unroll
            for (int e = 0; e < 4; ++e) w[e] = cvt_pk_bf16(of[2 * e] * rs * gn[2 * e] * siluf_(zf[2 * e]), of[2 * e + 1] * rs * gn[2 * e + 1] * siluf_(zf[2 * e + 1]));
            if (half == 0) *(u32x4*)opA = w; else if (v2) *(u32x4*)opB = w;
        }
    }
}


#define XB_TMO      128
#define XB_XCNT(j)  (256  + 64 * (j))
#define XB_XSUB(j)  (1280 + 64 * (j))
#define XB_XGEN(j)  (2304 + 64 * (j))
#define XB_TOP      3328
#define XB_TOPGEN   3392
#define XCD_BAR_WORDS 3456
#define XB_SPIN_CAP (1u << 18)
__device__ __forceinline__ unsigned xb_ld(unsigned* p)              { return __hip_atomic_load(p, __ATOMIC_RELAXED, __HIP_MEMORY_SCOPE_AGENT); }
__device__ __forceinline__ unsigned xb_add(unsigned* p, unsigned v) { return __hip_atomic_fetch_add(p, v, __ATOMIC_RELAXED, __HIP_MEMORY_SCOPE_AGENT); }
__device__ __forceinline__ unsigned xb_xcc_id() { return (unsigned)__builtin_amdgcn_s_getreg((3 << 11) | 20) & 0xFu; }
#define XB_SPIN(cond, bar) do { unsigned _sp = 0; while (cond) { __builtin_amdgcn_s_sleep(1); \
    if ((++_sp & 255u) == 0u) { if (xb_ld(&(bar)[XB_TMO])) break; if (_sp > XB_SPIN_CAP) { atomicAdd(&(bar)[XB_TMO], 1u); break; } } } } while (0)
struct XcdBarrier { unsigned* bar; unsigned x; volatile LAS unsigned* st; };
__device__ __forceinline__ XcdBarrier xcd_barrier_post(unsigned* bar, volatile LAS unsigned* st) {
    XcdBarrier b; b.bar = bar; b.x = xb_xcc_id(); b.st = st;
    if (threadIdx.x == 0) (void)xb_add(&bar[XB_XCNT(b.x)], 1u);
    return b;
}
__device__ __forceinline__ void xcd_barrier_complete(unsigned* bar, unsigned x, unsigned& nloc, unsigned& nx) {
    const unsigned G = gridDim.x * gridDim.y * gridDim.z;
    unsigned sum, cnt, mine, sp = 0u;
    for (;;) {
        sum = 0u; cnt = 0u; mine = 0u;
#pragma unroll
        for (unsigned j = 0; j < 16; ++j) { const unsigned c = xb_ld(&bar[XB_XCNT(j)]); sum += c; cnt += (c > 0u) ? 1u : 0u; mine = (j == x) ? c : mine; }
        if (sum == G) break;
        __builtin_amdgcn_s_sleep(1);
        if ((++sp & 255u) == 0u) { if (xb_ld(&bar[XB_TMO])) break; if (sp > XB_SPIN_CAP) { atomicAdd(&bar[XB_TMO], 1u); break; } }
    }
    nloc = mine > 0u ? mine : 1u; nx = cnt > 0u ? cnt : 1u;
}
__device__ __forceinline__ void xcd_barrier(const XcdBarrier& b) {
    asm volatile("s_waitcnt vmcnt(0)" ::: "memory");
    __syncthreads();
    if (threadIdx.x == 0) {
        unsigned* bar = b.bar;
        __builtin_amdgcn_s_waitcnt(0);
        unsigned nloc = b.st[0], nx = b.st[1];
        if (nloc == 0u) { xcd_barrier_complete(bar, b.x, nloc, nx); b.st[0] = nloc; b.st[1] = nx; }
        const unsigned old = xb_add(&bar[XB_XSUB(b.x)], 1u);
        const unsigned gen = old / nloc;
        if (old + 1u == (gen + 1u) * nloc) {
            __builtin_amdgcn_fence(__ATOMIC_RELEASE, "agent");
            asm volatile("s_waitcnt vmcnt(0)" ::: "memory");
            const unsigned og = xb_add(&bar[XB_TOP], 1u);
            const unsigned tg = og / nx;
            if (og + 1u == (tg + 1u) * nx) xb_add(&bar[XB_TOPGEN], 1u);
            else XB_SPIN(xb_ld(&bar[XB_TOPGEN]) == tg, bar);
            __builtin_amdgcn_fence(__ATOMIC_ACQUIRE, "agent");
            xb_add(&bar[XB_XGEN(b.x)], 1u);
            asm volatile("s_waitcnt vmcnt(0)" ::: "memory");
        } else {
            XB_SPIN(xb_ld(&bar[XB_XGEN(b.x)]) == gen, bar);
            __builtin_amdgcn_fence(__ATOMIC_ACQUIRE, "agent");
            asm volatile("s_waitcnt vmcnt(0)" ::: "memory");
        }
    }
    __syncthreads();
}

__global__ void __launch_bounds__(512, 2) fwd_megakernel(Params p) {
    extern __shared__ __attribute__((aligned(16))) unsigned char lds_raw[];
    LAS unsigned char* lds = (LAS unsigned char*)lds_raw;
    cg::grid_group grid = cg::this_grid();
    __shared__ unsigned xb_st[2];
    if (threadIdx.x == 0) { xb_st[0] = 0u; xb_st[1] = 0u; }
    __syncthreads();
    const XcdBarrier xbar = xcd_barrier_post((unsigned*)(p.ws + WS_XBAR), (volatile LAS unsigned*)xb_st);
#define GRID_SYNC() xcd_barrier(xbar)
    const int G = gridDim.x, bid = blockIdx.x;
    unsigned char* ws = p.ws;
    bf16_t* U = (bf16_t*)(ws + WS_U); bf16_t* ACT = (bf16_t*)(ws + WS_ACT); bf16_t* QKV = (bf16_t*)(ws + WS_QKV); bf16_t* MB = (bf16_t*)(ws + WS_MB);
    const float* ada = (const float*)(ws + WS_ADA);
    const bf16_t* W13 = (const bf16_t*)(ws + WS_W13); const bf16_t* W2 = (const bf16_t*)(ws + WS_W2);

    phase0(p, lds);
    grid.sync();
    phase_ada_reduce(p);
    GRID_SYNC();
    phase_normmod(p.x, p.norm1_g, ada, 0 * D_, 1 * D_, U);
    GRID_SYNC();
    { pg8::Gemm g{U, D_, W13, D_}; pg8::StaticOrder S; S.init(64, 44, G, bid); pg8::EpiSwiglu E{ACT}; pg8::gemm_phase(lds, g, S, E); }
    GRID_SYNC();
    { pg8::Gemm g{ACT, FF_, W2, FF_}; pg8::StaticOrder S; S.init(64, 8, G, bid); pg8::EpiResid E{p.x, p.out, ada + 2 * D_, 0.5f}; pg8::gemm_phase(lds, g, S, E); }
    GRID_SYNC();
#ifndef PROBE_N
#define PROBE_N 0
#endif
    for (int pass = (PROBE_N > 0 ? 0 : 1); pass < 2; ++pass) {
    const int lim = (pass == 0) ? PROBE_N : 99;
    if (lim >= 1) { phase_normmod(p.out, p.norm2_g, ada, 3 * D_, 4 * D_, U); GRID_SYNC(); }
    if (lim >= 2) { pg8::Gemm g{U, D_, (const bf16_t*)(ws + WS_WIN1), D_}; pg8::StaticOrder S; S.init(64, 48, G, bid); pg8::EpiIn1 E{QKV, MB, (float*)(ws + WS_BA)}; pg8::gemm_phase(lds, g, S, E); phase_ba(p, lds); GRID_SYNC(); }
    if (lim >= 3) { phase_halo(p); GRID_SYNC(); }
    if (lim >= 4) { phase_postproc(p, lds); GRID_SYNC(); }
    if (lim >= 6) { phase_dn_local(p, lds); GRID_SYNC(); }
    if (lim >= 7) { phase_dn_scan3(p, lds); __syncthreads(); }
    if (lim >= 8) { phase_moba_mfma(p, lds, (unsigned)(size_t)lds_raw); }
    if (lim >= 7) GRID_SYNC();
    if (lim >= 9) { pg8::Gemm g{U, D_, (const bf16_t*)(ws + WS_WIN2), D_}; pg8::StaticOrder S; S.init(64, 24, G, bid); pg8::EpiIn2 E{QKV, MB + (size_t)M_ * D_}; pg8::gemm_phase(lds, g, S, E); GRID_SYNC(); }
    if (lim >= 10) { phase_ya(p); GRID_SYNC(); }
    if (lim >= 11) {
      { pg8::Gemm g{QKV + 4096, 6144, (const bf16_t*)(ws + WS_WPAB), D_}; pg8::StaticOrder S; S.init(64, 8, G, bid);
        pg8::EpiProjA E{QKV + 2048, 6144, MB + 2 * (size_t)M_ * D_}; pg8::gemm_phase(lds, g, S, E); }
      { pg8::Gemm g{MB, D_, (const bf16_t*)(ws + WS_WPAB) + (size_t)2048 * 2048, D_}; pg8::StaticOrder S; S.init(64, 8, G, bid);
        pg8::EpiProjB E{MB + (size_t)M_ * D_, D_, MB + 2 * (size_t)M_ * D_, U}; pg8::gemm_phase(lds, g, S, E); }
      GRID_SYNC(); }
    }
    { pg8::Gemm g{U, D_, (const bf16_t*)(ws + WS_WOUT), D_}; pg8::StaticOrder S; S.init(64, 8, G, bid); pg8::EpiResid E{p.out, p.out, ada + 5 * D_, 1.0f}; pg8::gemm_phase(lds, g, S, E); }
    GRID_SYNC();
    phase_normmod(p.out, p.norm3_g, ada, 6 * D_, 7 * D_, U);
    { const int tid_ = tid_opaque(); const int lane = tid_ & 63, wave = tid_ >> 6; __syncthreads();
      convert_ffn(p.f2w1, p.f2w3, p.f2w2, (bf16_t*)(ws + WS_W13), (bf16_t*)(ws + WS_W2), (LAS float*)(lds + wave * 8448), bid * 8 + wave, G * 8, lane); }
    GRID_SYNC();
    { pg8::Gemm g{U, D_, W13, D_}; pg8::StaticOrder S; S.init(64, 44, G, bid); pg8::EpiSwiglu E{ACT}; pg8::gemm_phase(lds, g, S, E); }
    GRID_SYNC();
    { pg8::Gemm g{ACT, FF_, W2, FF_}; pg8::StaticOrder S; S.init(64, 8, G, bid); pg8::EpiResid E{p.out, p.out, ada + 8 * D_, 0.5f}; pg8::gemm_phase(lds, g, S, E); }
}

extern "C" void kernel_launch(void* const* d_in, const int* in_sizes, int n_in, void* d_out, int out_size, void* d_ws, size_t ws_size, hipStream_t stream) {
    static int grid_blocks = 0;
    if (grid_blocks == 0) {
        if (n_in != 24 || ws_size < WS_END) { fprintf(stderr, "kernel_launch: unexpected n_in %d or ws_size %zu (< %zu)\n", n_in, ws_size, (size_t)WS_END); grid_blocks = -1; return; }
        int dev = 0, cus = 0, per_cu = 0;
        hipGetDevice(&dev);
        hipDeviceGetAttribute(&cus, hipDeviceAttributeMultiprocessorCount, dev);
        hipFuncSetAttribute((const void*)fwd_megakernel, hipFuncAttributeMaxDynamicSharedMemorySize, LDS_BYTES);
        hipOccupancyMaxActiveBlocksPerMultiprocessor(&per_cu, (const void*)fwd_megakernel, 512, LDS_BYTES);
        if (per_cu < 1) { fprintf(stderr, "kernel_launch: occupancy query says %d blocks per CU\n", per_cu); per_cu = 1; }
        (void)hipGetLastError();
        grid_blocks = cus;
        if (grid_blocks > 256) grid_blocks = 256;
    }
    if (grid_blocks < 0) return;
    Params p{};
    const float** pp = (const float**)&p;
    for (int i = 0; i < 24; ++i) pp[i] = (const float*)d_in[i];
    p.out = (float*)d_out; p.ws = (unsigned char*)d_ws;
    (void)hipMemsetAsync((char*)d_ws + WS_XBAR, 0, 16384, stream);
    void* args[] = {&p};
    hipError_t e = hipLaunchCooperativeKernel((const void*)fwd_megakernel, dim3(grid_blocks), dim3(512), args, LDS_BYTES, stream);
    if (e != hipSuccess) fprintf(stderr, "cooperative launch failed: %s (grid %d)\n", hipGetErrorString(e), grid_blocks);
}
```

```cpp
#include <hip/hip_runtime.h>
#include <hip/hip_cooperative_groups.h>
#include <cstdio>
#include <cstdint>
namespace cg = cooperative_groups;

#define LAS __attribute__((address_space(3)))
typedef unsigned short bf16_t;
typedef short bf16x8 __attribute__((ext_vector_type(8)));
typedef float f32x4 __attribute__((ext_vector_type(4)));
typedef unsigned u32x4 __attribute__((ext_vector_type(4)));
typedef unsigned u32x2 __attribute__((ext_vector_type(2)));

constexpr int M_ = 16384, D_ = 2048, FF_ = 5632, T_ = 4096;
constexpr int NIN1 = 12544, NIN2 = 6144, NADA = 18432;
constexpr float LOG2E = 1.4426950408889634f;
constexpr float QSCALE = 0.08838834764831845f;

constexpr size_t SZ_MD = (size_t)M_ * D_ * 2;
constexpr size_t WS_W13 = 0;
constexpr size_t WS_W2 = WS_W13 + (size_t)11264 * 2048 * 2;
constexpr size_t WS_WIN1 = WS_W2 + (size_t)2048 * 5632 * 2;
constexpr size_t WS_WIN2 = WS_WIN1 + (size_t)NIN1 * 2048 * 2;
constexpr size_t WS_WPAB = WS_WIN2 + (size_t)NIN2 * 2048 * 2;
constexpr size_t WS_WOUT = WS_WPAB + (size_t)2048 * 4096 * 2;
constexpr size_t WS_ADA = WS_WOUT + (size_t)2048 * 2048 * 2;
constexpr size_t WS_BT = WS_ADA + (size_t)4 * NADA * 4;
constexpr size_t WS_KMEAN = WS_BT + (size_t)16 * 4096 * 4;
constexpr size_t WS_U = WS_KMEAN + (size_t)4 * 16 * 16 * 128 * 4;
constexpr size_t WS_BIG = WS_U + SZ_MD;
constexpr size_t WS_QKV = WS_BIG;
constexpr size_t WS_MB = WS_QKV + 3 * SZ_MD;
constexpr size_t WS_BA = WS_MB + 3 * SZ_MD;
constexpr size_t WS_WDN = WS_BA + (size_t)M_ * 32 * 4;
constexpr size_t WS_QK = WS_WDN + SZ_MD;
constexpr size_t WS_XBAR = WS_QK + SZ_MD / 2;
constexpr size_t WS_END = WS_XBAR + 16384;
constexpr size_t WS_ACT = WS_BIG;
constexpr size_t WS_ADAP = WS_BIG;
constexpr size_t WS_HALO = WS_WDN;

constexpr int LDS_BYTES = 147456;

struct Params {
    const float* x; const float* c; const float* ada_w; const float* ada_b; const float* norm1_g;
    const float* f1w1; const float* f1w3; const float* f1w2; const float* norm2_g; const float* w_in;
    const float* conv_w; const float* a_log; const float* dt_bias; const float* dn_norm_g; const float* qn_g; const float* kn_g;
    const float* rel_bias; const float* wpa; const float* wpb; const float* wout; const float* norm3_g;
    const float* f2w1; const float* f2w3; const float* f2w2;
    float* out; unsigned char* ws;
};

typedef float f32x2v __attribute__((ext_vector_type(2)));
typedef __bf16 bf16x2_t __attribute__((ext_vector_type(2)));
__device__ __forceinline__ unsigned cvt_pk_bf16(float lo, float hi) { f32x2v v = {lo, hi}; bf16x2_t r = __builtin_convertvector(v, bf16x2_t); return __builtin_bit_cast(unsigned, r); }
__device__ __forceinline__ bf16_t f2bf(float f) { return (bf16_t)(cvt_pk_bf16(f, 0.f) & 0xffffu); }
__device__ __forceinline__ float bf2f(unsigned b) { return __uint_as_float(b << 16); }
__device__ __forceinline__ float bflo(unsigned w) { return __uint_as_float(w << 16); }
__device__ __forceinline__ float bfhi(unsigned w) { return __uint_as_float(w & 0xffff0000u); }
__device__ __forceinline__ float wave_sum(float v) {
#pragma unroll
    for (int o = 1; o < 64; o <<= 1) v += __shfl_xor(v, o);
    return v;
}
__device__ __forceinline__ float wave_max(float v) {
#pragma unroll
    for (int o = 1; o < 64; o <<= 1) v = fmaxf(v, __shfl_xor(v, o));
    return v;
}
__device__ __forceinline__ float sigmoidf_(float x) { return __builtin_amdgcn_rcpf(1.0f + __builtin_amdgcn_exp2f(-x * LOG2E)); }
__device__ __forceinline__ float siluf_(float x) { return x * sigmoidf_(x); }
#define LDS_WAIT() asm volatile("s_waitcnt lgkmcnt(0)" ::: "memory")
__device__ __forceinline__ int tid_opaque() { int t = threadIdx.x; asm volatile("" : "+v"(t)); return t; }

namespace pg8 {
constexpr int BM = 256, BK = 64, HALF = 128, HTB = HALF * BK * 2, STAGE_BYTES = 8 * HTB, NXCD = 8, WGM = 4;
__host__ __device__ __forceinline__ int lds_byte(int r, int c) { const int st = (r >> 4) * 2 + (c >> 5), rr = r & 15, cc = c & 31, ob = rr * 64 + cc * 2; return st * 1024 + (ob ^ (((ob >> 9) & 1) << 5)); }
__host__ __device__ __forceinline__ void stage_rc(int b, int& R, int& C) { const int st = b / 1024, sb = b % 1024, swz = sb ^ (((sb >> 9) & 1) << 5); R = (st >> 1) * 16 + swz / 64; C = (st & 1) * 32 + (swz % 64) / 2; }
__host__ __device__ __forceinline__ int perm32(int rho) { const int n = rho >> 4, i = rho & 15; return 8 * (i >> 2) + 4 * n + (i & 3); }

struct Unit { int pm, pn; };
struct Gemm { const bf16_t* A; int lda; const bf16_t* Bt; int K; };

struct StaticOrder {
    int nM, nN, nwg, G, c;
    __device__ void init(int nM_, int nN_, int G_, int c_) { nM = nM_; nN = nN_; nwg = nM * nN; G = G_; c = c_; }
    __device__ bool next(int i, Unit& u) const {
        const long L = (long)i * G + c; if (L >= nwg) return false;
        int wgid = (int)L; { const int q = nwg / NXCD, r = nwg % NXCD, xcd = wgid % NXCD, off = wgid / NXCD; wgid = (xcd < r ? xcd * (q + 1) : r * (q + 1) + (xcd - r) * q) + off; }
        const int nig = WGM * nN, gid = wgid / nig, fm = gid * WGM, gsz = (nM - fm) < WGM ? (nM - fm) : WGM;
        u.pm = fm + ((wgid % nig) % gsz); u.pn = (wgid % nig) / gsz; return true;
    }
};

typedef f32x4 Acc[2][2][4][2];

struct EpiSwiglu {
    static constexpr bool PERM = true;
    bf16_t* O;
    __device__ __forceinline__ void operator()(const Acc& acc, const Unit& u, int wr, int wc, int fr, int fq) const {
        const int row0 = u.pm * BM + wr * 64 + fr, col0 = u.pn * 128 + wc * 32 + 8 * fq;
#pragma unroll
        for (int ai = 0; ai < 2; ++ai)
#pragma unroll
            for (int m = 0; m < 4; ++m) {
                bf16_t* rowp = O + (size_t)(row0 + ai * HALF + m * 16) * FF_ + col0;
                float v[8];
#pragma unroll
                for (int n = 0; n < 2; ++n)
#pragma unroll
                    for (int j = 0; j < 4; ++j) v[n * 4 + j] = siluf_(acc[ai][0][m][n][j]) * acc[ai][1][m][n][j];
                u32x4 w; w.x = cvt_pk_bf16(v[0], v[1]); w.y = cvt_pk_bf16(v[2], v[3]); w.z = cvt_pk_bf16(v[4], v[5]); w.w = cvt_pk_bf16(v[6], v[7]);
                *(u32x4*)rowp = w;
            }
    }
};
struct EpiResid {
    static constexpr bool PERM = false;
    const float* resid; float* out; const float* gada; float scale;
    __device__ __forceinline__ void operator()(const Acc& acc, const Unit& u, int wr, int wc, int fr, int fq) const {
        const int row0 = u.pm * BM + wr * 64 + fr, col0 = u.pn * BM + wc * 32 + 4 * fq;
        const float* g = gada + (size_t)(u.pm >> 4) * NADA;
        f32x4 gv[2][2];
#pragma unroll
        for (int bj = 0; bj < 2; ++bj)
#pragma unroll
            for (int n = 0; n < 2; ++n) gv[bj][n] = *(const f32x4*)(g + col0 + bj * HALF + n * 16) * scale;
#pragma unroll
        for (int ai = 0; ai < 2; ++ai) {
            f32x4 rr[4][2][2];
#pragma unroll
            for (int m = 0; m < 4; ++m)
#pragma unroll
                for (int bj = 0; bj < 2; ++bj)
#pragma unroll
                    for (int n = 0; n < 2; ++n) rr[m][bj][n] = *(const f32x4*)(resid + (size_t)(row0 + ai * HALF + m * 16) * D_ + col0 + bj * HALF + n * 16);
#pragma unroll
            for (int m = 0; m < 4; ++m)
#pragma unroll
                for (int bj = 0; bj < 2; ++bj)
#pragma unroll
                    for (int n = 0; n < 2; ++n) *(f32x4*)(out + (size_t)(row0 + ai * HALF + m * 16) * D_ + col0 + bj * HALF + n * 16) = rr[m][bj][n] + gv[bj][n] * acc[ai][bj][m][n];
        }
    }
};
__device__ __forceinline__ void store_bf16_tile(const Acc& acc, bf16_t* base, int ldc, int row0, int col0) {
#pragma unroll
    for (int ai = 0; ai < 2; ++ai)
#pragma unroll
        for (int m = 0; m < 4; ++m) {
            bf16_t* rowp = base + (size_t)(row0 + ai * HALF + m * 16) * ldc + col0;
#pragma unroll
            for (int bj = 0; bj < 2; ++bj) {
                const f32x4 v0 = acc[ai][bj][m][0], v1 = acc[ai][bj][m][1];
                u32x4 w; w.x = cvt_pk_bf16(v0[0], v0[1]); w.y = cvt_pk_bf16(v0[2], v0[3]); w.z = cvt_pk_bf16(v1[0], v1[1]); w.w = cvt_pk_bf16(v1[2], v1[3]);
                *(u32x4*)(rowp + bj * HALF) = w;
            }
        }
}
struct EpiIn1 {
    static constexpr bool PERM = true;
    bf16_t* QKV; bf16_t* MB; float* BA;
    __device__ __forceinline__ void operator()(const Acc& acc, const Unit& u, int wr, int wc, int fr, int fq) const {
        const int row0 = u.pm * BM + wr * 64 + fr, pn = u.pn;
        if (pn < 48) {
            bf16_t* base; int ldc, colt;
            if (pn < 24) { base = QKV; ldc = 6144; colt = pn * 256; }
            else { const int t = (pn - 24) >> 3; base = MB + (size_t)t * M_ * D_; ldc = 2048; colt = ((pn - 24) & 7) * 256; }
            store_bf16_tile(acc, base, ldc, row0, colt + wc * 32 + 8 * fq);
        } else if (wc == 0) {
#pragma unroll
            for (int ai = 0; ai < 2; ++ai)
#pragma unroll
                for (int m = 0; m < 4; ++m) { float* pp = BA + (size_t)(row0 + ai * HALF + m * 16) * 32 + 8 * fq; *(f32x4*)pp = acc[ai][0][m][0]; *(f32x4*)(pp + 4) = acc[ai][0][m][1]; }
        }
    }
};
struct EpiIn2 {
    static constexpr bool PERM = true;
    bf16_t* QKV; bf16_t* MBK;
    __device__ __forceinline__ void operator()(const Acc& acc, const Unit& u, int wr, int wc, int fr, int fq) const {
        const int row0 = u.pm * BM + wr * 64 + fr, pn = u.pn;
        bf16_t* base; int ldc, colt;
        if (pn < 16) { base = QKV; ldc = 6144; colt = pn * 256; }
        else { base = MBK; ldc = 2048; colt = (pn - 16) * 256; }
        store_bf16_tile(acc, base, ldc, row0, colt + wc * 32 + 8 * fq);
    }
};
struct EpiProjA {
    static constexpr bool PERM = true;
    const bf16_t* GA; int ldga; bf16_t* Tm;
    __device__ __forceinline__ void operator()(const Acc& acc, const Unit& u, int wr, int wc, int fr, int fq) const {
        const int row0 = u.pm * BM + wr * 64 + fr, col0 = u.pn * BM + wc * 32 + 8 * fq;
#pragma unroll
        for (int ai = 0; ai < 2; ++ai) {
            u32x4 ga[4][2];
#pragma unroll
            for (int m = 0; m < 4; ++m)
#pragma unroll
                for (int bj = 0; bj < 2; ++bj) ga[m][bj] = *(const u32x4*)(GA + (size_t)(row0 + ai * HALF + m * 16) * ldga + col0 + bj * HALF);
#pragma unroll
            for (int m = 0; m < 4; ++m)
#pragma unroll
                for (int bj = 0; bj < 2; ++bj) {
                    u32x4 w;
#pragma unroll
                    for (int e = 0; e < 4; ++e) {
                        const float s0 = sigmoidf_(bflo(ga[m][bj][e])), s1 = sigmoidf_(bfhi(ga[m][bj][e]));
                        w[e] = cvt_pk_bf16(acc[ai][bj][m][e >> 1][(e & 1) * 2] * s0, acc[ai][bj][m][e >> 1][(e & 1) * 2 + 1] * s1);
                    }
                    *(u32x4*)(Tm + (size_t)(row0 + ai * HALF + m * 16) * D_ + col0 + bj * HALF) = w;
                }
        }
    }
};
struct EpiProjB {
    static constexpr bool PERM = true;
    const bf16_t* GB; int ldgb; const bf16_t* Tm; bf16_t* O;
    __device__ __forceinline__ void operator()(const Acc& acc, const Unit& u, int wr, int wc, int fr, int fq) const {
        const int row0 = u.pm * BM + wr * 64 + fr, col0 = u.pn * BM + wc * 32 + 8 * fq;
#pragma unroll
        for (int ai = 0; ai < 2; ++ai) {
            u32x4 gb[4][2], tv[4][2];
#pragma unroll
            for (int m = 0; m < 4; ++m)
#pragma unroll
                for (int bj = 0; bj < 2; ++bj) { const size_t row = (size_t)(row0 + ai * HALF + m * 16);
                    gb[m][bj] = *(const u32x4*)(GB + row * ldgb + col0 + bj * HALF); tv[m][bj] = *(const u32x4*)(Tm + row * D_ + col0 + bj * HALF); }
#pragma unroll
            for (int m = 0; m < 4; ++m)
#pragma unroll
                for (int bj = 0; bj < 2; ++bj) {
                    u32x4 w;
#pragma unroll
                    for (int e = 0; e < 4; ++e) {
                        const float s0 = sigmoidf_(bflo(gb[m][bj][e])), s1 = sigmoidf_(bfhi(gb[m][bj][e]));
                        w[e] = cvt_pk_bf16(bflo(tv[m][bj][e]) + acc[ai][bj][m][e >> 1][(e & 1) * 2] * s0, bfhi(tv[m][bj][e]) + acc[ai][bj][m][e >> 1][(e & 1) * 2 + 1] * s1);
                    }
                    *(u32x4*)(O + (size_t)(row0 + ai * HALF + m * 16) * D_ + col0 + bj * HALF) = w;
                }
        }
    }
};

template <class Epi>
__device__ __forceinline__ void gemm_phase(LAS unsigned char* lds, const Gemm g, const StaticOrder& S, const Epi& E) {
    const int tid = tid_opaque(), wid = __builtin_amdgcn_readfirstlane(tid >> 6), lane = tid & 63, wr = wid >> 2, wc = wid & 3, fr = lane & 15, fq = lane >> 4;
    const int K = g.K, nt = K / BK;
    unsigned voffA[2], voffB[2];
#pragma unroll
    for (int i = 0; i < 2; ++i) { int R, C; stage_rc(tid * 16 + i * 8192, R, C); const int Rb = Epi::PERM ? ((R & ~31) + perm32(R & 31)) : R;
        voffA[i] = (unsigned)(R * g.lda + C) * 2u; voffB[i] = (unsigned)(Rb * K + C) * 2u; }
    const size_t kstep = (size_t)(BK * 2);
    const size_t hstepA = (size_t)HALF * g.lda * 2, hstepB = (size_t)HALF * K * 2;
    const unsigned ldsw = (unsigned)wid * 1024u;
    const int aoff = lds_byte(wr * 64 + fr, fq * 8), boff = lds_byte(wc * 32 + fr, fq * 8);
#define PG8_SA(b, h) (((b) * 2 + (h)) * HTB)
#define PG8_SB(b, h) ((4 + (b) * 2 + (h)) * HTB)
#define PG8_STAGE_B(bufoff, gbase) do { _Pragma("unroll") for (int _i = 0; _i < 2; ++_i) \
        __builtin_amdgcn_global_load_lds((const unsigned*)((const char*)(gbase) + voffB[_i]), (LAS unsigned*)(lds + (bufoff) + ldsw + _i * 8192), 16, 0, 0); } while (0)
#define PG8_STAGE_A(bufoff, gbase, second) do { _Pragma("unroll") for (int _i = 0; _i < 2; ++_i) \
        __builtin_amdgcn_global_load_lds((const unsigned*)((const char*)(gbase) + voffA[_i]), (LAS unsigned*)(lds + (bufoff) + ldsw + _i * 8192), 16, 0, 0); } while (0)
#define PG8_LDA(dst, b, h) do { _Pragma("unroll") for (int m = 0; m < 4; ++m) _Pragma("unroll") for (int k = 0; k < 2; ++k) dst[m][k] = *(const LAS bf16x8*)(lds + PG8_SA(b, h) + aoff + m * 2048 + k * 1024); } while (0)
#define PG8_LDB(dst, b, h) do { _Pragma("unroll") for (int n = 0; n < 2; ++n) _Pragma("unroll") for (int k = 0; k < 2; ++k) dst[n][k] = *(const LAS bf16x8*)(lds + PG8_SB(b, h) + boff + n * 2048 + k * 1024); } while (0)
#define PG8_MMA(ai, bj, At, Bt) do { __builtin_amdgcn_s_setprio(1); _Pragma("unroll") for (int m = 0; m < 4; ++m) _Pragma("unroll") for (int n = 0; n < 2; ++n) _Pragma("unroll") for (int k = 0; k < 2; ++k) \
        acc[ai][bj][m][n] = __builtin_amdgcn_mfma_f32_16x16x32_bf16(Bt[n][k], At[m][k], acc[ai][bj][m][n], 0, 0, 0); __builtin_amdgcn_s_setprio(0); } while (0)
#define PG8_WAIT_V(n) asm volatile("s_waitcnt vmcnt(" #n ")" ::: "memory")
#define PG8_WAIT_L(n) asm volatile("s_waitcnt lgkmcnt(" #n ")" ::: "memory")
#define PG8_BAR __builtin_amdgcn_s_barrier()
#define PG8_SCHED __builtin_amdgcn_sched_barrier(0)
    Unit cur, nxt; int ui = 0;
    if (!S.next(0, cur)) return;
    Acc acc;
#pragma unroll
    for (int a = 0; a < 2; ++a)
#pragma unroll
        for (int b = 0; b < 2; ++b)
#pragma unroll
            for (int m = 0; m < 4; ++m)
#pragma unroll
                for (int n = 0; n < 2; ++n) acc[a][b][m][n] = (f32x4){0.f, 0.f, 0.f, 0.f};
    bf16x8 At[4][2], B0[2][2], B1[2][2];
    const char* cA = (const char*)g.A + (size_t)cur.pm * 2 * hstepA; const char* cB = (const char*)g.Bt + (size_t)cur.pn * 2 * hstepB;
    PG8_STAGE_B(PG8_SB(0, 0), cB); PG8_STAGE_B(PG8_SB(0, 1), cB + hstepB); PG8_STAGE_A(PG8_SA(0, 0), cA, false); PG8_STAGE_A(PG8_SA(0, 1), cA + hstepA, false);
    if (wr == 1) PG8_BAR;
    PG8_WAIT_V(2); PG8_BAR;
    PG8_STAGE_B(PG8_SB(1, 0), cB + kstep); PG8_STAGE_A(PG8_SA(1, 0), cA + kstep, false); PG8_STAGE_B(PG8_SB(1, 1), cB + hstepB + kstep);
    PG8_WAIT_V(6); PG8_BAR;
    for (;;) {
        const bool has_next = S.next(ui + 1, nxt);
        const char* nA = has_next ? (const char*)g.A + (size_t)nxt.pm * 2 * hstepA : cA; const char* nB = has_next ? (const char*)g.Bt + (size_t)nxt.pn * 2 * hstepB : cB;
        for (int t = 0; t < nt; t += 2) {
            const bool last = (t == nt - 2);
            const char* a1 = cA + (size_t)(t + 1) * kstep;
            const char* a2 = last ? nA : cA + (size_t)(t + 2) * kstep; const char* a3 = a2 + kstep;
            const size_t h1 = hstepA, h2 = hstepA;
            const char* b2 = last ? nB : cB + (size_t)(t + 2) * kstep; const char* b3 = b2 + kstep;
            PG8_LDB(B0, 0, 0); PG8_LDB(B1, 0, 1); PG8_SCHED; PG8_LDA(At, 0, 0); PG8_STAGE_A(PG8_SA(1, 1), a1 + h1, false);
            PG8_WAIT_V(8); PG8_WAIT_L(0); PG8_BAR; PG8_MMA(0, 0, At, B0); PG8_MMA(0, 1, At, B1); PG8_BAR; PG8_SCHED;
            PG8_LDA(At, 0, 1); PG8_STAGE_B(PG8_SB(0, 0), b2); PG8_STAGE_B(PG8_SB(0, 1), b2 + hstepB); PG8_STAGE_A(PG8_SA(0, 0), a2, false);
            PG8_WAIT_V(8); PG8_WAIT_L(0); PG8_BAR; PG8_MMA(1, 0, At, B0); PG8_MMA(1, 1, At, B1); PG8_BAR; PG8_SCHED;
            PG8_LDB(B0, 1, 0); PG8_LDB(B1, 1, 1); PG8_SCHED; PG8_LDA(At, 1, 0); PG8_STAGE_A(PG8_SA(0, 1), a2 + h2, false);
            PG8_WAIT_V(8); PG8_WAIT_L(0); PG8_BAR; PG8_MMA(0, 0, At, B0); PG8_MMA(0, 1, At, B1); PG8_BAR; PG8_SCHED;
            PG8_LDA(At, 1, 1); PG8_STAGE_B(PG8_SB(1, 0), b3); PG8_STAGE_B(PG8_SB(1, 1), b3 + hstepB); PG8_STAGE_A(PG8_SA(1, 0), a3, false);
            PG8_WAIT_V(8); PG8_WAIT_L(0); PG8_BAR; PG8_MMA(1, 0, At, B0); PG8_MMA(1, 1, At, B1); PG8_BAR; PG8_SCHED;
        }
        if (wr == 0) PG8_BAR;
        E(acc, cur, wr, wc, fr, fq);
        if (!has_next) break;
#pragma unroll
        for (int a = 0; a < 2; ++a)
#pragma unroll
            for (int b = 0; b < 2; ++b)
#pragma unroll
                for (int m = 0; m < 4; ++m)
#pragma unroll
                    for (int n = 0; n < 2; ++n) acc[a][b][m][n] = (f32x4){0.f, 0.f, 0.f, 0.f};
        cur = nxt; cA = nA; cB = nB; ++ui;
        if (wr == 1) PG8_BAR;
    }
    PG8_WAIT_V(0);
    PG8_BAR;
#undef PG8_SA
#undef PG8_SB
#undef PG8_STAGE_A
#undef PG8_STAGE_B
#undef PG8_LDA
#undef PG8_LDB
#undef PG8_MMA
#undef PG8_WAIT_V
#undef PG8_WAIT_L
#undef PG8_BAR
#undef PG8_SCHED
}
}

__device__ __forceinline__ void tr_item(const float* __restrict__ W, int N, int k0, int n0, bf16_t* dst, int ldd, LAS float* scr, int lane) {
    { float wv[32];
#pragma unroll
      for (int i = 0; i < 32; ++i) wv[i] = W[(size_t)(k0 + 2 * i + (lane >> 5)) * N + n0 + (lane & 31)];
      __builtin_amdgcn_sched_barrier(0);
#pragma unroll
      for (int i = 0; i < 32; ++i) scr[(2 * i + (lane >> 5)) * 33 + (lane & 31)] = wv[i]; }
    LDS_WAIT();
    const int c = lane & 7;
#pragma unroll
    for (int j = 0; j < 4; ++j) { const int n = (lane >> 3) + 8 * j; const LAS float* s = scr + (8 * c) * 33 + n;
        u32x4 o; o.x = cvt_pk_bf16(s[0 * 33], s[1 * 33]); o.y = cvt_pk_bf16(s[2 * 33], s[3 * 33]); o.z = cvt_pk_bf16(s[4 * 33], s[5 * 33]); o.w = cvt_pk_bf16(s[6 * 33], s[7 * 33]);
        *(u32x4*)(dst + (size_t)n * ldd + 8 * c) = o; }
    LDS_WAIT();
}
__device__ __forceinline__ void convert_ffn(const float* w1, const float* w3, const float* w2, bf16_t* W13, bf16_t* W2, LAS float* scr, int gw, int NGW, int lane) {
    constexpr int I_UP = 32 * 176, I_DN = 88 * 64;
    for (int it = gw; it < 2 * I_UP + I_DN; it += NGW) {
        int r = it;
        if (r < 2 * I_UP) { const int which = r >= I_UP; if (which) r -= I_UP; const int kb = r / 176, nb = r % 176, n0 = nb * 32;
            tr_item(which ? w3 : w1, FF_, kb * 64, n0, W13 + (size_t)((n0 >> 7) * 256 + which * 128 + (n0 & 127)) * 2048 + kb * 64, 2048, scr, lane); }
        else { r -= 2 * I_UP; const int kb = r / 64, nb = r % 64; tr_item(w2, D_, kb * 64, nb * 32, W2 + (size_t)(nb * 32) * FF_ + kb * 64, FF_, scr, lane); }
    }
}
__device__ __forceinline__ void convert_mixer(const Params& p, LAS float* scr, int gw, int NGW, int lane) {
    bf16_t* WIN1 = (bf16_t*)(p.ws + WS_WIN1); bf16_t* WIN2 = (bf16_t*)(p.ws + WS_WIN2); bf16_t* WPAB = (bf16_t*)(p.ws + WS_WPAB); bf16_t* WOUT = (bf16_t*)(p.ws + WS_WOUT);
    constexpr int I_IN = 32 * 577, I_P = 32 * 64;
    for (int it = gw; it < I_IN + 3 * I_P; it += NGW) {
        int r = it;
        if (r < I_IN) { const int kb = r / 577, nb = r % 577, n0 = nb * 32; bf16_t* dst; int drow;
            if (n0 < 6144) { dst = WIN1; drow = n0; }
            else if (n0 < 8192) { dst = WIN2; drow = n0 - 6144; }
            else if (n0 < 8224) { dst = WIN1; drow = 12288 + (n0 - 8192); }
            else if (n0 < 10272) { dst = WIN1; drow = 6144 + (n0 - 8224); }
            else if (n0 < 12320) { dst = WIN1; drow = 8192 + (n0 - 10272); }
            else if (n0 < 14368) { dst = WIN1; drow = 10240 + (n0 - 12320); }
            else if (n0 < 16416) { dst = WIN2; drow = 2048 + (n0 - 14368); }
            else { dst = WIN2; drow = 4096 + (n0 - 16416); }
            tr_item(p.w_in, 18464, kb * 64, n0, dst + (size_t)drow * 2048 + kb * 64, 2048, scr, lane); continue; }
        r -= I_IN;
        const int which = r / I_P; r -= which * I_P; const int kb = r / 64, nb = r % 64;
        if (which == 0) tr_item(p.wpa, D_, kb * 64, nb * 32, WPAB + (size_t)(nb * 32) * 2048 + kb * 64, 2048, scr, lane);
        else if (which == 1) tr_item(p.wpb, D_, kb * 64, nb * 32, WPAB + (size_t)2048 * 2048 + (size_t)(nb * 32) * 2048 + kb * 64, 2048, scr, lane);
        else tr_item(p.wout, D_, kb * 64, nb * 32, WOUT + (size_t)(nb * 32) * 2048 + kb * 64, 2048, scr, lane);
    }
}

__device__ __forceinline__ void phase0(const Params& p, LAS unsigned char* lds) {
    const int tid = tid_opaque(), lane = tid & 63, wave = tid >> 6;
    const int gw = blockIdx.x * 8 + wave, NGW = gridDim.x * 8;
    const int gt = blockIdx.x * 512 + tid, NGT = gridDim.x * 512;
    {
        LAS float* sil = (LAS float*)lds;
        float* ADAP = (float*)(p.ws + WS_ADAP);
        for (int item = blockIdx.x; item < 9 * 32; item += gridDim.x) {
            const int cb = item % 9, ks = item / 9;
            if (tid < 256) { const int b = tid >> 6, kk = tid & 63; sil[tid] = siluf_(p.c[b * D_ + ks * 64 + kk]); }
            __syncthreads();
            const int col = cb * 2048 + tid * 4;
            f32x4 a0 = {0, 0, 0, 0}, a1 = a0, a2 = a0, a3 = a0;
#pragma unroll 1
            for (int kq = 0; kq < 4; ++kq) {
                f32x4 w[16];
#pragma unroll
                for (int kk = 0; kk < 16; ++kk) w[kk] = *(const f32x4*)(p.ada_w + (size_t)(ks * 64 + kq * 16 + kk) * NADA + col);
                __builtin_amdgcn_sched_barrier(0);
#pragma unroll
                for (int kk = 0; kk < 16; ++kk) { const int k2 = kq * 16 + kk; a0 += sil[k2] * w[kk]; a1 += sil[64 + k2] * w[kk]; a2 += sil[128 + k2] * w[kk]; a3 += sil[192 + k2] * w[kk]; }
            }
            *(f32x4*)(ADAP + (size_t)(ks * 4 + 0) * NADA + col) = a0; *(f32x4*)(ADAP + (size_t)(ks * 4 + 1) * NADA + col) = a1;
            *(f32x4*)(ADAP + (size_t)(ks * 4 + 2) * NADA + col) = a2; *(f32x4*)(ADAP + (size_t)(ks * 4 + 3) * NADA + col) = a3;
            __syncthreads();
        }
    }
    LAS float* scr = (LAS float*)(lds + wave * 8448);
    convert_ffn(p.f1w1, p.f1w3, p.f1w2, (bf16_t*)(p.ws + WS_W13), (bf16_t*)(p.ws + WS_W2), scr, gw, NGW, lane);
    convert_mixer(p, scr, gw, NGW, lane);
    { u32x4* z = (u32x4*)(p.ws + WS_WIN1 + (size_t)12320 * 2048 * 2); for (int i = gt; i < 224 * 2048 * 2 / 16; i += NGT) z[i] = (u32x4){0u, 0u, 0u, 0u}; }
    { float* BT = (float*)(p.ws + WS_BT);
      for (int i = gt; i < 16 * 4096; i += NGT) { const int h = i >> 12, d = i & 4095; int bucket;
          if (d < 16) bucket = d; else { const double dd = (double)d, d2 = dd * dd, d4 = d2 * d2, d8 = d4 * d4; int k = 0; double thr = 34359738368.0  ;
              for (int q = 1; q <= 15; ++q) { if (d8 >= thr) k = q; thr *= 8.0; } bucket = 16 + k; if (bucket > 31) bucket = 31; }
          BT[i] = p.rel_bias[bucket * 16 + h] * LOG2E; } }
}
__device__ __forceinline__ void phase_ada_reduce(const Params& p) {
    const int gt = blockIdx.x * 512 + tid_opaque(), NGT = gridDim.x * 512;
    const float* ADAP = (const float*)(p.ws + WS_ADAP); float* ada = (float*)(p.ws + WS_ADA);
    for (int i = gt; i < 4 * NADA; i += NGT) { const int b = i / NADA, n = i - b * NADA; float s = p.ada_b[n];
        for (int ks = 0; ks < 32; ++ks) s += ADAP[(size_t)(ks * 4 + b) * NADA + n];
        ada[i] = s; }
}
__device__ __forceinline__ void phase_normmod(const float* src, const float* gain, const float* ada, int shoff, int scoff, bf16_t* dst) {
    const int tid_ = tid_opaque(); const int lane = tid_ & 63, wave = tid_ >> 6;
    const int gw = blockIdx.x * 8 + wave, NGW = gridDim.x * 8;
    for (int m = gw; m < M_; m += NGW) {
        const f32x4* xr = (const f32x4*)(src + (size_t)m * D_) + lane;
        f32x4 v[8]; float ss = 0.f;
#pragma unroll
        for (int j = 0; j < 8; ++j) { v[j] = xr[64 * j]; ss += (v[j][0] * v[j][0] + v[j][1] * v[j][1]) + (v[j][2] * v[j][2] + v[j][3] * v[j][3]); }
        ss = wave_sum(ss);
        const float rstd = rsqrtf(ss * (1.0f / D_) + 1e-6f);
        const float* ab = ada + (size_t)(m >> 12) * NADA;
#pragma unroll
        for (int j = 0; j < 8; ++j) { const int col = 4 * (lane + 64 * j);
            const f32x4 g = *(const f32x4*)(gain + col), sh = *(const f32x4*)(ab + shoff + col), sc = *(const f32x4*)(ab + scoff + col);
            const f32x4 y = v[j] * rstd * g * (sc + 1.0f) + sh;
            u32x2 w; w.x = cvt_pk_bf16(y[0], y[1]); w.y = cvt_pk_bf16(y[2], y[3]);
            *(u32x2*)(dst + (size_t)m * D_ + col) = w; }
    }
}
__device__ __forceinline__ void phase_halo(const Params& p) {
    const int tid_ = tid_opaque(); const int lane = tid_ & 63, wave = tid_ >> 6;
    const int gw = blockIdx.x * 8 + wave, NGW = gridDim.x * 8;
    const bf16_t* QKV = (const bf16_t*)(p.ws + WS_QKV); bf16_t* HALO = (bf16_t*)(p.ws + WS_HALO);
    for (int r = gw; r < 4 * 16 * 3; r += NGW) {
        const int j = r % 3, tile = (r / 3) & 15, b = r / 48;
        u32x4* d = (u32x4*)(HALO + (size_t)r * 6144);
        if (tile == 0) { for (int i = lane; i < 768; i += 64) d[i] = (u32x4){0u, 0u, 0u, 0u}; }
        else { const u32x4* s = (const u32x4*)(QKV + ((size_t)b * T_ + tile * 256 - 3 + j) * 6144); for (int i = lane; i < 768; i += 64) d[i] = s[i]; }
    }
}
__device__ __forceinline__ void unpack8(const u32x4 w, float* f) {
#pragma unroll
    for (int e = 0; e < 4; ++e) { f[2 * e] = bflo(w[e]); f[2 * e + 1] = bfhi(w[e]); }
}
__device__ __forceinline__ void phase_postproc(const Params& p, LAS unsigned char* lds) {
    const int tid = tid_opaque(), ti = tid >> 3, cg8 = tid & 7, lane = tid & 63, wave = tid >> 6;
    bf16_t* QKV = (bf16_t*)(p.ws + WS_QKV); const bf16_t* HALO = (const bf16_t*)(p.ws + WS_HALO); bf16_t* MB = (bf16_t*)(p.ws + WS_MB); float* BA = (float*)(p.ws + WS_BA);
    float* KM = (float*)(p.ws + WS_KMEAN);
    for (int item = blockIdx.x; item < 4 * 16 * 48; item += gridDim.x) {
        const int s = item % 48, tile = (item / 48) & 15, b = item / 768;
        const int c0 = s * 128 + cg8 * 16; const size_t row0 = (size_t)b * T_ + tile * 256 + ti * 4;
        u32x4 xr[7][2];
#pragma unroll
        for (int j = 0; j < 7; ++j) {
            const bf16_t* src = (ti > 0 || j >= 3) ? QKV + (row0 - 3 + j) * 6144 + c0 : HALO + ((size_t)((b * 16 + tile) * 3) + j) * 6144 + c0;
            xr[j][0] = *(const u32x4*)src; xr[j][1] = *(const u32x4*)(src + 8);
        }
        f32x4 w[4][4];
#pragma unroll
        for (int j = 0; j < 4; ++j)
#pragma unroll
            for (int q = 0; q < 4; ++q) w[j][q] = *(const f32x4*)(p.conv_w + j * 6144 + c0 + 4 * q);
        u32x4 o[4][2];
#pragma unroll
        for (int r = 0; r < 4; ++r) {
            float y[16];
#pragma unroll
            for (int i = 0; i < 16; ++i) y[i] = 0.f;
#pragma unroll
            for (int j = 0; j < 4; ++j) { float xf[16]; unpack8(xr[r + j][0], xf); unpack8(xr[r + j][1], xf + 8);
#pragma unroll
                for (int q = 0; q < 4; ++q)
#pragma unroll
                    for (int e = 0; e < 4; ++e) y[4 * q + e] += w[j][q][e] * xf[4 * q + e]; }
            float ss = 0.f;
#pragma unroll
            for (int i = 0; i < 16; ++i) { y[i] = siluf_(y[i]); ss += y[i] * y[i]; }
            ss += __shfl_xor(ss, 1); ss += __shfl_xor(ss, 2); ss += __shfl_xor(ss, 4);
            float sc = 1.0f;
            if (s < 32) { sc = rsqrtf(ss + 1e-6f); if (s < 16) sc *= QSCALE; }
#pragma unroll
            for (int e = 0; e < 4; ++e) { o[r][0][e] = cvt_pk_bf16(y[2 * e] * sc, y[2 * e + 1] * sc); o[r][1][e] = cvt_pk_bf16(y[8 + 2 * e] * sc, y[8 + 2 * e + 1] * sc); }
        }
        __syncthreads();
#pragma unroll
        for (int r = 0; r < 4; ++r) { bf16_t* dp = QKV + (row0 + r) * 6144 + c0; *(u32x4*)dp = o[r][0]; *(u32x4*)(dp + 8) = o[r][1]; }
    }
    LAS float* red = (LAS float*)lds;
    for (int item = blockIdx.x; item < 4 * 16 * 32; item += gridDim.x) {
        const int hh = item & 31, tile = (item >> 5) & 15, b = item >> 9; const int which = hh >> 4, h = hh & 15;
        bf16_t* dp = MB + (size_t)which * M_ * D_ + ((size_t)b * T_ + tile * 256 + ti * 4) * D_ + h * 128 + cg8 * 16;
        u32x4 xr[4][2];
#pragma unroll
        for (int r = 0; r < 4; ++r) { xr[r][0] = *(const u32x4*)(dp + (size_t)r * D_); xr[r][1] = *(const u32x4*)(dp + (size_t)r * D_ + 8); }
        const float* gp = (which == 0 ? p.qn_g : p.kn_g) + cg8 * 16;
        float gn[16];
#pragma unroll
        for (int i = 0; i < 16; ++i) gn[i] = gp[i] * (which == 0 ? QSCALE * LOG2E : 1.0f);
        float ks[16];
#pragma unroll
        for (int i = 0; i < 16; ++i) ks[i] = 0.f;
#pragma unroll
        for (int r = 0; r < 4; ++r) {
            float xf[16]; unpack8(xr[r][0], xf); unpack8(xr[r][1], xf + 8);
            float ss = 0.f;
#pragma unroll
            for (int i = 0; i < 16; ++i) ss += xf[i] * xf[i];
            ss += __shfl_xor(ss, 1); ss += __shfl_xor(ss, 2); ss += __shfl_xor(ss, 4);
            const float rs = rsqrtf(ss * (1.0f / 128.0f) + 1e-6f);
            u32x4 o0, o1;
#pragma unroll
            for (int i = 0; i < 16; ++i) { xf[i] = xf[i] * rs * gn[i]; ks[i] += xf[i]; }
#pragma unroll
            for (int e = 0; e < 4; ++e) { o0[e] = cvt_pk_bf16(xf[2 * e], xf[2 * e + 1]); o1[e] = cvt_pk_bf16(xf[8 + 2 * e], xf[8 + 2 * e + 1]); }
            *(u32x4*)(dp + (size_t)r * D_) = o0; *(u32x4*)(dp + (size_t)r * D_ + 8) = o1;
        }
        if (which == 1) {
#pragma unroll
            for (int i = 0; i < 16; ++i) { float v = ks[i]; v += __shfl_xor(v, 8); v += __shfl_xor(v, 16); v += __shfl_xor(v, 32); ks[i] = v; }
            if (lane < 8) {
#pragma unroll
                for (int i = 0; i < 16; ++i) red[wave * 128 + lane * 16 + i] = ks[i]; }
            __syncthreads();
            if (tid < 128) { float t = 0.f;
#pragma unroll
                for (int w8 = 0; w8 < 8; ++w8) t += red[w8 * 128 + tid];
                KM[((size_t)((b * 16 + h) * 16 + tile)) * 128 + tid] = t * (1.0f / 256.0f); }
            __syncthreads();
        }
    }
    {
        const int gt = blockIdx.x * 512 + tid, NGT = gridDim.x * 512;
        for (int i = gt; i < M_ * 16; i += NGT) { const int h = i & 15; const size_t r = (size_t)(i >> 4) * 32;
            const float bv = BA[r + h], av = BA[r + 16 + h] + p.dt_bias[h];
            const float sp = fmaxf(av, 0.f) + log1pf(expf(-fabsf(av)));
            BA[r + h] = 1.0f / (1.0f + expf(-bv)); BA[r + 16 + h] = -expf(p.a_log[h]) * sp; }
    }
}

typedef float f32x16 __attribute__((ext_vector_type(16)));
__device__ __forceinline__ unsigned pkbf(float a, float b) { return cvt_pk_bf16(a, b); }
#define MFMA32(a, b, c) __builtin_amdgcn_mfma_f32_32x32x16_bf16((a), (b), (c), 0, 0, 0)
template <int OFF, int ROWQ, int COLT> __device__ __forceinline__ void tr8(unsigned addr, u32x2 (&v)[8]) {
    asm volatile(
        "ds_read_b64_tr_b16 %0, %8 offset:%9\n\t"
        "ds_read_b64_tr_b16 %1, %8 offset:%10\n\t"
        "ds_read_b64_tr_b16 %2, %8 offset:%11\n\t"
        "ds_read_b64_tr_b16 %3, %8 offset:%12\n\t"
        "ds_read_b64_tr_b16 %4, %8 offset:%13\n\t"
        "ds_read_b64_tr_b16 %5, %8 offset:%14\n\t"
        "ds_read_b64_tr_b16 %6, %8 offset:%15\n\t"
        "ds_read_b64_tr_b16 %7, %8 offset:%16\n\t"
        "s_waitcnt lgkmcnt(0)"
        : "=&v"(v[0]), "=&v"(v[1]), "=&v"(v[2]), "=&v"(v[3]), "=&v"(v[4]), "=&v"(v[5]), "=&v"(v[6]), "=&v"(v[7])
        : "v"(addr), "n"(OFF), "n"(OFF + ROWQ), "n"(OFF + COLT), "n"(OFF + COLT + ROWQ), "n"(OFF + 2 * COLT), "n"(OFF + 2 * COLT + ROWQ), "n"(OFF + 3 * COLT), "n"(OFF + 3 * COLT + ROWQ)
        : "memory");
}
__device__ __forceinline__ bf16x8 frag2(const u32x2 a, const u32x2 b) { u32x4 w = {a.x, a.y, b.x, b.y}; return __builtin_bit_cast(bf16x8, w); }
__device__ __forceinline__ bf16x8 pack8(const f32x16& x, int s) {
    u32x4 w = {pkbf(x[8 * s], x[8 * s + 1]), pkbf(x[8 * s + 2], x[8 * s + 3]), pkbf(x[8 * s + 4], x[8 * s + 5]), pkbf(x[8 * s + 6], x[8 * s + 7])};
    return __builtin_bit_cast(bf16x8, w);
}

__device__ __forceinline__ void phase_moba_mfma(const Params& p, LAS unsigned char* lds, unsigned lds_base) {
    constexpr int KST = 272, VST = 320;
    constexpr int OFF_K = 0, OFF_V = 2 * 64 * KST, OFF_KM = OFF_V + 2 * 64 * VST, OFF_BT = OFF_KM + 32 * KST, OFF_UM = OFF_BT + 4096;
    const int tid = tid_opaque(), lane = tid & 63, wave = __builtin_amdgcn_readfirstlane(tid >> 6);
    const int i32 = lane & 31, hh = lane >> 5;
    bf16_t* MBQ = (bf16_t*)(p.ws + WS_MB); const bf16_t* MBK = MBQ + (size_t)M_ * D_; const bf16_t* MBV = MBK + (size_t)M_ * D_;
    const float* KM = (const float*)(p.ws + WS_KMEAN); const float* BT = (const float*)(p.ws + WS_BT);
    const int G = gridDim.x, cblk = blockIdx.x;
    const int lrow = tid >> 3, lc = tid & 7;
    const unsigned vbase = lds_base + OFF_V + (4 * hh + ((lane & 15) >> 2)) * VST + (16 * ((lane >> 4) & 1) + 4 * (lane & 3)) * 2;
    const float NINF = -__builtin_inff();
    for (int k = 0;; ++k) {
        const int it = k * G + ((k & 1) ? (G - 1 - cblk) : cblk);
        if (it >= 1024) break;
        const int qb = 15 - (it >> 6), bh = it & 63, b = bh >> 4, h = bh & 15;
        const size_t rowb = (size_t)b * T_;
        __syncthreads();
        { const int r = tid >> 5, c4 = (tid & 31) * 4; const f32x4 kv = *(const f32x4*)(KM + ((size_t)(bh * 16 + r)) * 128 + c4);
          u32x2 w = {pkbf(kv[0], kv[1]), pkbf(kv[2], kv[3])}; *(LAS u32x2*)(lds + OFF_KM + r * KST + c4 * 2) = w; *(LAS u32x2*)(lds + OFF_KM + (r + 16) * KST + c4 * 2) = (u32x2){0u, 0u}; }
        { LAS float* bts = (LAS float*)(lds + OFF_BT); bts[tid] = BT[h * 4096 + tid]; bts[tid + 512] = BT[h * 4096 + tid + 512]; }
        const float c31 = BT[h * 4096 + 1023];
        const int q0 = qb * 256 + 32 * wave;
        bf16_t* qptr = MBQ + (rowb + q0 + i32) * D_ + h * 128;
        bf16x8 qf[8];
#pragma unroll
        for (int kc = 0; kc < 8; ++kc) qf[kc] = *(const bf16x8*)(qptr + 16 * kc + 8 * hh);
        __syncthreads();
        unsigned sel = 0;
        {
            f32x16 g;
#pragma unroll
            for (int r = 0; r < 16; ++r) g[r] = 0.f;
#pragma unroll
            for (int kc = 0; kc < 8; ++kc) { const bf16x8 a = *(const LAS bf16x8*)(lds + OFF_KM + i32 * KST + (16 * kc + 8 * hh) * 2); g = MFMA32(a, qf[kc], g); }
            float gate[16];
#pragma unroll
            for (int j = 0; j < 16; ++j) { const int half = (j >> 2) & 1, r = (j & 3) + 4 * (j >> 3); const float og = __shfl_xor(g[r], 32); gate[j] = (hh == half) ? g[r] : og; }
#pragma unroll
            for (int rep = 0; rep < 3; ++rep) { float best = NINF; int bi = -1;
#pragma unroll
                for (int j = 0; j < 16; ++j) if (j < qb && !((sel >> j) & 1u) && gate[j] > best) { best = gate[j]; bi = j; }
                if (bi >= 0) sel |= 1u << bi; }
        }
        { unsigned wsel = sel;
#pragma unroll
          for (int o = 1; o < 64; o <<= 1) wsel |= (unsigned)__shfl_xor((int)wsel, o);
          if (lane == 0) ((LAS unsigned*)(lds + OFF_UM))[wave] = wsel; }
        __syncthreads();
        unsigned um = 0;
#pragma unroll
        for (int w = 0; w < 8; ++w) um |= ((const LAS unsigned*)(lds + OFF_UM))[w];
        um = __builtin_amdgcn_readfirstlane(um);

        f32x16 O[4];
#pragma unroll
        for (int dt = 0; dt < 4; ++dt)
#pragma unroll
            for (int r = 0; r < 16; ++r) O[dt][r] = 0.f;
        float m = NINF, l = 0.f;
        int j = qb, kt = 0, buf = 0;
        u32x4 rk0, rk1, rv0, rv1;
#define MOBA_LOAD(jj, kk) do { const size_t r_ = (rowb + (jj) * 256 + (kk) * 64 + lrow) * D_ + h * 128 + lc * 16; rk0 = *(const u32x4*)(MBK + r_); rk1 = *(const u32x4*)(MBK + r_ + 8); rv0 = *(const u32x4*)(MBV + r_); rv1 = *(const u32x4*)(MBV + r_ + 8); } while (0)
#define MOBA_STORE(bb) do { LAS unsigned char* kd = lds + OFF_K + (bb) * 64 * KST + lrow * KST + lc * 32; *(LAS u32x4*)kd = rk0; *(LAS u32x4*)(kd + 16) = rk1; \
        LAS unsigned char* vd = lds + OFF_V + (bb) * 64 * VST + lrow * VST + lc * 32; *(LAS u32x4*)vd = rv0; *(LAS u32x4*)(vd + 16) = rv1; } while (0)
        MOBA_LOAD(j, kt); MOBA_STORE(0); __syncthreads();
        while (j >= 0) {
            int nj = j, nkt = kt + 1;
            if (nkt == 4) { nkt = 0; do { --nj; } while (nj >= 0 && !((um >> nj) & 1u)); }
            if (nj >= 0) MOBA_LOAD(nj, nkt);
            const bool own = (j == qb);
            bool need;
            if (own) need = (kt * 64 <= 32 * wave + 31); else need = (__ballot((sel >> j) & 1u) != 0ull);
            if (need) {
                const LAS unsigned char* Ks = lds + OFF_K + buf * 64 * KST + i32 * KST + 16 * hh;
                f32x16 s0, s1;
#pragma unroll
                for (int r = 0; r < 16; ++r) { s0[r] = 0.f; s1[r] = 0.f; }
#pragma unroll
                for (int kc = 0; kc < 8; ++kc) { const bf16x8 a0 = *(const LAS bf16x8*)(Ks + 32 * kc), a1 = *(const LAS bf16x8*)(Ks + 32 * KST + 32 * kc);
                    s0 = MFMA32(a0, qf[kc], s0); s1 = MFMA32(a1, qf[kc], s1); }
                const int tq = q0 + i32, kbase = j * 256 + kt * 64;
                const bool far = (q0 - (kbase + 63)) >= 790;
                const bool diag = own && (kbase + 63 > q0);
                const bool lsel = own || ((sel >> j) & 1u);
                const int db = tq - kbase - 4 * hh;
                if (far) {
#pragma unroll
                    for (int r = 0; r < 16; ++r) { s0[r] += c31; s1[r] += c31; }
                } else {
                    const LAS float* bp = (const LAS float*)(lds + OFF_BT) + db;
                    float b0[16], b1[16];
#pragma unroll
                    for (int r = 0; r < 16; ++r) { b0[r] = bp[-(8 * (r >> 2) + (r & 3))]; b1[r] = bp[-(32 + 8 * (r >> 2) + (r & 3))]; }
#pragma unroll
                    for (int r = 0; r < 16; ++r) { s0[r] += b0[r]; s1[r] += b1[r]; }
                }
                if (diag) {
#pragma unroll
                    for (int r = 0; r < 16; ++r) { const int d0 = db - (8 * (r >> 2) + (r & 3)); if (d0 < 0) s0[r] = NINF; if (d0 < 32) s1[r] = NINF; }
                }
                float mx = NINF;
#pragma unroll
                for (int r = 0; r < 16; ++r) { if (!lsel) { s0[r] = NINF; s1[r] = NINF; } mx = fmaxf(mx, fmaxf(s0[r], s1[r])); }
                mx = fmaxf(mx, __shfl_xor(mx, 32));
                const float mnew = fmaxf(m, mx);
                const float alpha = __builtin_amdgcn_exp2f(m - mnew);
                float ps = 0.f;
#pragma unroll
                for (int r = 0; r < 16; ++r) { s0[r] = __builtin_amdgcn_exp2f(s0[r] - mnew); s1[r] = __builtin_amdgcn_exp2f(s1[r] - mnew); ps += s0[r] + s1[r]; }
                l = l * alpha + ps; m = mnew;
                if (__ballot(alpha != 1.0f) != 0ull) {
#pragma unroll
                    for (int dt = 0; dt < 4; ++dt)
#pragma unroll
                        for (int r = 0; r < 16; ++r) O[dt][r] *= alpha;
                }
                const unsigned va = vbase + buf * 64 * VST;
                u32x2 v[8];
                { const bf16x8 pf = pack8(s0, 0); tr8<0, 8 * VST, 64>(va, v);
#pragma unroll
                  for (int dt = 0; dt < 4; ++dt) O[dt] = MFMA32(frag2(v[2 * dt], v[2 * dt + 1]), pf, O[dt]); }
                { const bf16x8 pf = pack8(s0, 1); tr8<16 * VST, 8 * VST, 64>(va, v);
#pragma unroll
                  for (int dt = 0; dt < 4; ++dt) O[dt] = MFMA32(frag2(v[2 * dt], v[2 * dt + 1]), pf, O[dt]); }
                { const bf16x8 pf = pack8(s1, 0); tr8<32 * VST, 8 * VST, 64>(va, v);
#pragma unroll
                  for (int dt = 0; dt < 4; ++dt) O[dt] = MFMA32(frag2(v[2 * dt], v[2 * dt + 1]), pf, O[dt]); }
                { const bf16x8 pf = pack8(s1, 1); tr8<48 * VST, 8 * VST, 64>(va, v);
#pragma unroll
                  for (int dt = 0; dt < 4; ++dt) O[dt] = MFMA32(frag2(v[2 * dt], v[2 * dt + 1]), pf, O[dt]); }
            }
            if (nj >= 0) MOBA_STORE(buf ^ 1);
            __syncthreads();
            j = nj; kt = nkt; buf ^= 1;
        }
#undef MOBA_LOAD
#undef MOBA_STORE
        l += __shfl_xor(l, 32);
        const float inv = 1.0f / l;
#pragma unroll
        for (int dt = 0; dt < 4; ++dt)
#pragma unroll
            for (int r4 = 0; r4 < 4; ++r4) {
                u32x2 w = {pkbf(O[dt][4 * r4] * inv, O[dt][4 * r4 + 1] * inv), pkbf(O[dt][4 * r4 + 2] * inv, O[dt][4 * r4 + 3] * inv)};
                *(u32x2*)(qptr + 32 * dt + 4 * hh + 8 * r4) = w;
            }
    }
}


#define MFMA16(a, b, c) __builtin_amdgcn_mfma_f32_16x16x32_bf16((a), (b), (c), 0, 0, 0)
__device__ __forceinline__ void phase_dn_local(const Params& p, LAS unsigned char* lds) {
    const int tid = tid_opaque(), lane = tid & 63, wave = __builtin_amdgcn_readfirstlane(tid >> 6), i32 = lane & 31, hh = lane >> 5;
    LAS unsigned char* wl = lds + wave * 18432;
    LAS float* Am = (LAS float*)wl; LAS bf16_t* Tb = (LAS bf16_t*)wl; LAS bf16_t* Tb2 = (LAS bf16_t*)(wl + 8192);
    LAS float* gcs = (LAS float*)(wl + 16384); LAS float* bes = gcs + 64;
    bf16_t* QKV = (bf16_t*)(p.ws + WS_QKV); float* BA = (float*)(p.ws + WS_BA); bf16_t* WDN = (bf16_t*)(p.ws + WS_WDN); bf16_t* QKb = (bf16_t*)(p.ws + WS_QK);
    const int gw = blockIdx.x * 8 + wave, NGW = gridDim.x * 8;
    const unsigned fo6 = (unsigned)(i32 * 6144 + 8 * hh);
    const unsigned go6 = (unsigned)(8 * hh * 6144 + i32);
    const unsigned so6 = (unsigned)(4 * hh * 6144 + i32);
    const unsigned so2 = (unsigned)(4 * hh * D_ + i32);
    const unsigned soq = (unsigned)(4 * hh * 64 + i32);
    for (int ch = gw; ch < 4096; ch += NGW) {
        const int n = ch & 63, bh = ch >> 6, b = bh >> 4, h = bh & 15;
        const size_t r0 = (size_t)b * T_ + n * 64;
        float* bap = BA + r0 * 32 + h;
        const float be = bap[lane * 32];
        float gc = bap[lane * 32 + 16];
        { int ln = lane; asm volatile("" : "+v"(ln));
#pragma unroll
          for (int o = 1; o < 64; o <<= 1) { const float t = __shfl(gc, (ln - o) & 63); if (ln >= o) gc += t; } }
        gcs[lane] = gc; bes[lane] = be;
        bf16_t* kslab = QKV + r0 * 6144 + 2048 + h * 128;
        bf16_t* vslab = QKV + r0 * 6144 + 4096 + h * 128;
        const bf16_t* qslab = QKV + r0 * 6144 + h * 128;
        LDS_WAIT();
        const float gcj0 = gcs[i32], gcj1 = gcs[32 + i32];
        {
            f32x16 a00, a10, a11; bf16x8 kk0[8], kk1[8];
#pragma unroll
            for (int r = 0; r < 16; ++r) { a00[r] = 0.f; a10[r] = 0.f; a11[r] = 0.f; }
#pragma unroll
            for (int kc = 0; kc < 8; ++kc) { kk0[kc] = *(const bf16x8*)(kslab + 16 * kc + fo6); kk1[kc] = *(const bf16x8*)(kslab + 32 * 6144 + 16 * kc + fo6); }
            __builtin_amdgcn_sched_barrier(0);
#pragma unroll
            for (int kc = 0; kc < 8; ++kc) { a00 = MFMA32(kk0[kc], kk0[kc], a00); a10 = MFMA32(kk1[kc], kk0[kc], a10); a11 = MFMA32(kk1[kc], kk1[kc], a11); }
            const LAS float* gcl = gcs + 4 * hh; const LAS float* bel = bes + 4 * hh; LAS float* aml = Am + soq;
#pragma unroll
            for (int r = 0; r < 16; ++r) {
                const int ic = (r & 3) + 8 * (r >> 2);
                const float gi0 = gcl[ic], gi1 = gcl[32 + ic], bi0 = bel[ic], bi1 = bel[32 + ic];
                aml[ic * 64] = bi0 * a00[r] * __expf(fminf(gi0 - gcj0, 0.f));
                aml[(32 + ic) * 64] = bi1 * a10[r] * __expf(fminf(gi1 - gcj0, 0.f));
                aml[(32 + ic) * 64 + 32] = bi1 * a11[r] * __expf(fminf(gi1 - gcj1, 0.f));
            }
        }
        LDS_WAIT();
        {
            float T[64];
            f32x4 ra[16];
#define DN_LOADROW(i_, buf_) do { _Pragma("unroll") for (int j4 = 0; j4 < ((i_) + 3) / 4; ++j4) buf_[j4] = *(const LAS f32x4*)(Am + (i_) * 64 + 4 * j4); } while (0)
#define DN_ROW(i_, buf_) do { float c0 = 0.f, c1 = 0.f, c2 = 0.f, c3 = 0.f; \
                _Pragma("unroll") for (int j4 = 0; j4 < ((i_) + 3) / 4; ++j4) { \
                    if (4 * j4 + 0 < (i_)) c0 += buf_[j4][0] * T[4 * j4 + 0]; if (4 * j4 + 1 < (i_)) c1 += buf_[j4][1] * T[4 * j4 + 1]; \
                    if (4 * j4 + 2 < (i_)) c2 += buf_[j4][2] * T[4 * j4 + 2]; if (4 * j4 + 3 < (i_)) c3 += buf_[j4][3] * T[4 * j4 + 3]; } \
                T[i_] = ((lane == (i_)) ? 1.0f : 0.0f) - ((c0 + c1) + (c2 + c3)); } while (0)
#pragma unroll
            for (int i = 0; i < 64; ++i) {
                DN_LOADROW(i, ra); asm volatile("" ::: "memory");
                DN_ROW(i, ra);
                asm volatile("" ::: "memory");
            }
#undef DN_LOADROW
#undef DN_ROW
            LDS_WAIT();
            const float eg = __expf(gc);
#pragma unroll
            for (int i = 0; i < 64; ++i) { const float tp = T[i] * be; Tb[i * 64 + lane] = f2bf(tp); Tb2[i * 64 + lane] = f2bf(tp * eg); }
        }
        LDS_WAIT();
#define DN_TMUL(TBUF, SRC, DST, DSTLD, SOFF) do { \
            _Pragma("unroll 1") for (int dt = 0; dt < 4; ++dt) { \
                f32x16 u0, u1; \
                _Pragma("unroll") for (int r = 0; r < 16; ++r) { u0[r] = 0.f; u1[r] = 0.f; } \
                unsigned short rw[4][8]; \
                _Pragma("unroll") for (int jc = 0; jc < 4; ++jc) _Pragma("unroll") for (int e = 0; e < 8; ++e) rw[jc][e] = ((SRC) + (16 * jc + e) * 6144 + 32 * dt)[go6]; \
                __builtin_amdgcn_sched_barrier(0);     \
                _Pragma("unroll") for (int jc = 0; jc < 4; ++jc) { \
                    bf16x8 vb; \
                    _Pragma("unroll") for (int e = 0; e < 8; ++e) vb[e] = (short)rw[jc][e]; \
                    const bf16x8 ta0 = *(const LAS bf16x8*)((const LAS unsigned char*)(TBUF) + ((i32) * 64 + 16 * jc + 8 * hh) * 2); \
                    const bf16x8 ta1 = *(const LAS bf16x8*)((const LAS unsigned char*)(TBUF) + ((32 + i32) * 64 + 16 * jc + 8 * hh) * 2); \
                    u0 = MFMA32(ta0, vb, u0); u1 = MFMA32(ta1, vb, u1); } \
                asm volatile("" ::: "memory"); \
                _Pragma("unroll") for (int r = 0; r < 16; ++r) { \
                    ((DST) + ((r & 3) + 8 * (r >> 2)) * (DSTLD) + 32 * dt)[SOFF] = f2bf(u0[r]); \
                    ((DST) + (32 + (r & 3) + 8 * (r >> 2)) * (DSTLD) + 32 * dt)[SOFF] = f2bf(u1[r]); } \
                asm volatile("" ::: "memory"); } } while (0)
        DN_TMUL(Tb, vslab, vslab, 6144, so6);
        { bf16_t* wslab = WDN + r0 * D_ + h * 128; DN_TMUL(Tb2, kslab, wslab, D_, so2); }
#undef DN_TMUL
        {
            bf16x8 kf[2][8];
#pragma unroll
            for (int it = 0; it < 2; ++it)
#pragma unroll
                for (int kc = 0; kc < 8; ++kc) kf[it][kc] = *(const bf16x8*)(kslab + 32 * it * 6144 + 16 * kc + fo6);
            f32x16 q00, q10, q11; bf16x8 qa0[4], qa1[4];
#pragma unroll
            for (int r = 0; r < 16; ++r) { q00[r] = 0.f; q10[r] = 0.f; q11[r] = 0.f; }
#pragma unroll
            for (int kh = 0; kh < 2; ++kh) {
#pragma unroll
                for (int kc = 0; kc < 4; ++kc) { qa0[kc] = *(const bf16x8*)(qslab + 16 * (4 * kh + kc) + fo6); qa1[kc] = *(const bf16x8*)(qslab + 32 * 6144 + 16 * (4 * kh + kc) + fo6); }
                __builtin_amdgcn_sched_barrier(0);
#pragma unroll
                for (int kc = 0; kc < 4; ++kc) { q00 = MFMA32(qa0[kc], kf[0][4 * kh + kc], q00); q10 = MFMA32(qa1[kc], kf[0][4 * kh + kc], q10); q11 = MFMA32(qa1[kc], kf[1][4 * kh + kc], q11); }
                __builtin_amdgcn_sched_barrier(0);
            }
            asm volatile("" ::: "memory");
            bf16_t* qkc = QKb + (size_t)ch * 4096;
            const LAS float* gcl = gcs + 4 * hh;
#pragma unroll
            for (int r = 0; r < 16; ++r) {
                const int ic = (r & 3) + 8 * (r >> 2);
                const float gi0 = gcl[ic], gi1 = gcl[32 + ic];
                const bool low = (ic + 4 * hh >= i32);
                (qkc + ic * 64)[soq] = f2bf(low ? q00[r] * __expf(fminf(gi0 - gcj0, 0.f)) : 0.f);
                (qkc + ic * 64 + 32)[soq] = (bf16_t)0;
                (qkc + (32 + ic) * 64)[soq] = f2bf(q10[r] * __expf(fminf(gi1 - gcj0, 0.f)));
                (qkc + (32 + ic) * 64 + 32)[soq] = f2bf(low ? q11[r] * __expf(fminf(gi1 - gcj1, 0.f)) : 0.f);
            }
            asm volatile("" ::: "memory");
#pragma unroll
            for (int it = 0; it < 2; ++it)
#pragma unroll
                for (int kc = 0; kc < 8; ++kc) {
#pragma unroll
                    for (int e = 0; e < 8; ++e) (kslab + (8 * kc + (e >> 1)) * 6144 + (e & 1) * 64 + 32 * it)[so6] = (bf16_t)kf[it][kc][e];
                    asm volatile("" ::: "memory"); }
        }
        bap[lane * 32 + 16] = gc;
        LDS_WAIT();
    }
}
__device__ __forceinline__ bf16x8 pack44(const f32x4 a, const f32x4 b) { u32x4 w = {pkbf(a[0], a[1]), pkbf(a[2], a[3]), pkbf(b[0], b[1]), pkbf(b[2], b[3])}; return __builtin_bit_cast(bf16x8, w); }

__device__ __forceinline__ bf16x8 ldl44(const LAS unsigned char* p0) { const u32x2 a = *(const LAS u32x2*)p0, b = *(const LAS u32x2*)(p0 + 32); u32x4 w = {a.x, a.y, b.x, b.y}; return __builtin_bit_cast(bf16x8, w); }
#define SC_BAR() do { asm volatile("s_waitcnt lgkmcnt(0)" ::: "memory"); __builtin_amdgcn_s_barrier(); asm volatile("" ::: "memory"); } while (0)
__device__ __forceinline__ void phase_dn_scan3(const Params& p, LAS unsigned char* lds) {
    constexpr int WP = 272, KP = 144, QP = 144, UP = 80;
    constexpr int O_W = 0, O_Q = O_W + 64 * WP, O_KT = O_Q + 64 * WP, O_QK = O_KT + 128 * KP, O_U = O_QK + 64 * QP, O_GC = O_U + 64 * UP, BUF = O_GC + 256;
    static_assert(2 * BUF <= LDS_BYTES, "scan LDS image");
    const int tid = tid_opaque(), lane = tid & 63, wave = __builtin_amdgcn_readfirstlane(tid >> 6), i16 = lane & 15, g4 = lane >> 4;
    bf16_t* QKV = (bf16_t*)(p.ws + WS_QKV); const float* BA = (const float*)(p.ws + WS_BA); const bf16_t* WDN = (const bf16_t*)(p.ws + WS_WDN); const bf16_t* QKb = (const bf16_t*)(p.ws + WS_QK);
    for (int item = blockIdx.x; item < 256; item += gridDim.x) {
        const int xc = item & 7, sl = item >> 3, dvq = sl & 3, bh = (sl >> 2) * 8 + xc, b = bh >> 4, h = bh & 15;
        const size_t rowb = (size_t)b * T_;
        __syncthreads();
        if (wave >= 2) {
            const int lt = tid - 128;
            const int p0 = lt, p1 = lt + 384, p2 = (lt + 768 < 1024) ? lt + 768 : lt, q1 = (lt + 384 < 512) ? lt + 384 : lt, pu = lt & 255;
            const unsigned gw0 = (unsigned)((p0 >> 4) * (D_ * 2) + (p0 & 15) * 16), gw1 = (unsigned)((p1 >> 4) * (D_ * 2) + (p1 & 15) * 16), gw2 = (unsigned)((p2 >> 4) * (D_ * 2) + (p2 & 15) * 16);
            const unsigned g60 = (unsigned)((p0 >> 4) * 12288 + (p0 & 15) * 16), g61 = (unsigned)((p1 >> 4) * 12288 + (p1 & 15) * 16), g62 = (unsigned)((p2 >> 4) * 12288 + (p2 & 15) * 16);
            const unsigned lw0 = (unsigned)((p0 >> 4) * WP + (p0 & 15) * 16), lw1 = (unsigned)((p1 >> 4) * WP + (p1 & 15) * 16), lw2 = (unsigned)((p2 >> 4) * WP + (p2 & 15) * 16);
            const unsigned lk0 = (unsigned)((2 * (p0 >> 4) + ((p0 >> 3) & 1)) * KP + (p0 & 7) * 16), lk1 = (unsigned)((2 * (p1 >> 4) + ((p1 >> 3) & 1)) * KP + (p1 & 7) * 16), lk2 = (unsigned)((2 * (p2 >> 4) + ((p2 >> 3) & 1)) * KP + (p2 & 7) * 16);
            const unsigned gq0 = (unsigned)(p0 * 16), gq1 = (unsigned)(q1 * 16);
            const unsigned lq0 = (unsigned)((p0 >> 3) * QP + (p0 & 7) * 16), lq1 = (unsigned)((q1 >> 3) * QP + (q1 & 7) * 16);
            const unsigned gu0 = (unsigned)((pu >> 2) * 12288 + (pu & 3) * 16), lu0 = (unsigned)((pu >> 2) * UP + (pu & 3) * 16);
            const char* Wg = (const char*)(WDN + rowb * D_ + h * 128);
            const char* Qg = (const char*)(QKV + rowb * 6144 + h * 128);
            const char* Kg = (const char*)(QKV + rowb * 6144 + 2048 + h * 128);
            const char* Ug = (const char*)(QKV + rowb * 6144 + 4096 + h * 128 + dvq * 32);
            const char* QKg = (const char*)(QKb + (size_t)(bh * 64) * 4096);
            const float* gcp = BA + (rowb + (lt & 63)) * 32 + 16 + h;
            u32x4 dA[12], dB[12], dC[12]; float gA = 0.f, gB = 0.f, gC = 0.f;
#define SC_LOAD(D, GV, n) do { const char* w_ = Wg + (size_t)(n) * (64 * D_ * 2); const char* q_ = Qg + (size_t)(n) * (64 * 12288); const char* k_ = Kg + (size_t)(n) * (64 * 12288); \
                const char* u_ = Ug + (size_t)(n) * (64 * 12288); const char* qk_ = QKg + (size_t)(n) * 8192; \
                D[0] = *(const u32x4*)(w_ + gw0); D[1] = *(const u32x4*)(w_ + gw1); D[2] = *(const u32x4*)(w_ + gw2); \
                D[3] = *(const u32x4*)(q_ + g60); D[4] = *(const u32x4*)(q_ + g61); D[5] = *(const u32x4*)(q_ + g62); \
                D[6] = *(const u32x4*)(k_ + g60); D[7] = *(const u32x4*)(k_ + g61); D[8] = *(const u32x4*)(k_ + g62); \
                D[9] = *(const u32x4*)(qk_ + gq0); D[10] = *(const u32x4*)(qk_ + gq1); D[11] = *(const u32x4*)(u_ + gu0); \
                GV = gcp[(size_t)(n) * 2048]; } while (0)
#define SC_STORE(D, GV, bb) do { LAS unsigned char* bp = lds + (bb) * BUF; \
                *(LAS u32x4*)(bp + O_W + lw0) = D[0]; *(LAS u32x4*)(bp + O_W + lw1) = D[1]; *(LAS u32x4*)(bp + O_W + lw2) = D[2]; \
                *(LAS u32x4*)(bp + O_Q + lw0) = D[3]; *(LAS u32x4*)(bp + O_Q + lw1) = D[4]; *(LAS u32x4*)(bp + O_Q + lw2) = D[5]; \
                *(LAS u32x4*)(bp + O_KT + lk0) = D[6]; *(LAS u32x4*)(bp + O_KT + lk1) = D[7]; *(LAS u32x4*)(bp + O_KT + lk2) = D[8]; \
                *(LAS u32x4*)(bp + O_QK + lq0) = D[9]; *(LAS u32x4*)(bp + O_QK + lq1) = D[10]; *(LAS u32x4*)(bp + O_U + lu0) = D[11]; \
                ((LAS float*)(bp + O_GC))[lt & 63] = GV; } while (0)
#define SC_CL(n) ((n) < 64 ? (n) : 63)
#define SC_STEP(D, GV, t, bb) do { if ((t) < 64) { if ((t) + 1 < 64) SC_STORE(D, GV, bb); SC_LOAD(D, GV, SC_CL((t) + 4)); SC_BAR(); } } while (0)
            SC_LOAD(dA, gA, 0); SC_STORE(dA, gA, 0);
            SC_LOAD(dA, gA, 1); SC_LOAD(dB, gB, 2); SC_LOAD(dC, gC, 3);
            SC_BAR();
#pragma unroll 1
            for (int n = 0; n < 64; n += 6) {
                SC_STEP(dA, gA, n, 1); SC_STEP(dB, gB, n + 1, 0); SC_STEP(dC, gC, n + 2, 1);
                SC_STEP(dA, gA, n + 3, 0); SC_STEP(dB, gB, n + 4, 1); SC_STEP(dC, gC, n + 5, 0);
            }
#undef SC_STEP
#undef SC_CL
#undef SC_LOAD
#undef SC_STORE
        } else {
            f32x4 S[8];
#pragma unroll
            for (int dt = 0; dt < 8; ++dt) S[dt] = (f32x4){0.f, 0.f, 0.f, 0.f};
            SC_BAR();
#pragma unroll 1
            for (int n = 0; n < 64; ++n) {
                const LAS unsigned char* bp = lds + (n & 1) * BUF;
                const LAS unsigned char* wr_ = bp + O_W + i16 * WP + 8 * g4;
                const LAS unsigned char* qr_ = bp + O_Q + i16 * WP + 8 * g4;
                const LAS unsigned char* qkr = bp + O_QK + i16 * QP + 8 * g4;
                const LAS unsigned char* ktr = bp + O_KT + i16 * KP + 8 * g4;
                const LAS unsigned char* ur = bp + O_U + (4 * g4) * UP + (wave * 16 + i16) * 2;
                const LAS float* gcl = (const LAS float*)(bp + O_GC) + 4 * g4;
                const float gl = ((const LAS float*)(bp + O_GC))[63];
                bf16_t* uo = QKV + (rowb + n * 64 + 4 * g4) * 6144 + 4096 + h * 128 + dvq * 32 + wave * 16 + i16;
                bf16x8 wf[4][4], qf4[4][4];
#pragma unroll
                for (int mt = 0; mt < 4; ++mt)
#pragma unroll
                    for (int kc = 0; kc < 4; ++kc) { wf[mt][kc] = ldl44(wr_ + 16 * mt * WP + 64 * kc); qf4[mt][kc] = ldl44(qr_ + 16 * mt * WP + 64 * kc); }
                asm volatile("" ::: "memory");
                bf16x8 sb[4];
#pragma unroll
                for (int kc = 0; kc < 4; ++kc) sb[kc] = pack44(S[2 * kc], S[2 * kc + 1]);
                f32x4 ws4[4], qs4[4];
#pragma unroll
                for (int mt = 0; mt < 4; ++mt) { ws4[mt] = (f32x4){0.f, 0.f, 0.f, 0.f}; qs4[mt] = ws4[mt]; }
#pragma unroll
                for (int kc = 0; kc < 4; ++kc)
#pragma unroll
                    for (int mt = 0; mt < 4; ++mt) { ws4[mt] = MFMA16(wf[mt][kc], sb[kc], ws4[mt]); qs4[mt] = MFMA16(qf4[mt][kc], sb[kc], qs4[mt]); }
                bf16x8 qkf[4][2], ktf[8][2];
#pragma unroll
                for (int mt = 0; mt < 4; ++mt) { qkf[mt][0] = ldl44(qkr + 16 * mt * QP); qkf[mt][1] = ldl44(qkr + 16 * mt * QP + 64); }
#pragma unroll
                for (int dt = 0; dt < 8; ++dt) { ktf[dt][0] = ldl44(ktr + 16 * dt * KP); ktf[dt][1] = ldl44(ktr + 16 * dt * KP + 64); }
                float gcv[4][4], uu[4][4];
#pragma unroll
                for (int mt = 0; mt < 4; ++mt)
#pragma unroll
                    for (int r = 0; r < 4; ++r) { gcv[mt][r] = gcl[16 * mt + r]; uu[mt][r] = bf2f(*(const LAS bf16_t*)(ur + (16 * mt + r) * UP)); }
                asm volatile("" ::: "memory");
                f32x4 vn[4], vs[4], eg[4];
#pragma unroll
                for (int mt = 0; mt < 4; ++mt)
#pragma unroll
                    for (int r = 0; r < 4; ++r) { eg[mt][r] = __expf(gcv[mt][r]); vn[mt][r] = uu[mt][r] - ws4[mt][r]; vs[mt][r] = vn[mt][r] * __expf(gl - gcv[mt][r]); }
                const bf16x8 vb10 = pack44(vn[0], vn[1]), vb11 = pack44(vn[2], vn[3]), vb20 = pack44(vs[0], vs[1]), vb21 = pack44(vs[2], vs[3]);
#pragma unroll
                for (int mt = 0; mt < 4; ++mt) { f32x4 o = qs4[mt] * eg[mt];
                    o = MFMA16(qkf[mt][0], vb10, o); o = MFMA16(qkf[mt][1], vb11, o);
#pragma unroll
                    for (int r = 0; r < 4; ++r) uo[(size_t)(16 * mt + r) * 6144] = f2bf(o[r]); }
                const float egl = __expf(gl);
#pragma unroll
                for (int dt = 0; dt < 8; ++dt) { f32x4 sn = S[dt] * egl; sn = MFMA16(ktf[dt][0], vb20, sn); sn = MFMA16(ktf[dt][1], vb21, sn); S[dt] = sn; }
                SC_BAR();
            }
        }
    }
}


__device__ __forceinline__ void phase_ba(const Params& p, LAS unsigned char* lds) {
    const int tid = tid_opaque(), lane = tid & 63, wave = __builtin_amdgcn_readfirstlane(tid >> 6), i32 = lane & 31, hh = lane >> 5;
    const bf16_t* U = (const bf16_t*)(p.ws + WS_U); const bf16_t* Wb = (const bf16_t*)(p.ws + WS_WIN1) + (size_t)12288 * 2048; float* BA = (float*)(p.ws + WS_BA);
    LAS float* red = (LAS float*)lds;
    for (int item = blockIdx.x; item < 256; item += gridDim.x) {
        const size_t row0 = (size_t)item * 64;
        f32x16 a0, a1;
#pragma unroll
        for (int r = 0; r < 16; ++r) { a0[r] = 0.f; a1[r] = 0.f; }
        const bf16_t* bp = Wb + (size_t)i32 * 2048 + 256 * wave + 8 * hh;
        const bf16_t* ap = U + (row0 + i32) * D_ + 256 * wave + 8 * hh;
#pragma unroll
        for (int kb = 0; kb < 2; ++kb) {
            bf16x8 bfr[8], af0[8], af1[8];
#pragma unroll
            for (int ks = 0; ks < 8; ++ks) { bfr[ks] = *(const bf16x8*)(bp + 16 * (8 * kb + ks)); af0[ks] = *(const bf16x8*)(ap + 16 * (8 * kb + ks)); af1[ks] = *(const bf16x8*)(ap + (size_t)32 * D_ + 16 * (8 * kb + ks)); }
            __builtin_amdgcn_sched_barrier(0);
#pragma unroll
            for (int ks = 0; ks < 8; ++ks) { a0 = MFMA32(af0[ks], bfr[ks], a0); a1 = MFMA32(af1[ks], bfr[ks], a1); }
        }
        __syncthreads();
#pragma unroll
        for (int r = 0; r < 16; ++r) { red[((wave * 2 + 0) * 16 + r) * 64 + lane] = a0[r]; red[((wave * 2 + 1) * 16 + r) * 64 + lane] = a1[r]; }
        __syncthreads();
#pragma unroll
        for (int q = 0; q < 4; ++q) { const int idx = tid + 512 * q, mt = idx >> 10, r = (idx >> 6) & 15, ln = idx & 63; float t = 0.f;
#pragma unroll
            for (int w8 = 0; w8 < 8; ++w8) t += red[((w8 * 2 + mt) * 16 + r) * 64 + ln];
            BA[(row0 + 32 * mt + (r & 3) + 8 * (r >> 2) + 4 * (ln >> 5)) * 32 + (ln & 31)] = t; }
    }
}

__device__ __forceinline__ void phase_ya(const Params& p) {
    const int tid_ = tid_opaque(); const int lane = tid_ & 63, wave = tid_ >> 6;
    const int gw = blockIdx.x * 8 + wave, NGW = gridDim.x * 8;
    bf16_t* QKV = (bf16_t*)(p.ws + WS_QKV);
    const int e8 = lane & 15;
    float gn[8];
#pragma unroll
    for (int i = 0; i < 8; ++i) gn[i] = p.dn_norm_g[e8 * 8 + i];
    for (int it = gw; it < M_ * 16 / 4; it += 2 * NGW) {
        const int it2 = it + NGW; const bool v2 = it2 < M_ * 16 / 4;
        const int pairA = it * 4 + (lane >> 4), pairB = (v2 ? it2 : it) * 4 + (lane >> 4);
        bf16_t* opA = QKV + (size_t)(pairA >> 4) * 6144 + 4096 + (pairA & 15) * 128 + e8 * 8; const bf16_t* zpA = opA - 4096;
        bf16_t* opB = QKV + (size_t)(pairB >> 4) * 6144 + 4096 + (pairB & 15) * 128 + e8 * 8; const bf16_t* zpB = opB - 4096;
        const u32x4 oA = *(const u32x4*)opA, zA = *(const u32x4*)zpA, oB = *(const u32x4*)opB, zB = *(const u32x4*)zpB;
#pragma unroll
        for (int half = 0; half < 2; ++half) {
            float of[8], zf[8]; unpack8(half ? oB : oA, of); unpack8(half ? zB : zA, zf);
            float ss = 0.f;
#pragma unroll
            for (int i = 0; i < 8; ++i) ss += of[i] * of[i];
            ss += __shfl_xor(ss, 1); ss += __shfl_xor(ss, 2); ss += __shfl_xor(ss, 4); ss += __shfl_xor(ss, 8);
            const float rs = rsqrtf(ss * (1.0f / 128.0f) + 1e-6f);
            u32x4 w;
#pragma unroll
            for (int e = 0; e < 4; ++e) w[e] = cvt_pk_bf16(of[2 * e] * rs * gn[2 * e] * siluf_(zf[2 * e]), of[2 * e + 1] * rs * gn[2 * e + 1] * siluf_(zf[2 * e + 1]));
            if (half == 0) *(u32x4*)opA = w; else if (v2) *(u32x4*)opB = w;
        }
    }
}


#define XB_TMO      128
#define XB_XCNT(j)  (256  + 64 * (j))
#define XB_XSUB(j)  (1280 + 64 * (j))
#define XB_XGEN(j)  (2304 + 64 * (j))
#define XB_TOP      3328
#define XB_TOPGEN   3392
#define XCD_BAR_WORDS 3456
#define XB_SPIN_CAP (1u << 18)
__device__ __forceinline__ unsigned xb_ld(unsigned* p)              { return __hip_atomic_load(p, __ATOMIC_RELAXED, __HIP_MEMORY_SCOPE_AGENT); }
__device__ __forceinline__ unsigned xb_add(unsigned* p, unsigned v) { return __hip_atomic_fetch_add(p, v, __ATOMIC_RELAXED, __HIP_MEMORY_SCOPE_AGENT); }
__device__ __forceinline__ unsigned xb_xcc_id() { return (unsigned)__builtin_amdgcn_s_getreg((3 << 11) | 20) & 0xFu; }
#define XB_SPIN(cond, bar) do { unsigned _sp = 0; while (cond) { __builtin_amdgcn_s_sleep(1); \
    if ((++_sp & 255u) == 0u) { if (xb_ld(&(bar)[XB_TMO])) break; if (_sp > XB_SPIN_CAP) { atomicAdd(&(bar)[XB_TMO], 1u); break; } } } } while (0)
struct XcdBarrier { unsigned* bar; unsigned x; volatile LAS unsigned* st; };
__device__ __forceinline__ XcdBarrier xcd_barrier_post(unsigned* bar, volatile LAS unsigned* st) {
    XcdBarrier b; b.bar = bar; b.x = xb_xcc_id(); b.st = st;
    if (threadIdx.x == 0) (void)xb_add(&bar[XB_XCNT(b.x)], 1u);
    return b;
}
__device__ __forceinline__ void xcd_barrier_complete(unsigned* bar, unsigned x, unsigned& nloc, unsigned& nx) {
    const unsigned G = gridDim.x * gridDim.y * gridDim.z;
    unsigned sum, cnt, mine, sp = 0u;
    for (;;) {
        sum = 0u; cnt = 0u; mine = 0u;
#pragma unroll
        for (unsigned j = 0; j < 16; ++j) { const unsigned c = xb_ld(&bar[XB_XCNT(j)]); sum += c; cnt += (c > 0u) ? 1u : 0u; mine = (j == x) ? c : mine; }
        if (sum == G) break;
        __builtin_amdgcn_s_sleep(1);
        if ((++sp & 255u) == 0u) { if (xb_ld(&bar[XB_TMO])) break; if (sp > XB_SPIN_CAP) { atomicAdd(&bar[XB_TMO], 1u); break; } }
    }
    nloc = mine > 0u ? mine : 1u; nx = cnt > 0u ? cnt : 1u;
}
__device__ __forceinline__ void xcd_barrier(const XcdBarrier& b) {
    asm volatile("s_waitcnt vmcnt(0)" ::: "memory");
    __syncthreads();
    if (threadIdx.x == 0) {
        unsigned* bar = b.bar;
        __builtin_amdgcn_s_waitcnt(0);
        unsigned nloc = b.st[0], nx = b.st[1];
        if (nloc == 0u) { xcd_barrier_complete(bar, b.x, nloc, nx); b.st[0] = nloc; b.st[1] = nx; }
        const unsigned old = xb_add(&bar[XB_XSUB(b.x)], 1u);
        const unsigned gen = old / nloc;
        if (old + 1u == (gen + 1u) * nloc) {
            __builtin_amdgcn_fence(__ATOMIC_RELEASE, "agent");
            asm volatile("s_waitcnt vmcnt(0)" ::: "memory");
            const unsigned og = xb_add(&bar[XB_TOP], 1u);
            const unsigned tg = og / nx;
            if (og + 1u == (tg + 1u) * nx) xb_add(&bar[XB_TOPGEN], 1u);
            else XB_SPIN(xb_ld(&bar[XB_TOPGEN]) == tg, bar);
            __builtin_amdgcn_fence(__ATOMIC_ACQUIRE, "agent");
            xb_add(&bar[XB_XGEN(b.x)], 1u);
            asm volatile("s_waitcnt vmcnt(0)" ::: "memory");
        } else {
            XB_SPIN(xb_ld(&bar[XB_XGEN(b.x)]) == gen, bar);
            __builtin_amdgcn_fence(__ATOMIC_ACQUIRE, "agent");
            asm volatile("s_waitcnt vmcnt(0)" ::: "memory");
        }
    }
    __syncthreads();
}

__global__ void __launch_bounds__(512, 2) fwd_megakernel(Params p) {
    extern __shared__ __attribute__((aligned(16))) unsigned char lds_raw[];
    LAS unsigned char* lds = (LAS unsigned char*)lds_raw;
    cg::grid_group grid = cg::this_grid();
    __shared__ unsigned xb_st[2];
    if (threadIdx.x == 0) { xb_st[0] = 0u; xb_st[1] = 0u; }
    __syncthreads();
    const XcdBarrier xbar = xcd_barrier_post((unsigned*)(p.ws + WS_XBAR), (volatile LAS unsigned*)xb_st);
#define GRID_SYNC() xcd_barrier(xbar)
    const int G = gridDim.x, bid = blockIdx.x;
    unsigned char* ws = p.ws;
    bf16_t* U = (bf16_t*)(ws + WS_U); bf16_t* ACT = (bf16_t*)(ws + WS_ACT); bf16_t* QKV = (bf16_t*)(ws + WS_QKV); bf16_t* MB = (bf16_t*)(ws + WS_MB);
    const float* ada = (const float*)(ws + WS_ADA);
    const bf16_t* W13 = (const bf16_t*)(ws + WS_W13); const bf16_t* W2 = (const bf16_t*)(ws + WS_W2);

    phase0(p, lds);
    grid.sync();
    phase_ada_reduce(p);
    GRID_SYNC();
    phase_normmod(p.x, p.norm1_g, ada, 0 * D_, 1 * D_, U);
    GRID_SYNC();
    { pg8::Gemm g{U, D_, W13, D_}; pg8::StaticOrder S; S.init(64, 44, G, bid); pg8::EpiSwiglu E{ACT}; pg8::gemm_phase(lds, g, S, E); }
    GRID_SYNC();
    { pg8::Gemm g{ACT, FF_, W2, FF_}; pg8::StaticOrder S; S.init(64, 8, G, bid); pg8::EpiResid E{p.x, p.out, ada + 2 * D_, 0.5f}; pg8::gemm_phase(lds, g, S, E); }
    GRID_SYNC();
#ifndef PROBE_N
#define PROBE_N 0
#endif
    for (int pass = (PROBE_N > 0 ? 0 : 1); pass < 2; ++pass) {
    const int lim = (pass == 0) ? PROBE_N : 99;
    if (lim >= 1) { phase_normmod(p.out, p.norm2_g, ada, 3 * D_, 4 * D_, U); GRID_SYNC(); }
    if (lim >= 2) { pg8::Gemm g{U, D_, (const bf16_t*)(ws + WS_WIN1), D_}; pg8::StaticOrder S; S.init(64, 48, G, bid); pg8::EpiIn1 E{QKV, MB, (float*)(ws + WS_BA)}; pg8::gemm_phase(lds, g, S, E); phase_ba(p, lds); GRID_SYNC(); }
    if (lim >= 3) { phase_halo(p); GRID_SYNC(); }
    if (lim >= 4) { phase_postproc(p, lds); GRID_SYNC(); }
    if (lim >= 6) { phase_dn_local(p, lds); GRID_SYNC(); }
    if (lim >= 7) { phase_dn_scan3(p, lds); __syncthreads(); }
    if (lim >= 8) { phase_moba_mfma(p, lds, (unsigned)(size_t)lds_raw); }
    if (lim >= 7) GRID_SYNC();
    if (lim >= 9) { pg8::Gemm g{U, D_, (const bf16_t*)(ws + WS_WIN2), D_}; pg8::StaticOrder S; S.init(64, 24, G, bid); pg8::EpiIn2 E{QKV, MB + (size_t)M_ * D_}; pg8::gemm_phase(lds, g, S, E); GRID_SYNC(); }
    if (lim >= 10) { phase_ya(p); GRID_SYNC(); }
    if (lim >= 11) {
      { pg8::Gemm g{QKV + 4096, 6144, (const bf16_t*)(ws + WS_WPAB), D_}; pg8::StaticOrder S; S.init(64, 8, G, bid);
        pg8::EpiProjA E{QKV + 2048, 6144, MB + 2 * (size_t)M_ * D_}; pg8::gemm_phase(lds, g, S, E); }
      { pg8::Gemm g{MB, D_, (const bf16_t*)(ws + WS_WPAB) + (size_t)2048 * 2048, D_}; pg8::StaticOrder S; S.init(64, 8, G, bid);
        pg8::EpiProjB E{MB + (size_t)M_ * D_, D_, MB + 2 * (size_t)M_ * D_, U}; pg8::gemm_phase(lds, g, S, E); }
      GRID_SYNC(); }
    }
    { pg8::Gemm g{U, D_, (const bf16_t*)(ws + WS_WOUT), D_}; pg8::StaticOrder S; S.init(64, 8, G, bid); pg8::EpiResid E{p.out, p.out, ada + 5 * D_, 1.0f}; pg8::gemm_phase(lds, g, S, E); }
    GRID_SYNC();
    phase_normmod(p.out, p.norm3_g, ada, 6 * D_, 7 * D_, U);
    { const int tid_ = tid_opaque(); const int lane = tid_ & 63, wave = tid_ >> 6; __syncthreads();
      convert_ffn(p.f2w1, p.f2w3, p.f2w2, (bf16_t*)(ws + WS_W13), (bf16_t*)(ws + WS_W2), (LAS float*)(lds + wave * 8448), bid * 8 + wave, G * 8, lane); }
    GRID_SYNC();
    { pg8::Gemm g{U, D_, W13, D_}; pg8::StaticOrder S; S.init(64, 44, G, bid); pg8::EpiSwiglu E{ACT}; pg8::gemm_phase(lds, g, S, E); }
    GRID_SYNC();
    { pg8::Gemm g{ACT, FF_, W2, FF_}; pg8::StaticOrder S; S.init(64, 8, G, bid); pg8::EpiResid E{p.out, p.out, ada + 8 * D_, 0.5f}; pg8::gemm_phase(lds, g, S, E); }
}

extern "C" void kernel_launch(void* const* d_in, const int* in_sizes, int n_in, void* d_out, int out_size, void* d_ws, size_t ws_size, hipStream_t stream) {
    static int grid_blocks = 0;
    if (grid_blocks == 0) {
        if (n_in != 24 || ws_size < WS_END) { fprintf(stderr, "kernel_launch: unexpected n_in %d or ws_size %zu (< %zu)\n", n_in, ws_size, (size_t)WS_END); grid_blocks = -1; return; }
        int dev = 0, cus = 0, per_cu = 0;
        hipGetDevice(&dev);
        hipDeviceGetAttribute(&cus, hipDeviceAttributeMultiprocessorCount, dev);
        hipFuncSetAttribute((const void*)fwd_megakernel, hipFuncAttributeMaxDynamicSharedMemorySize, LDS_BYTES);
        hipOccupancyMaxActiveBlocksPerMultiprocessor(&per_cu, (const void*)fwd_megakernel, 512, LDS_BYTES);
        if (per_cu < 1) { fprintf(stderr, "kernel_launch: occupancy query says %d blocks per CU\n", per_cu); per_cu = 1; }
        (void)hipGetLastError();
        grid_blocks = cus;
        if (grid_blocks > 256) grid_blocks = 256;
    }
    if (grid_blocks < 0) return;
    Params p{};
    const float** pp = (const float**)&p;
    for (int i = 0; i < 24; ++i) pp[i] = (const float*)d_in[i];
    p.out = (float*)d_out; p.ws = (unsigned char*)d_ws;
    (void)hipMemsetAsync((char*)d_ws + WS_XBAR, 0, 16384, stream);
    void* args[] = {&p};
    hipError_t e = hipLaunchCooperativeKernel((const void*)fwd_megakernel, dim3(grid_blocks), dim3(512), args, LDS_BYTES, stream);
    if (e != hipSuccess) fprintf(stderr, "cooperative launch failed: %s (grid %d)\n", hipGetErrorString(e), grid_blocks);
}
```

```cpp
#include <hip/hip_runtime.h>
#include <hip/hip_cooperative_groups.h>
#include <cstdio>
#include <cstdint>
namespace cg = cooperative_groups;

#define LAS __attribute__((address_space(3)))
typedef unsigned short bf16_t;
typedef short bf16x8 __attribute__((ext_vector_type(8)));
typedef float f32x4 __attribute__((ext_vector_type(4)));
typedef unsigned u32x4 __attribute__((ext_vector_type(4)));
typedef unsigned u32x2 __attribute__((ext_vector_type(2)));

constexpr int M_ = 16384, D_ = 2048, FF_ = 5632, T_ = 4096;
constexpr int NIN1 = 12544, NIN2 = 6144, NADA = 18432;
constexpr float LOG2E = 1.4426950408889634f;
constexpr float QSCALE = 0.08838834764831845f;

constexpr size_t SZ_MD = (size_t)M_ * D_ * 2;
constexpr size_t WS_W13 = 0;
constexpr size_t WS_W2 = WS_W13 + (size_t)11264 * 2048 * 2;
constexpr size_t WS_WIN1 = WS_W2 + (size_t)2048 * 5632 * 2;
constexpr size_t WS_WIN2 = WS_WIN1 + (size_t)NIN1 * 2048 * 2;
constexpr size_t WS_WPAB = WS_WIN2 + (size_t)NIN2 * 2048 * 2;
constexpr size_t WS_WOUT = WS_WPAB + (size_t)2048 * 4096 * 2;
constexpr size_t WS_ADA = WS_WOUT + (size_t)2048 * 2048 * 2;
constexpr size_t WS_BT = WS_ADA + (size_t)4 * NADA * 4;
constexpr size_t WS_KMEAN = WS_BT + (size_t)16 * 4096 * 4;
constexpr size_t WS_U = WS_KMEAN + (size_t)4 * 16 * 16 * 128 * 4;
constexpr size_t WS_BIG = WS_U + SZ_MD;
constexpr size_t WS_QKV = WS_BIG;
constexpr size_t WS_MB = WS_QKV + 3 * SZ_MD;
constexpr size_t WS_BA = WS_MB + 3 * SZ_MD;
constexpr size_t WS_WDN = WS_BA + (size_t)M_ * 32 * 4;
constexpr size_t WS_QK = WS_WDN + SZ_MD;
constexpr size_t WS_XBAR = WS_QK + SZ_MD / 2;
constexpr size_t WS_END = WS_XBAR + 16384;
constexpr size_t WS_ACT = WS_BIG;
constexpr size_t WS_ADAP = WS_BIG;
constexpr size_t WS_HALO = WS_WDN;

constexpr int LDS_BYTES = 147456;

struct Params {
    const float* x; const float* c; const float* ada_w; const float* ada_b; const float* norm1_g;
    const float* f1w1; const float* f1w3; const float* f1w2; const float* norm2_g; const float* w_in;
    const float* conv_w; const float* a_log; const float* dt_bias; const float* dn_norm_g; const float* qn_g; const float* kn_g;
    const float* rel_bias; const float* wpa; const float* wpb; const float* wout; const float* norm3_g;
    const float* f2w1; const float* f2w3; const float* f2w2;
    float* out; unsigned char* ws;
};

typedef float f32x2v __attribute__((ext_vector_type(2)));
typedef __bf16 bf16x2_t __attribute__((ext_vector_type(2)));
__device__ __forceinline__ unsigned cvt_pk_bf16(float lo, float hi) { f32x2v v = {lo, hi}; bf16x2_t r = __builtin_convertvector(v, bf16x2_t); return __builtin_bit_cast(unsigned, r); }
__device__ __forceinline__ bf16_t f2bf(float f) { return (bf16_t)(cvt_pk_bf16(f, 0.f) & 0xffffu); }
__device__ __forceinline__ float bf2f(unsigned b) { return __uint_as_float(b << 16); }
__device__ __forceinline__ float bflo(unsigned w) { return __uint_as_float(w << 16); }
__device__ __forceinline__ float bfhi(unsigned w) { return __uint_as_float(w & 0xffff0000u); }
__device__ __forceinline__ float wave_sum(float v) {
#pragma unroll
    for (int o = 1; o < 64; o <<= 1) v += __shfl_xor(v, o);
    return v;
}
__device__ __forceinline__ float wave_max(float v) {
#pragma unroll
    for (int o = 1; o < 64; o <<= 1) v = fmaxf(v, __shfl_xor(v, o));
    return v;
}
__device__ __forceinline__ float sigmoidf_(float x) { return __builtin_amdgcn_rcpf(1.0f + __builtin_amdgcn_exp2f(-x * LOG2E)); }
__device__ __forceinline__ float siluf_(float x) { return x * sigmoidf_(x); }
#define LDS_WAIT() asm volatile("s_waitcnt lgkmcnt(0)" ::: "memory")
__device__ __forceinline__ int tid_opaque() { int t = threadIdx.x; asm volatile("" : "+v"(t)); return t; }

namespace pg8 {
constexpr int BM = 256, BK = 64, HALF = 128, HTB = HALF * BK * 2, STAGE_BYTES = 8 * HTB, NXCD = 8, WGM = 4;
__host__ __device__ __forceinline__ int lds_byte(int r, int c) { const int st = (r >> 4) * 2 + (c >> 5), rr = r & 15, cc = c & 31, ob = rr * 64 + cc * 2; return st * 1024 + (ob ^ (((ob >> 9) & 1) << 5)); }
__host__ __device__ __forceinline__ void stage_rc(int b, int& R, int& C) { const int st = b / 1024, sb = b % 1024, swz = sb ^ (((sb >> 9) & 1) << 5); R = (st >> 1) * 16 + swz / 64; C = (st & 1) * 32 + (swz % 64) / 2; }
__host__ __device__ __forceinline__ int perm32(int rho) { const int n = rho >> 4, i = rho & 15; return 8 * (i >> 2) + 4 * n + (i & 3); }

struct Unit { int pm, pn; };
struct Gemm { const bf16_t* A; int lda; const bf16_t* Bt; int K; };

struct StaticOrder {
    int nM, nN, nwg, G, c;
    __device__ void init(int nM_, int nN_, int G_, int c_) { nM = nM_; nN = nN_; nwg = nM * nN; G = G_; c = c_; }
    __device__ bool next(int i, Unit& u) const {
        const long L = (long)i * G + c; if (L >= nwg) return false;
        int wgid = (int)L; { const int q = nwg / NXCD, r = nwg % NXCD, xcd = wgid % NXCD, off = wgid / NXCD; wgid = (xcd < r ? xcd * (q + 1) : r * (q + 1) + (xcd - r) * q) + off; }
        const int nig = WGM * nN, gid = wgid / nig, fm = gid * WGM, gsz = (nM - fm) < WGM ? (nM - fm) : WGM;
        u.pm = fm + ((wgid % nig) % gsz); u.pn = (wgid % nig) / gsz; return true;
    }
};

typedef f32x4 Acc[2][2][4][2];

struct EpiSwiglu {
    static constexpr bool PERM = true;
    bf16_t* O;
    __device__ __forceinline__ void operator()(const Acc& acc, const Unit& u, int wr, int wc, int fr, int fq) const {
        const int row0 = u.pm * BM + wr * 64 + fr, col0 = u.pn * 128 + wc * 32 + 8 * fq;
#pragma unroll
        for (int ai = 0; ai < 2; ++ai)
#pragma unroll
            for (int m = 0; m < 4; ++m) {
                bf16_t* rowp = O + (size_t)(row0 + ai * HALF + m * 16) * FF_ + col0;
                float v[8];
#pragma unroll
                for (int n = 0; n < 2; ++n)
#pragma unroll
                    for (int j = 0; j < 4; ++j) v[n * 4 + j] = siluf_(acc[ai][0][m][n][j]) * acc[ai][1][m][n][j];
                u32x4 w; w.x = cvt_pk_bf16(v[0], v[1]); w.y = cvt_pk_bf16(v[2], v[3]); w.z = cvt_pk_bf16(v[4], v[5]); w.w = cvt_pk_bf16(v[6], v[7]);
                *(u32x4*)rowp = w;
            }
    }
};
struct EpiResid {
    static constexpr bool PERM = false;
    const float* resid; float* out; const float* gada; float scale;
    __device__ __forceinline__ void operator()(const Acc& acc, const Unit& u, int wr, int wc, int fr, int fq) const {
        const int row0 = u.pm * BM + wr * 64 + fr, col0 = u.pn * BM + wc * 32 + 4 * fq;
        const float* g = gada + (size_t)(u.pm >> 4) * NADA;
        f32x4 gv[2][2];
#pragma unroll
        for (int bj = 0; bj < 2; ++bj)
#pragma unroll
            for (int n = 0; n < 2; ++n) gv[bj][n] = *(const f32x4*)(g + col0 + bj * HALF + n * 16) * scale;
#pragma unroll
        for (int ai = 0; ai < 2; ++ai) {
            f32x4 rr[4][2][2];
#pragma unroll
            for (int m = 0; m < 4; ++m)
#pragma unroll
                for (int bj = 0; bj < 2; ++bj)
#pragma unroll
                    for (int n = 0; n < 2; ++n) rr[m][bj][n] = *(const f32x4*)(resid + (size_t)(row0 + ai * HALF + m * 16) * D_ + col0 + bj * HALF + n * 16);
#pragma unroll
            for (int m = 0; m < 4; ++m)
#pragma unroll
                for (int bj = 0; bj < 2; ++bj)
#pragma unroll
                    for (int n = 0; n < 2; ++n) *(f32x4*)(out + (size_t)(row0 + ai * HALF + m * 16) * D_ + col0 + bj * HALF + n * 16) = rr[m][bj][n] + gv[bj][n] * acc[ai][bj][m][n];
        }
    }
};
__device__ __forceinline__ void store_bf16_tile(const Acc& acc, bf16_t* base, int ldc, int row0, int col0) {
#pragma unroll
    for (int ai = 0; ai < 2; ++ai)
#pragma unroll
        for (int m = 0; m < 4; ++m) {
            bf16_t* rowp = base + (size_t)(row0 + ai * HALF + m * 16) * ldc + col0;
#pragma unroll
            for (int bj = 0; bj < 2; ++bj) {
                const f32x4 v0 = acc[ai][bj][m][0], v1 = acc[ai][bj][m][1];
                u32x4 w; w.x = cvt_pk_bf16(v0[0], v0[1]); w.y = cvt_pk_bf16(v0[2], v0[3]); w.z = cvt_pk_bf16(v1[0], v1[1]); w.w = cvt_pk_bf16(v1[2], v1[3]);
                *(u32x4*)(rowp + bj * HALF) = w;
            }
        }
}
struct EpiIn1 {
    static constexpr bool PERM = true;
    bf16_t* QKV; bf16_t* MB; float* BA;
    __device__ __forceinline__ void operator()(const Acc& acc, const Unit& u, int wr, int wc, int fr, int fq) const {
        const int row0 = u.pm * BM + wr * 64 + fr, pn = u.pn;
        if (pn < 48) {
            bf16_t* base; int ldc, colt;
            if (pn < 24) { base = QKV; ldc = 6144; colt = pn * 256; }
            else { const int t = (pn - 24) >> 3; base = MB + (size_t)t * M_ * D_; ldc = 2048; colt = ((pn - 24) & 7) * 256; }
            store_bf16_tile(acc, base, ldc, row0, colt + wc * 32 + 8 * fq);
        } else if (wc == 0) {
#pragma unroll
            for (int ai = 0; ai < 2; ++ai)
#pragma unroll
                for (int m = 0; m < 4; ++m) { float* pp = BA + (size_t)(row0 + ai * HALF + m * 16) * 32 + 8 * fq; *(f32x4*)pp = acc[ai][0][m][0]; *(f32x4*)(pp + 4) = acc[ai][0][m][1]; }
        }
    }
};
struct EpiIn2 {
    static constexpr bool PERM = true;
    bf16_t* QKV; bf16_t* MBK;
    __device__ __forceinline__ void operator()(const Acc& acc, const Unit& u, int wr, int wc, int fr, int fq) const {
        const int row0 = u.pm * BM + wr * 64 + fr, pn = u.pn;
        bf16_t* base; int ldc, colt;
        if (pn < 16) { base = QKV; ldc = 6144; colt = pn * 256; }
        else { base = MBK; ldc = 2048; colt = (pn - 16) * 256; }
        store_bf16_tile(acc, base, ldc, row0, colt + wc * 32 + 8 * fq);
    }
};
struct EpiProjA {
    static constexpr bool PERM = true;
    const bf16_t* GA; int ldga; bf16_t* Tm;
    __device__ __forceinline__ void operator()(const Acc& acc, const Unit& u, int wr, int wc, int fr, int fq) const {
        const int row0 = u.pm * BM + wr * 64 + fr, col0 = u.pn * BM + wc * 32 + 8 * fq;
#pragma unroll
        for (int ai = 0; ai < 2; ++ai) {
            u32x4 ga[4][2];
#pragma unroll
            for (int m = 0; m < 4; ++m)
#pragma unroll
                for (int bj = 0; bj < 2; ++bj) ga[m][bj] = *(const u32x4*)(GA + (size_t)(row0 + ai * HALF + m * 16) * ldga + col0 + bj * HALF);
#pragma unroll
            for (int m = 0; m < 4; ++m)
#pragma unroll
                for (int bj = 0; bj < 2; ++bj) {
                    u32x4 w;
#pragma unroll
                    for (int e = 0; e < 4; ++e) {
                        const float s0 = sigmoidf_(bflo(ga[m][bj][e])), s1 = sigmoidf_(bfhi(ga[m][bj][e]));
                        w[e] = cvt_pk_bf16(acc[ai][bj][m][e >> 1][(e & 1) * 2] * s0, acc[ai][bj][m][e >> 1][(e & 1) * 2 + 1] * s1);
                    }
                    *(u32x4*)(Tm + (size_t)(row0 + ai * HALF + m * 16) * D_ + col0 + bj * HALF) = w;
                }
        }
    }
};
struct EpiProjB {
    static constexpr bool PERM = true;
    const bf16_t* GB; int ldgb; const bf16_t* Tm; bf16_t* O;
    __device__ __forceinline__ void operator()(const Acc& acc, const Unit& u, int wr, int wc, int fr, int fq) const {
        const int row0 = u.pm * BM + wr * 64 + fr, col0 = u.pn * BM + wc * 32 + 8 * fq;
#pragma unroll
        for (int ai = 0; ai < 2; ++ai) {
            u32x4 gb[4][2], tv[4][2];
#pragma unroll
            for (int m = 0; m < 4; ++m)
#pragma unroll
                for (int bj = 0; bj < 2; ++bj) { const size_t row = (size_t)(row0 + ai * HALF + m * 16);
                    gb[m][bj] = *(const u32x4*)(GB + row * ldgb + col0 + bj * HALF); tv[m][bj] = *(const u32x4*)(Tm + row * D_ + col0 + bj * HALF); }
#pragma unroll
            for (int m = 0; m < 4; ++m)
#pragma unroll
                for (int bj = 0; bj < 2; ++bj) {
                    u32x4 w;
#pragma unroll
                    for (int e = 0; e < 4; ++e) {
                        const float s0 = sigmoidf_(bflo(gb[m][bj][e])), s1 = sigmoidf_(bfhi(gb[m][bj][e]));
                        w[e] = cvt_pk_bf16(bflo(tv[m][bj][e]) + acc[ai][bj][m][e >> 1][(e & 1) * 2] * s0, bfhi(tv[m][bj][e]) + acc[ai][bj][m][e >> 1][(e & 1) * 2 + 1] * s1);
                    }
                    *(u32x4*)(O + (size_t)(row0 + ai * HALF + m * 16) * D_ + col0 + bj * HALF) = w;
                }
        }
    }
};

template <class Epi>
__device__ __forceinline__ void gemm_phase(LAS unsigned char* lds, const Gemm g, const StaticOrder& S, const Epi& E) {
    const int tid = tid_opaque(), wid = __builtin_amdgcn_readfirstlane(tid >> 6), lane = tid & 63, wr = wid >> 2, wc = wid & 3, fr = lane & 15, fq = lane >> 4;
    const int K = g.K, nt = K / BK;
    unsigned voffA[2], voffB[2];
#pragma unroll
    for (int i = 0; i < 2; ++i) { int R, C; stage_rc(tid * 16 + i * 8192, R, C); const int Rb = Epi::PERM ? ((R & ~31) + perm32(R & 31)) : R;
        voffA[i] = (unsigned)(R * g.lda + C) * 2u; voffB[i] = (unsigned)(Rb * K + C) * 2u; }
    const size_t kstep = (size_t)(BK * 2);
    const size_t hstepA = (size_t)HALF * g.lda * 2, hstepB = (size_t)HALF * K * 2;
    const unsigned ldsw = (unsigned)wid * 1024u;
    const int aoff = lds_byte(wr * 64 + fr, fq * 8), boff = lds_byte(wc * 32 + fr, fq * 8);
#define PG8_SA(b, h) (((b) * 2 + (h)) * HTB)
#define PG8_SB(b, h) ((4 + (b) * 2 + (h)) * HTB)
#define PG8_STAGE_B(bufoff, gbase) do { _Pragma("unroll") for (int _i = 0; _i < 2; ++_i) \
        __builtin_amdgcn_global_load_lds((const unsigned*)((const char*)(gbase) + voffB[_i]), (LAS unsigned*)(lds + (bufoff) + ldsw + _i * 8192), 16, 0, 0); } while (0)
#define PG8_STAGE_A(bufoff, gbase, second) do { _Pragma("unroll") for (int _i = 0; _i < 2; ++_i) \
        __builtin_amdgcn_global_load_lds((const unsigned*)((const char*)(gbase) + voffA[_i]), (LAS unsigned*)(lds + (bufoff) + ldsw + _i * 8192), 16, 0, 0); } while (0)
#define PG8_LDA(dst, b, h) do { _Pragma("unroll") for (int m = 0; m < 4; ++m) _Pragma("unroll") for (int k = 0; k < 2; ++k) dst[m][k] = *(const LAS bf16x8*)(lds + PG8_SA(b, h) + aoff + m * 2048 + k * 1024); } while (0)
#define PG8_LDB(dst, b, h) do { _Pragma("unroll") for (int n = 0; n < 2; ++n) _Pragma("unroll") for (int k = 0; k < 2; ++k) dst[n][k] = *(const LAS bf16x8*)(lds + PG8_SB(b, h) + boff + n * 2048 + k * 1024); } while (0)
#define PG8_MMA(ai, bj, At, Bt) do { __builtin_amdgcn_s_setprio(1); _Pragma("unroll") for (int m = 0; m < 4; ++m) _Pragma("unroll") for (int n = 0; n < 2; ++n) _Pragma("unroll") for (int k = 0; k < 2; ++k) \
        acc[ai][bj][m][n] = __builtin_amdgcn_mfma_f32_16x16x32_bf16(Bt[n][k], At[m][k], acc[ai][bj][m][n], 0, 0, 0); __builtin_amdgcn_s_setprio(0); } while (0)
#define PG8_WAIT_V(n) asm volatile("s_waitcnt vmcnt(" #n ")" ::: "memory")
#define PG8_WAIT_L(n) asm volatile("s_waitcnt lgkmcnt(" #n ")" ::: "memory")
#define PG8_BAR __builtin_amdgcn_s_barrier()
#define PG8_SCHED __builtin_amdgcn_sched_barrier(0)
    Unit cur, nxt; int ui = 0;
    if (!S.next(0, cur)) return;
    Acc acc;
#pragma unroll
    for (int a = 0; a < 2; ++a)
#pragma unroll
        for (int b = 0; b < 2; ++b)
#pragma unroll
            for (int m = 0; m < 4; ++m)
#pragma unroll
                for (int n = 0; n < 2; ++n) acc[a][b][m][n] = (f32x4){0.f, 0.f, 0.f, 0.f};
    bf16x8 At[4][2], B0[2][2], B1[2][2];
    const char* cA = (const char*)g.A + (size_t)cur.pm * 2 * hstepA; const char* cB = (const char*)g.Bt + (size_t)cur.pn * 2 * hstepB;
    PG8_STAGE_B(PG8_SB(0, 0), cB); PG8_STAGE_B(PG8_SB(0, 1), cB + hstepB); PG8_STAGE_A(PG8_SA(0, 0), cA, false); PG8_STAGE_A(PG8_SA(0, 1), cA + hstepA, false);
    if (wr == 1) PG8_BAR;
    PG8_WAIT_V(2); PG8_BAR;
    PG8_STAGE_B(PG8_SB(1, 0), cB + kstep); PG8_STAGE_A(PG8_SA(1, 0), cA + kstep, false); PG8_STAGE_B(PG8_SB(1, 1), cB + hstepB + kstep);
    PG8_WAIT_V(6); PG8_BAR;
    for (;;) {
        const bool has_next = S.next(ui + 1, nxt);
        const char* nA = has_next ? (const char*)g.A + (size_t)nxt.pm * 2 * hstepA : cA; const char* nB = has_next ? (const char*)g.Bt + (size_t)nxt.pn * 2 * hstepB : cB;
        for (int t = 0; t < nt; t += 2) {
            const bool last = (t == nt - 2);
            const char* a1 = cA + (size_t)(t + 1) * kstep;
            const char* a2 = last ? nA : cA + (size_t)(t + 2) * kstep; const char* a3 = a2 + kstep;
            const size_t h1 = hstepA, h2 = hstepA;
            const char* b2 = last ? nB : cB + (size_t)(t + 2) * kstep; const char* b3 = b2 + kstep;
            PG8_LDB(B0, 0, 0); PG8_LDB(B1, 0, 1); PG8_SCHED; PG8_LDA(At, 0, 0); PG8_STAGE_A(PG8_SA(1, 1), a1 + h1, false);
            PG8_WAIT_V(8); PG8_WAIT_L(0); PG8_BAR; PG8_MMA(0, 0, At, B0); PG8_MMA(0, 1, At, B1); PG8_BAR; PG8_SCHED;
            PG8_LDA(At, 0, 1); PG8_STAGE_B(PG8_SB(0, 0), b2); PG8_STAGE_B(PG8_SB(0, 1), b2 + hstepB); PG8_STAGE_A(PG8_SA(0, 0), a2, false);
            PG8_WAIT_V(8); PG8_WAIT_L(0); PG8_BAR; PG8_MMA(1, 0, At, B0); PG8_MMA(1, 1, At, B1); PG8_BAR; PG8_SCHED;
            PG8_LDB(B0, 1, 0); PG8_LDB(B1, 1, 1); PG8_SCHED; PG8_LDA(At, 1, 0); PG8_STAGE_A(PG8_SA(0, 1), a2 + h2, false);
            PG8_WAIT_V(8); PG8_WAIT_L(0); PG8_BAR; PG8_MMA(0, 0, At, B0); PG8_MMA(0, 1, At, B1); PG8_BAR; PG8_SCHED;
            PG8_LDA(At, 1, 1); PG8_STAGE_B(PG8_SB(1, 0), b3); PG8_STAGE_B(PG8_SB(1, 1), b3 + hstepB); PG8_STAGE_A(PG8_SA(1, 0), a3, false);
            PG8_WAIT_V(8); PG8_WAIT_L(0); PG8_BAR; PG8_MMA(1, 0, At, B0); PG8_MMA(1, 1, At, B1); PG8_BAR; PG8_SCHED;
        }
        if (wr == 0) PG8_BAR;
        E(acc, cur, wr, wc, fr, fq);
        if (!has_next) break;
#pragma unroll
        for (int a = 0; a < 2; ++a)
#pragma unroll
            for (int b = 0; b < 2; ++b)
#pragma unroll
                for (int m = 0; m < 4; ++m)
#pragma unroll
                    for (int n = 0; n < 2; ++n) acc[a][b][m][n] = (f32x4){0.f, 0.f, 0.f, 0.f};
        cur = nxt; cA = nA; cB = nB; ++ui;
        if (wr == 1) PG8_BAR;
    }
    PG8_WAIT_V(0);
    PG8_BAR;
#undef PG8_SA
#undef PG8_SB
#undef PG8_STAGE_A
#undef PG8_STAGE_B
#undef PG8_LDA
#undef PG8_LDB
#undef PG8_MMA
#undef PG8_WAIT_V
#undef PG8_WAIT_L
#undef PG8_BAR
#undef PG8_SCHED
}
}

__device__ __forceinline__ void tr_item(const float* __restrict__ W, int N, int k0, int n0, bf16_t* dst, int ldd, LAS float* scr, int lane) {
    { float wv[32];
#pragma unroll
      for (int i = 0; i < 32; ++i) wv[i] = W[(size_t)(k0 + 2 * i + (lane >> 5)) * N + n0 + (lane & 31)];
      __builtin_amdgcn_sched_barrier(0);
#pragma unroll
      for (int i = 0; i < 32; ++i) scr[(2 * i + (lane >> 5)) * 33 + (lane & 31)] = wv[i]; }
    LDS_WAIT();
    const int c = lane & 7;
#pragma unroll
    for (int j = 0; j < 4; ++j) { const int n = (lane >> 3) + 8 * j; const LAS float* s = scr + (8 * c) * 33 + n;
        u32x4 o; o.x = cvt_pk_bf16(s[0 * 33], s[1 * 33]); o.y = cvt_pk_bf16(s[2 * 33], s[3 * 33]); o.z = cvt_pk_bf16(s[4 * 33], s[5 * 33]); o.w = cvt_pk_bf16(s[6 * 33], s[7 * 33]);
        *(u32x4*)(dst + (size_t)n * ldd + 8 * c) = o; }
    LDS_WAIT();
}
__device__ __forceinline__ void convert_ffn(const float* w1, const float* w3, const float* w2, bf16_t* W13, bf16_t* W2, LAS float* scr, int gw, int NGW, int lane) {
    constexpr int I_UP = 32 * 176, I_DN = 88 * 64;
    for (int it = gw; it < 2 * I_UP + I_DN; it += NGW) {
        int r = it;
        if (r < 2 * I_UP) { const int which = r >= I_UP; if (which) r -= I_UP; const int kb = r / 176, nb = r % 176, n0 = nb * 32;
            tr_item(which ? w3 : w1, FF_, kb * 64, n0, W13 + (size_t)((n0 >> 7) * 256 + which * 128 + (n0 & 127)) * 2048 + kb * 64, 2048, scr, lane); }
        else { r -= 2 * I_UP; const int kb = r / 64, nb = r % 64; tr_item(w2, D_, kb * 64, nb * 32, W2 + (size_t)(nb * 32) * FF_ + kb * 64, FF_, scr, lane); }
    }
}
__device__ __forceinline__ void convert_mixer(const Params& p, LAS float* scr, int gw, int NGW, int lane) {
    bf16_t* WIN1 = (bf16_t*)(p.ws + WS_WIN1); bf16_t* WIN2 = (bf16_t*)(p.ws + WS_WIN2); bf16_t* WPAB = (bf16_t*)(p.ws + WS_WPAB); bf16_t* WOUT = (bf16_t*)(p.ws + WS_WOUT);
    constexpr int I_IN = 32 * 577, I_P = 32 * 64;
    for (int it = gw; it < I_IN + 3 * I_P; it += NGW) {
        int r = it;
        if (r < I_IN) { const int kb = r / 577, nb = r % 577, n0 = nb * 32; bf16_t* dst; int drow;
            if (n0 < 6144) { dst = WIN1; drow = n0; }
            else if (n0 < 8192) { dst = WIN2; drow = n0 - 6144; }
            else if (n0 < 8224) { dst = WIN1; drow = 12288 + (n0 - 8192); }
            else if (n0 < 10272) { dst = WIN1; drow = 6144 + (n0 - 8224); }
            else if (n0 < 12320) { dst = WIN1; drow = 8192 + (n0 - 10272); }
            else if (n0 < 14368) { dst = WIN1; drow = 10240 + (n0 - 12320); }
            else if (n0 < 16416) { dst = WIN2; drow = 2048 + (n0 - 14368); }
            else { dst = WIN2; drow = 4096 + (n0 - 16416); }
            tr_item(p.w_in, 18464, kb * 64, n0, dst + (size_t)drow * 2048 + kb * 64, 2048, scr, lane); continue; }
        r -= I_IN;
        const int which = r / I_P; r -= which * I_P; const int kb = r / 64, nb = r % 64;
        if (which == 0) tr_item(p.wpa, D_, kb * 64, nb * 32, WPAB + (size_t)(nb * 32) * 2048 + kb * 64, 2048, scr, lane);
        else if (which == 1) tr_item(p.wpb, D_, kb * 64, nb * 32, WPAB + (size_t)2048 * 2048 + (size_t)(nb * 32) * 2048 + kb * 64, 2048, scr, lane);
        else tr_item(p.wout, D_, kb * 64, nb * 32, WOUT + (size_t)(nb * 32) * 2048 + kb * 64, 2048, scr, lane);
    }
}

__device__ __forceinline__ void phase0(const Params& p, LAS unsigned char* lds) {
    const int tid = tid_opaque(), lane = tid & 63, wave = tid >> 6;
    const int gw = blockIdx.x * 8 + wave, NGW = gridDim.x * 8;
    const int gt = blockIdx.x * 512 + tid, NGT = gridDim.x * 512;
    {
        LAS float* sil = (LAS float*)lds;
        float* ADAP = (float*)(p.ws + WS_ADAP);
        for (int item = blockIdx.x; item < 9 * 32; item += gridDim.x) {
            const int cb = item % 9, ks = item / 9;
            if (tid < 256) { const int b = tid >> 6, kk = tid & 63; sil[tid] = siluf_(p.c[b * D_ + ks * 64 + kk]); }
            __syncthreads();
            const int col = cb * 2048 + tid * 4;
            f32x4 a0 = {0, 0, 0, 0}, a1 = a0, a2 = a0, a3 = a0;
#pragma unroll 1
            for (int kq = 0; kq < 4; ++kq) {
                f32x4 w[16];
#pragma unroll
                for (int kk = 0; kk < 16; ++kk) w[kk] = *(const f32x4*)(p.ada_w + (size_t)(ks * 64 + kq * 16 + kk) * NADA + col);
                __builtin_amdgcn_sched_barrier(0);
#pragma unroll
                for (int kk = 0; kk < 16; ++kk) { const int k2 = kq * 16 + kk; a0 += sil[k2] * w[kk]; a1 += sil[64 + k2] * w[kk]; a2 += sil[128 + k2] * w[kk]; a3 += sil[192 + k2] * w[kk]; }
            }
            *(f32x4*)(ADAP + (size_t)(ks * 4 + 0) * NADA + col) = a0; *(f32x4*)(ADAP + (size_t)(ks * 4 + 1) * NADA + col) = a1;
            *(f32x4*)(ADAP + (size_t)(ks * 4 + 2) * NADA + col) = a2; *(f32x4*)(ADAP + (size_t)(ks * 4 + 3) * NADA + col) = a3;
            __syncthreads();
        }
    }
    LAS float* scr = (LAS float*)(lds + wave * 8448);
    convert_ffn(p.f1w1, p.f1w3, p.f1w2, (bf16_t*)(p.ws + WS_W13), (bf16_t*)(p.ws + WS_W2), scr, gw, NGW, lane);
    convert_mixer(p, scr, gw, NGW, lane);
    { u32x4* z = (u32x4*)(p.ws + WS_WIN1 + (size_t)12320 * 2048 * 2); for (int i = gt; i < 224 * 2048 * 2 / 16; i += NGT) z[i] = (u32x4){0u, 0u, 0u, 0u}; }
    { float* BT = (float*)(p.ws + WS_BT);
      for (int i = gt; i < 16 * 4096; i += NGT) { const int h = i >> 12, d = i & 4095; int bucket;
          if (d < 16) bucket = d; else { const double dd = (double)d, d2 = dd * dd, d4 = d2 * d2, d8 = d4 * d4; int k = 0; double thr = 34359738368.0  ;
              for (int q = 1; q <= 15; ++q) { if (d8 >= thr) k = q; thr *= 8.0; } bucket = 16 + k; if (bucket > 31) bucket = 31; }
          BT[i] = p.rel_bias[bucket * 16 + h] * LOG2E; } }
}
__device__ __forceinline__ void phase_ada_reduce(const Params& p) {
    const int gt = blockIdx.x * 512 + tid_opaque(), NGT = gridDim.x * 512;
    const float* ADAP = (const float*)(p.ws + WS_ADAP); float* ada = (float*)(p.ws + WS_ADA);
    for (int i = gt; i < 4 * NADA; i += NGT) { const int b = i / NADA, n = i - b * NADA; float s = p.ada_b[n];
        for (int ks = 0; ks < 32; ++ks) s += ADAP[(size_t)(ks * 4 + b) * NADA + n];
        ada[i] = s; }
}
__device__ __forceinline__ void phase_normmod(const float* src, const float* gain, const float* ada, int shoff, int scoff, bf16_t* dst) {
    const int tid_ = tid_opaque(); const int lane = tid_ & 63, wave = tid_ >> 6;
    const int gw = blockIdx.x * 8 + wave, NGW = gridDim.x * 8;
    f32x4 g[8];
#pragma unroll
    for (int j = 0; j < 8; ++j) g[j] = *(const f32x4*)(gain + 4 * (lane + 64 * j));
    f32x4 v[8];
    if (gw < M_) {
#pragma unroll
        for (int j = 0; j < 8; ++j) v[j] = ((const f32x4*)(src + (size_t)gw * D_) + lane)[64 * j];
    }
    for (int m = gw; m < M_; m += NGW) {
        const int mn = (m + NGW < M_) ? m + NGW : m;
        const float* ab = ada + (size_t)(m >> 12) * NADA;
        f32x4 vn[8], sh[8], sc[8];
#pragma unroll
        for (int j = 0; j < 8; ++j) { const int col = 4 * (lane + 64 * j); sh[j] = *(const f32x4*)(ab + shoff + col); sc[j] = *(const f32x4*)(ab + scoff + col); vn[j] = ((const f32x4*)(src + (size_t)mn * D_) + lane)[64 * j]; }
        __builtin_amdgcn_sched_barrier(0);
        float ss = 0.f;
#pragma unroll
        for (int j = 0; j < 8; ++j) ss += (v[j][0] * v[j][0] + v[j][1] * v[j][1]) + (v[j][2] * v[j][2] + v[j][3] * v[j][3]);
        ss = wave_sum(ss);
        const float rstd = rsqrtf(ss * (1.0f / D_) + 1e-6f);
#pragma unroll
        for (int j = 0; j < 8; ++j) { const int col = 4 * (lane + 64 * j);
            const f32x4 y = v[j] * rstd * g[j] * (sc[j] + 1.0f) + sh[j];
            u32x2 w; w.x = cvt_pk_bf16(y[0], y[1]); w.y = cvt_pk_bf16(y[2], y[3]);
            *(u32x2*)(dst + (size_t)m * D_ + col) = w; }
#pragma unroll
        for (int j = 0; j < 8; ++j) v[j] = vn[j];
    }
}
__device__ __forceinline__ void phase_halo(const Params& p) {
    const int tid_ = tid_opaque(); const int lane = tid_ & 63, wave = tid_ >> 6;
    const int gw = blockIdx.x * 8 + wave, NGW = gridDim.x * 8;
    const bf16_t* QKV = (const bf16_t*)(p.ws + WS_QKV); bf16_t* HALO = (bf16_t*)(p.ws + WS_HALO);
    for (int r = gw; r < 4 * 16 * 3; r += NGW) {
        const int j = r % 3, tile = (r / 3) & 15, b = r / 48;
        u32x4* d = (u32x4*)(HALO + (size_t)r * 6144);
        if (tile == 0) { for (int i = lane; i < 768; i += 64) d[i] = (u32x4){0u, 0u, 0u, 0u}; }
        else { const u32x4* s = (const u32x4*)(QKV + ((size_t)b * T_ + tile * 256 - 3 + j) * 6144); for (int i = lane; i < 768; i += 64) d[i] = s[i]; }
    }
}
__device__ __forceinline__ void unpack8(const u32x4 w, float* f) {
#pragma unroll
    for (int e = 0; e < 4; ++e) { f[2 * e] = bflo(w[e]); f[2 * e + 1] = bfhi(w[e]); }
}
__device__ __forceinline__ void phase_postproc(const Params& p, LAS unsigned char* lds) {
    const int tid = tid_opaque(), ti = tid >> 3, cg8 = tid & 7, lane = tid & 63, wave = tid >> 6;
    bf16_t* QKV = (bf16_t*)(p.ws + WS_QKV); const bf16_t* HALO = (const bf16_t*)(p.ws + WS_HALO); bf16_t* MB = (bf16_t*)(p.ws + WS_MB); float* BA = (float*)(p.ws + WS_BA);
    float* KM = (float*)(p.ws + WS_KMEAN);
    for (int item = blockIdx.x; item < 4 * 16 * 48; item += gridDim.x) {
        const int s = item % 48, tile = (item / 48) & 15, b = item / 768;
        const int c0 = s * 128 + cg8 * 16; const size_t row0 = (size_t)b * T_ + tile * 256 + ti * 4;
        u32x4 xr[7][2];
#pragma unroll
        for (int j = 0; j < 7; ++j) {
            const bf16_t* src = (ti > 0 || j >= 3) ? QKV + (row0 - 3 + j) * 6144 + c0 : HALO + ((size_t)((b * 16 + tile) * 3) + j) * 6144 + c0;
            xr[j][0] = *(const u32x4*)src; xr[j][1] = *(const u32x4*)(src + 8);
        }
        f32x4 w[4][4];
#pragma unroll
        for (int j = 0; j < 4; ++j)
#pragma unroll
            for (int q = 0; q < 4; ++q) w[j][q] = *(const f32x4*)(p.conv_w + j * 6144 + c0 + 4 * q);
        u32x4 o[4][2];
#pragma unroll
        for (int r = 0; r < 4; ++r) {
            float y[16];
#pragma unroll
            for (int i = 0; i < 16; ++i) y[i] = 0.f;
#pragma unroll
            for (int j = 0; j < 4; ++j) { float xf[16]; unpack8(xr[r + j][0], xf); unpack8(xr[r + j][1], xf + 8);
#pragma unroll
                for (int q = 0; q < 4; ++q)
#pragma unroll
                    for (int e = 0; e < 4; ++e) y[4 * q + e] += w[j][q][e] * xf[4 * q + e]; }
            float ss = 0.f;
#pragma unroll
            for (int i = 0; i < 16; ++i) { y[i] = siluf_(y[i]); ss += y[i] * y[i]; }
            ss += __shfl_xor(ss, 1); ss += __shfl_xor(ss, 2); ss += __shfl_xor(ss, 4);
            float sc = 1.0f;
            if (s < 32) { sc = rsqrtf(ss + 1e-6f); if (s < 16) sc *= QSCALE; }
#pragma unroll
            for (int e = 0; e < 4; ++e) { o[r][0][e] = cvt_pk_bf16(y[2 * e] * sc, y[2 * e + 1] * sc); o[r][1][e] = cvt_pk_bf16(y[8 + 2 * e] * sc, y[8 + 2 * e + 1] * sc); }
        }
        __syncthreads();
#pragma unroll
        for (int r = 0; r < 4; ++r) { bf16_t* dp = QKV + (row0 + r) * 6144 + c0; *(u32x4*)dp = o[r][0]; *(u32x4*)(dp + 8) = o[r][1]; }
    }
    LAS float* red = (LAS float*)lds;
    for (int item = blockIdx.x; item < 4 * 16 * 32; item += gridDim.x) {
        const int hh = item & 31, tile = (item >> 5) & 15, b = item >> 9; const int which = hh >> 4, h = hh & 15;
        bf16_t* dp = MB + (size_t)which * M_ * D_ + ((size_t)b * T_ + tile * 256 + ti * 4) * D_ + h * 128 + cg8 * 16;
        u32x4 xr[4][2];
#pragma unroll
        for (int r = 0; r < 4; ++r) { xr[r][0] = *(const u32x4*)(dp + (size_t)r * D_); xr[r][1] = *(const u32x4*)(dp + (size_t)r * D_ + 8); }
        const float* gp = (which == 0 ? p.qn_g : p.kn_g) + cg8 * 16;
        float gn[16];
#pragma unroll
        for (int i = 0; i < 16; ++i) gn[i] = gp[i] * (which == 0 ? QSCALE * LOG2E : 1.0f);
        float ks[16];
#pragma unroll
        for (int i = 0; i < 16; ++i) ks[i] = 0.f;
#pragma unroll
        for (int r = 0; r < 4; ++r) {
            float xf[16]; unpack8(xr[r][0], xf); unpack8(xr[r][1], xf + 8);
            float ss = 0.f;
#pragma unroll
            for (int i = 0; i < 16; ++i) ss += xf[i] * xf[i];
            ss += __shfl_xor(ss, 1); ss += __shfl_xor(ss, 2); ss += __shfl_xor(ss, 4);
            const float rs = rsqrtf(ss * (1.0f / 128.0f) + 1e-6f);
            u32x4 o0, o1;
#pragma unroll
            for (int i = 0; i < 16; ++i) { xf[i] = xf[i] * rs * gn[i]; ks[i] += xf[i]; }
#pragma unroll
            for (int e = 0; e < 4; ++e) { o0[e] = cvt_pk_bf16(xf[2 * e], xf[2 * e + 1]); o1[e] = cvt_pk_bf16(xf[8 + 2 * e], xf[8 + 2 * e + 1]); }
            *(u32x4*)(dp + (size_t)r * D_) = o0; *(u32x4*)(dp + (size_t)r * D_ + 8) = o1;
        }
        if (which == 1) {
#pragma unroll
            for (int i = 0; i < 16; ++i) { float v = ks[i]; v += __shfl_xor(v, 8); v += __shfl_xor(v, 16); v += __shfl_xor(v, 32); ks[i] = v; }
            if (lane < 8) {
#pragma unroll
                for (int i = 0; i < 16; ++i) red[wave * 128 + lane * 16 + i] = ks[i]; }
            __syncthreads();
            if (tid < 128) { float t = 0.f;
#pragma unroll
                for (int w8 = 0; w8 < 8; ++w8) t += red[w8 * 128 + tid];
                KM[((size_t)((b * 16 + h) * 16 + tile)) * 128 + tid] = t * (1.0f / 256.0f); }
            __syncthreads();
        }
    }
    {
        const int gt = blockIdx.x * 512 + tid, NGT = gridDim.x * 512;
        for (int i = gt; i < M_ * 16; i += NGT) { const int h = i & 15; const size_t r = (size_t)(i >> 4) * 32;
            const float bv = BA[r + h], av = BA[r + 16 + h] + p.dt_bias[h];
            const float sp = fmaxf(av, 0.f) + log1pf(expf(-fabsf(av)));
            BA[r + h] = 1.0f / (1.0f + expf(-bv)); BA[r + 16 + h] = -expf(p.a_log[h]) * sp; }
    }
}

typedef float f32x16 __attribute__((ext_vector_type(16)));
__device__ __forceinline__ unsigned pkbf(float a, float b) { return cvt_pk_bf16(a, b); }
#define MFMA32(a, b, c) __builtin_amdgcn_mfma_f32_32x32x16_bf16((a), (b), (c), 0, 0, 0)
template <int OFF, int ROWQ, int COLT> __device__ __forceinline__ void tr8(unsigned addr, u32x2 (&v)[8]) {
    asm volatile(
        "ds_read_b64_tr_b16 %0, %8 offset:%9\n\t"
        "ds_read_b64_tr_b16 %1, %8 offset:%10\n\t"
        "ds_read_b64_tr_b16 %2, %8 offset:%11\n\t"
        "ds_read_b64_tr_b16 %3, %8 offset:%12\n\t"
        "ds_read_b64_tr_b16 %4, %8 offset:%13\n\t"
        "ds_read_b64_tr_b16 %5, %8 offset:%14\n\t"
        "ds_read_b64_tr_b16 %6, %8 offset:%15\n\t"
        "ds_read_b64_tr_b16 %7, %8 offset:%16\n\t"
        "s_waitcnt lgkmcnt(0)"
        : "=&v"(v[0]), "=&v"(v[1]), "=&v"(v[2]), "=&v"(v[3]), "=&v"(v[4]), "=&v"(v[5]), "=&v"(v[6]), "=&v"(v[7])
        : "v"(addr), "n"(OFF), "n"(OFF + ROWQ), "n"(OFF + COLT), "n"(OFF + COLT + ROWQ), "n"(OFF + 2 * COLT), "n"(OFF + 2 * COLT + ROWQ), "n"(OFF + 3 * COLT), "n"(OFF + 3 * COLT + ROWQ)
        : "memory");
}
__device__ __forceinline__ bf16x8 frag2(const u32x2 a, const u32x2 b) { u32x4 w = {a.x, a.y, b.x, b.y}; return __builtin_bit_cast(bf16x8, w); }
__device__ __forceinline__ bf16x8 pack8(const f32x16& x, int s) {
    u32x4 w = {pkbf(x[8 * s], x[8 * s + 1]), pkbf(x[8 * s + 2], x[8 * s + 3]), pkbf(x[8 * s + 4], x[8 * s + 5]), pkbf(x[8 * s + 6], x[8 * s + 7])};
    return __builtin_bit_cast(bf16x8, w);
}

__device__ __forceinline__ void phase_moba_mfma(const Params& p, LAS unsigned char* lds, unsigned lds_base) {
    constexpr int KST = 272, VST = 320;
    constexpr int OFF_K = 0, OFF_V = 2 * 64 * KST, OFF_KM = OFF_V + 2 * 64 * VST, OFF_BT = OFF_KM + 32 * KST, OFF_UM = OFF_BT + 4096;
    const int tid = tid_opaque(), lane = tid & 63, wave = __builtin_amdgcn_readfirstlane(tid >> 6);
    const int i32 = lane & 31, hh = lane >> 5;
    bf16_t* MBQ = (bf16_t*)(p.ws + WS_MB); const bf16_t* MBK = MBQ + (size_t)M_ * D_; const bf16_t* MBV = MBK + (size_t)M_ * D_;
    const float* KM = (const float*)(p.ws + WS_KMEAN); const float* BT = (const float*)(p.ws + WS_BT);
    const int G = gridDim.x, cblk = blockIdx.x;
    const int lrow = tid >> 3, lc = tid & 7;
    const unsigned vbase = lds_base + OFF_V + (4 * hh + ((lane & 15) >> 2)) * VST + (16 * ((lane >> 4) & 1) + 4 * (lane & 3)) * 2;
    const float NINF = -__builtin_inff();
    for (int k = 0;; ++k) {
        const int it = k * G + ((k & 1) ? (G - 1 - cblk) : cblk);
        if (it >= 1024) break;
        const int qb = 15 - (it >> 6), bh = it & 63, b = bh >> 4, h = bh & 15;
        const size_t rowb = (size_t)b * T_;
        __syncthreads();
        { const int r = tid >> 5, c4 = (tid & 31) * 4; const f32x4 kv = *(const f32x4*)(KM + ((size_t)(bh * 16 + r)) * 128 + c4);
          u32x2 w = {pkbf(kv[0], kv[1]), pkbf(kv[2], kv[3])}; *(LAS u32x2*)(lds + OFF_KM + r * KST + c4 * 2) = w; *(LAS u32x2*)(lds + OFF_KM + (r + 16) * KST + c4 * 2) = (u32x2){0u, 0u}; }
        { LAS float* bts = (LAS float*)(lds + OFF_BT); bts[tid] = BT[h * 4096 + tid]; bts[tid + 512] = BT[h * 4096 + tid + 512]; }
        const float c31 = BT[h * 4096 + 1023];
        const int q0 = qb * 256 + 32 * wave;
        bf16_t* qptr = MBQ + (rowb + q0 + i32) * D_ + h * 128;
        bf16x8 qf[8];
#pragma unroll
        for (int kc = 0; kc < 8; ++kc) qf[kc] = *(const bf16x8*)(qptr + 16 * kc + 8 * hh);
        __syncthreads();
        unsigned sel = 0;
        {
            f32x16 g;
#pragma unroll
            for (int r = 0; r < 16; ++r) g[r] = 0.f;
#pragma unroll
            for (int kc = 0; kc < 8; ++kc) { const bf16x8 a = *(const LAS bf16x8*)(lds + OFF_KM + i32 * KST + (16 * kc + 8 * hh) * 2); g = MFMA32(a, qf[kc], g); }
            float gate[16];
#pragma unroll
            for (int j = 0; j < 16; ++j) { const int half = (j >> 2) & 1, r = (j & 3) + 4 * (j >> 3); const float og = __shfl_xor(g[r], 32); gate[j] = (hh == half) ? g[r] : og; }
#pragma unroll
            for (int rep = 0; rep < 3; ++rep) { float best = NINF; int bi = -1;
#pragma unroll
                for (int j = 0; j < 16; ++j) if (j < qb && !((sel >> j) & 1u) && gate[j] > best) { best = gate[j]; bi = j; }
                if (bi >= 0) sel |= 1u << bi; }
        }
        { unsigned wsel = sel;
#pragma unroll
          for (int o = 1; o < 64; o <<= 1) wsel |= (unsigned)__shfl_xor((int)wsel, o);
          if (lane == 0) ((LAS unsigned*)(lds + OFF_UM))[wave] = wsel; }
        __syncthreads();
        unsigned um = 0;
#pragma unroll
        for (int w = 0; w < 8; ++w) um |= ((const LAS unsigned*)(lds + OFF_UM))[w];
        um = __builtin_amdgcn_readfirstlane(um);

        f32x16 O[4];
#pragma unroll
        for (int dt = 0; dt < 4; ++dt)
#pragma unroll
            for (int r = 0; r < 16; ++r) O[dt][r] = 0.f;
        float m = NINF, l = 0.f;
        int j = qb, kt = 0, buf = 0;
        u32x4 rk0, rk1, rv0, rv1;
#define MOBA_LOAD(jj, kk) do { const size_t r_ = (rowb + (jj) * 256 + (kk) * 64 + lrow) * D_ + h * 128 + lc * 16; rk0 = *(const u32x4*)(MBK + r_); rk1 = *(const u32x4*)(MBK + r_ + 8); rv0 = *(const u32x4*)(MBV + r_); rv1 = *(const u32x4*)(MBV + r_ + 8); } while (0)
#define MOBA_STORE(bb) do { LAS unsigned char* kd = lds + OFF_K + (bb) * 64 * KST + lrow * KST + lc * 32; *(LAS u32x4*)kd = rk0; *(LAS u32x4*)(kd + 16) = rk1; \
        LAS unsigned char* vd = lds + OFF_V + (bb) * 64 * VST + lrow * VST + lc * 32; *(LAS u32x4*)vd = rv0; *(LAS u32x4*)(vd + 16) = rv1; } while (0)
        MOBA_LOAD(j, kt); MOBA_STORE(0); __syncthreads();
        while (j >= 0) {
            int nj = j, nkt = kt + 1;
            if (nkt == 4) { nkt = 0; do { --nj; } while (nj >= 0 && !((um >> nj) & 1u)); }
            if (nj >= 0) MOBA_LOAD(nj, nkt);
            const bool own = (j == qb);
            bool need;
            if (own) need = (kt * 64 <= 32 * wave + 31); else need = (__ballot((sel >> j) & 1u) != 0ull);
            if (need) {
                const LAS unsigned char* Ks = lds + OFF_K + buf * 64 * KST + i32 * KST + 16 * hh;
                f32x16 s0, s1;
#pragma unroll
                for (int r = 0; r < 16; ++r) { s0[r] = 0.f; s1[r] = 0.f; }
#pragma unroll
                for (int kc = 0; kc < 8; ++kc) { const bf16x8 a0 = *(const LAS bf16x8*)(Ks + 32 * kc), a1 = *(const LAS bf16x8*)(Ks + 32 * KST + 32 * kc);
                    s0 = MFMA32(a0, qf[kc], s0); s1 = MFMA32(a1, qf[kc], s1); }
                const int tq = q0 + i32, kbase = j * 256 + kt * 64;
                const bool far = (q0 - (kbase + 63)) >= 790;
                const bool diag = own && (kbase + 63 > q0);
                const bool lsel = own || ((sel >> j) & 1u);
                const int db = tq - kbase - 4 * hh;
                if (far) {
#pragma unroll
                    for (int r = 0; r < 16; ++r) { s0[r] += c31; s1[r] += c31; }
                } else {
                    const LAS float* bp = (const LAS float*)(lds + OFF_BT) + db;
                    float b0[16], b1[16];
#pragma unroll
                    for (int r = 0; r < 16; ++r) { b0[r] = bp[-(8 * (r >> 2) + (r & 3))]; b1[r] = bp[-(32 + 8 * (r >> 2) + (r & 3))]; }
#pragma unroll
                    for (int r = 0; r < 16; ++r) { s0[r] += b0[r]; s1[r] += b1[r]; }
                }
                if (diag) {
#pragma unroll
                    for (int r = 0; r < 16; ++r) { const int d0 = db - (8 * (r >> 2) + (r & 3)); if (d0 < 0) s0[r] = NINF; if (d0 < 32) s1[r] = NINF; }
                }
                float mx = NINF;
#pragma unroll
                for (int r = 0; r < 16; ++r) { if (!lsel) { s0[r] = NINF; s1[r] = NINF; } mx = fmaxf(mx, fmaxf(s0[r], s1[r])); }
                mx = fmaxf(mx, __shfl_xor(mx, 32));
                const float mnew = fmaxf(m, mx);
                const float alpha = __builtin_amdgcn_exp2f(m - mnew);
                float ps = 0.f;
#pragma unroll
                for (int r = 0; r < 16; ++r) { s0[r] = __builtin_amdgcn_exp2f(s0[r] - mnew); s1[r] = __builtin_amdgcn_exp2f(s1[r] - mnew); ps += s0[r] + s1[r]; }
                l = l * alpha + ps; m = mnew;
                if (__ballot(alpha != 1.0f) != 0ull) {
#pragma unroll
                    for (int dt = 0; dt < 4; ++dt)
#pragma unroll
                        for (int r = 0; r < 16; ++r) O[dt][r] *= alpha;
                }
                const unsigned va = vbase + buf * 64 * VST;
                u32x2 v[8];
                { const bf16x8 pf = pack8(s0, 0); tr8<0, 8 * VST, 64>(va, v);
#pragma unroll
                  for (int dt = 0; dt < 4; ++dt) O[dt] = MFMA32(frag2(v[2 * dt], v[2 * dt + 1]), pf, O[dt]); }
                { const bf16x8 pf = pack8(s0, 1); tr8<16 * VST, 8 * VST, 64>(va, v);
#pragma unroll
                  for (int dt = 0; dt < 4; ++dt) O[dt] = MFMA32(frag2(v[2 * dt], v[2 * dt + 1]), pf, O[dt]); }
                { const bf16x8 pf = pack8(s1, 0); tr8<32 * VST, 8 * VST, 64>(va, v);
#pragma unroll
                  for (int dt = 0; dt < 4; ++dt) O[dt] = MFMA32(frag2(v[2 * dt], v[2 * dt + 1]), pf, O[dt]); }
                { const bf16x8 pf = pack8(s1, 1); tr8<48 * VST, 8 * VST, 64>(va, v);
#pragma unroll
                  for (int dt = 0; dt < 4; ++dt) O[dt] = MFMA32(frag2(v[2 * dt], v[2 * dt + 1]), pf, O[dt]); }
            }
            if (nj >= 0) MOBA_STORE(buf ^ 1);
            __syncthreads();
            j = nj; kt = nkt; buf ^= 1;
        }
#undef MOBA_LOAD
#undef MOBA_STORE
        l += __shfl_xor(l, 32);
        const float inv = 1.0f / l;
#pragma unroll
        for (int dt = 0; dt < 4; ++dt)
#pragma unroll
            for (int r4 = 0; r4 < 4; ++r4) {
                u32x2 w = {pkbf(O[dt][4 * r4] * inv, O[dt][4 * r4 + 1] * inv), pkbf(O[dt][4 * r4 + 2] * inv, O[dt][4 * r4 + 3] * inv)};
                *(u32x2*)(qptr + 32 * dt + 4 * hh + 8 * r4) = w;
            }
    }
}


#define MFMA16(a, b, c) __builtin_amdgcn_mfma_f32_16x16x32_bf16((a), (b), (c), 0, 0, 0)
__device__ __forceinline__ void phase_dn_local(const Params& p, LAS unsigned char* lds) {
    const int tid = tid_opaque(), lane = tid & 63, wave = __builtin_amdgcn_readfirstlane(tid >> 6), i32 = lane & 31, hh = lane >> 5;
    LAS unsigned char* wl = lds + wave * 18432;
    LAS float* Am = (LAS float*)wl; LAS bf16_t* Tb = (LAS bf16_t*)wl; LAS bf16_t* Tb2 = (LAS bf16_t*)(wl + 8192);
    LAS float* gcs = (LAS float*)(wl + 16384); LAS float* bes = gcs + 64;
    bf16_t* QKV = (bf16_t*)(p.ws + WS_QKV); float* BA = (float*)(p.ws + WS_BA); bf16_t* WDN = (bf16_t*)(p.ws + WS_WDN); bf16_t* QKb = (bf16_t*)(p.ws + WS_QK);
    const int gw = blockIdx.x * 8 + wave, NGW = gridDim.x * 8;
    const unsigned fo6 = (unsigned)(i32 * 6144 + 8 * hh);
    const unsigned go6 = (unsigned)(8 * hh * 6144 + i32);
    const unsigned so6 = (unsigned)(4 * hh * 6144 + i32);
    const unsigned so2 = (unsigned)(4 * hh * D_ + i32);
    const unsigned soq = (unsigned)(4 * hh * 64 + i32);
    for (int ch = gw; ch < 4096; ch += NGW) {
        const int n = ch & 63, bh = ch >> 6, b = bh >> 4, h = bh & 15;
        const size_t r0 = (size_t)b * T_ + n * 64;
        float* bap = BA + r0 * 32 + h;
        const float be = bap[lane * 32];
        float gc = bap[lane * 32 + 16];
        { int ln = lane; asm volatile("" : "+v"(ln));
#pragma unroll
          for (int o = 1; o < 64; o <<= 1) { const float t = __shfl(gc, (ln - o) & 63); if (ln >= o) gc += t; } }
        gcs[lane] = gc; bes[lane] = be;
        bf16_t* kslab = QKV + r0 * 6144 + 2048 + h * 128;
        bf16_t* vslab = QKV + r0 * 6144 + 4096 + h * 128;
        const bf16_t* qslab = QKV + r0 * 6144 + h * 128;
        LDS_WAIT();
        const float gcj0 = gcs[i32], gcj1 = gcs[32 + i32];
        {
            f32x16 a00, a10, a11; bf16x8 kk0[8], kk1[8];
#pragma unroll
            for (int r = 0; r < 16; ++r) { a00[r] = 0.f; a10[r] = 0.f; a11[r] = 0.f; }
#pragma unroll
            for (int kc = 0; kc < 8; ++kc) { kk0[kc] = *(const bf16x8*)(kslab + 16 * kc + fo6); kk1[kc] = *(const bf16x8*)(kslab + 32 * 6144 + 16 * kc + fo6); }
            __builtin_amdgcn_sched_barrier(0);
#pragma unroll
            for (int kc = 0; kc < 8; ++kc) { a00 = MFMA32(kk0[kc], kk0[kc], a00); a10 = MFMA32(kk1[kc], kk0[kc], a10); a11 = MFMA32(kk1[kc], kk1[kc], a11); }
            const LAS float* gcl = gcs + 4 * hh; const LAS float* bel = bes + 4 * hh; LAS float* aml = Am + soq;
#pragma unroll
            for (int r = 0; r < 16; ++r) {
                const int ic = (r & 3) + 8 * (r >> 2);
                const float gi0 = gcl[ic], gi1 = gcl[32 + ic], bi0 = bel[ic], bi1 = bel[32 + ic];
                aml[ic * 64] = bi0 * a00[r] * __expf(fminf(gi0 - gcj0, 0.f));
                aml[(32 + ic) * 64] = bi1 * a10[r] * __expf(fminf(gi1 - gcj0, 0.f));
                aml[(32 + ic) * 64 + 32] = bi1 * a11[r] * __expf(fminf(gi1 - gcj1, 0.f));
            }
        }
        LDS_WAIT();
        {
            float T[64];
            f32x4 ra[16];
#define DN_LOADROW(i_, buf_) do { _Pragma("unroll") for (int j4 = 0; j4 < ((i_) + 3) / 4; ++j4) buf_[j4] = *(const LAS f32x4*)(Am + (i_) * 64 + 4 * j4); } while (0)
#define DN_ROW(i_, buf_) do { float c0 = 0.f, c1 = 0.f, c2 = 0.f, c3 = 0.f; \
                _Pragma("unroll") for (int j4 = 0; j4 < ((i_) + 3) / 4; ++j4) { \
                    if (4 * j4 + 0 < (i_)) c0 += buf_[j4][0] * T[4 * j4 + 0]; if (4 * j4 + 1 < (i_)) c1 += buf_[j4][1] * T[4 * j4 + 1]; \
                    if (4 * j4 + 2 < (i_)) c2 += buf_[j4][2] * T[4 * j4 + 2]; if (4 * j4 + 3 < (i_)) c3 += buf_[j4][3] * T[4 * j4 + 3]; } \
                T[i_] = ((lane == (i_)) ? 1.0f : 0.0f) - ((c0 + c1) + (c2 + c3)); } while (0)
#pragma unroll
            for (int i = 0; i < 64; ++i) {
                DN_LOADROW(i, ra); asm volatile("" ::: "memory");
                DN_ROW(i, ra);
                asm volatile("" ::: "memory");
            }
#undef DN_LOADROW
#undef DN_ROW
            LDS_WAIT();
            const float eg = __expf(gc);
#pragma unroll
            for (int i = 0; i < 64; ++i) { const float tp = T[i] * be; Tb[i * 64 + lane] = f2bf(tp); Tb2[i * 64 + lane] = f2bf(tp * eg); }
        }
        LDS_WAIT();
#define DN_TMUL(TBUF, SRC, DST, DSTLD, SOFF) do { \
            _Pragma("unroll 1") for (int dt = 0; dt < 4; ++dt) { \
                f32x16 u0, u1; \
                _Pragma("unroll") for (int r = 0; r < 16; ++r) { u0[r] = 0.f; u1[r] = 0.f; } \
                unsigned short rw[4][8]; \
                _Pragma("unroll") for (int jc = 0; jc < 4; ++jc) _Pragma("unroll") for (int e = 0; e < 8; ++e) rw[jc][e] = ((SRC) + (16 * jc + e) * 6144 + 32 * dt)[go6]; \
                __builtin_amdgcn_sched_barrier(0);     \
                _Pragma("unroll") for (int jc = 0; jc < 4; ++jc) { \
                    bf16x8 vb; \
                    _Pragma("unroll") for (int e = 0; e < 8; ++e) vb[e] = (short)rw[jc][e]; \
                    const bf16x8 ta0 = *(const LAS bf16x8*)((const LAS unsigned char*)(TBUF) + ((i32) * 64 + 16 * jc + 8 * hh) * 2); \
                    const bf16x8 ta1 = *(const LAS bf16x8*)((const LAS unsigned char*)(TBUF) + ((32 + i32) * 64 + 16 * jc + 8 * hh) * 2); \
                    u0 = MFMA32(ta0, vb, u0); u1 = MFMA32(ta1, vb, u1); } \
                asm volatile("" ::: "memory"); \
                _Pragma("unroll") for (int r = 0; r < 16; ++r) { \
                    ((DST) + ((r & 3) + 8 * (r >> 2)) * (DSTLD) + 32 * dt)[SOFF] = f2bf(u0[r]); \
                    ((DST) + (32 + (r & 3) + 8 * (r >> 2)) * (DSTLD) + 32 * dt)[SOFF] = f2bf(u1[r]); } \
                asm volatile("" ::: "memory"); } } while (0)
        DN_TMUL(Tb, vslab, vslab, 6144, so6);
        { bf16_t* wslab = WDN + r0 * D_ + h * 128; DN_TMUL(Tb2, kslab, wslab, D_, so2); }
#undef DN_TMUL
        {
            bf16x8 kf[2][8];
#pragma unroll
            for (int it = 0; it < 2; ++it)
#pragma unroll
                for (int kc = 0; kc < 8; ++kc) kf[it][kc] = *(const bf16x8*)(kslab + 32 * it * 6144 + 16 * kc + fo6);
            f32x16 q00, q10, q11; bf16x8 qa0[4], qa1[4];
#pragma unroll
            for (int r = 0; r < 16; ++r) { q00[r] = 0.f; q10[r] = 0.f; q11[r] = 0.f; }
#pragma unroll
            for (int kh = 0; kh < 2; ++kh) {
#pragma unroll
                for (int kc = 0; kc < 4; ++kc) { qa0[kc] = *(const bf16x8*)(qslab + 16 * (4 * kh + kc) + fo6); qa1[kc] = *(const bf16x8*)(qslab + 32 * 6144 + 16 * (4 * kh + kc) + fo6); }
                __builtin_amdgcn_sched_barrier(0);
#pragma unroll
                for (int kc = 0; kc < 4; ++kc) { q00 = MFMA32(qa0[kc], kf[0][4 * kh + kc], q00); q10 = MFMA32(qa1[kc], kf[0][4 * kh + kc], q10); q11 = MFMA32(qa1[kc], kf[1][4 * kh + kc], q11); }
                __builtin_amdgcn_sched_barrier(0);
            }
            asm volatile("" ::: "memory");
            bf16_t* qkc = QKb + (size_t)ch * 4096;
            const LAS float* gcl = gcs + 4 * hh;
#pragma unroll
            for (int r = 0; r < 16; ++r) {
                const int ic = (r & 3) + 8 * (r >> 2);
                const float gi0 = gcl[ic], gi1 = gcl[32 + ic];
                const bool low = (ic + 4 * hh >= i32);
                (qkc + ic * 64)[soq] = f2bf(low ? q00[r] * __expf(fminf(gi0 - gcj0, 0.f)) : 0.f);
                (qkc + ic * 64 + 32)[soq] = (bf16_t)0;
                (qkc + (32 + ic) * 64)[soq] = f2bf(q10[r] * __expf(fminf(gi1 - gcj0, 0.f)));
                (qkc + (32 + ic) * 64 + 32)[soq] = f2bf(low ? q11[r] * __expf(fminf(gi1 - gcj1, 0.f)) : 0.f);
            }
            asm volatile("" ::: "memory");
#pragma unroll
            for (int it = 0; it < 2; ++it)
#pragma unroll
                for (int kc = 0; kc < 8; ++kc) {
#pragma unroll
                    for (int e = 0; e < 8; ++e) (kslab + (8 * kc + (e >> 1)) * 6144 + (e & 1) * 64 + 32 * it)[so6] = (bf16_t)kf[it][kc][e];
                    asm volatile("" ::: "memory"); }
        }
        bap[lane * 32 + 16] = gc;
        LDS_WAIT();
    }
}
__device__ __forceinline__ bf16x8 pack44(const f32x4 a, const f32x4 b) { u32x4 w = {pkbf(a[0], a[1]), pkbf(a[2], a[3]), pkbf(b[0], b[1]), pkbf(b[2], b[3])}; return __builtin_bit_cast(bf16x8, w); }

__device__ __forceinline__ bf16x8 ldl44(const LAS unsigned char* p0) { const u32x2 a = *(const LAS u32x2*)p0, b = *(const LAS u32x2*)(p0 + 32); u32x4 w = {a.x, a.y, b.x, b.y}; return __builtin_bit_cast(bf16x8, w); }
#define SC_BAR() do { asm volatile("s_waitcnt lgkmcnt(0)" ::: "memory"); __builtin_amdgcn_s_barrier(); asm volatile("" ::: "memory"); } while (0)
__device__ __forceinline__ void phase_dn_scan3(const Params& p, LAS unsigned char* lds) {
    constexpr int WP = 272, KP = 144, QP = 144, UP = 80;
    constexpr int O_W = 0, O_Q = O_W + 64 * WP, O_KT = O_Q + 64 * WP, O_QK = O_KT + 128 * KP, O_U = O_QK + 64 * QP, O_GC = O_U + 64 * UP, BUF = O_GC + 256;
    static_assert(2 * BUF <= LDS_BYTES, "scan LDS image");
    const int tid = tid_opaque(), lane = tid & 63, wave = __builtin_amdgcn_readfirstlane(tid >> 6), i16 = lane & 15, g4 = lane >> 4;
    bf16_t* QKV = (bf16_t*)(p.ws + WS_QKV); const float* BA = (const float*)(p.ws + WS_BA); const bf16_t* WDN = (const bf16_t*)(p.ws + WS_WDN); const bf16_t* QKb = (const bf16_t*)(p.ws + WS_QK);
    for (int item = blockIdx.x; item < 256; item += gridDim.x) {
        const int xc = item & 7, sl = item >> 3, dvq = sl & 3, bh = (sl >> 2) * 8 + xc, b = bh >> 4, h = bh & 15;
        const size_t rowb = (size_t)b * T_;
        __syncthreads();
        if (wave >= 2) {
            const int lt = tid - 128;
            const int p0 = lt, p1 = lt + 384, p2 = (lt + 768 < 1024) ? lt + 768 : lt, q1 = (lt + 384 < 512) ? lt + 384 : lt, pu = lt & 255;
            const unsigned gw0 = (unsigned)((p0 >> 4) * (D_ * 2) + (p0 & 15) * 16), gw1 = (unsigned)((p1 >> 4) * (D_ * 2) + (p1 & 15) * 16), gw2 = (unsigned)((p2 >> 4) * (D_ * 2) + (p2 & 15) * 16);
            const unsigned g60 = (unsigned)((p0 >> 4) * 12288 + (p0 & 15) * 16), g61 = (unsigned)((p1 >> 4) * 12288 + (p1 & 15) * 16), g62 = (unsigned)((p2 >> 4) * 12288 + (p2 & 15) * 16);
            const unsigned lw0 = (unsigned)((p0 >> 4) * WP + (p0 & 15) * 16), lw1 = (unsigned)((p1 >> 4) * WP + (p1 & 15) * 16), lw2 = (unsigned)((p2 >> 4) * WP + (p2 & 15) * 16);
            const unsigned lk0 = (unsigned)((2 * (p0 >> 4) + ((p0 >> 3) & 1)) * KP + (p0 & 7) * 16), lk1 = (unsigned)((2 * (p1 >> 4) + ((p1 >> 3) & 1)) * KP + (p1 & 7) * 16), lk2 = (unsigned)((2 * (p2 >> 4) + ((p2 >> 3) & 1)) * KP + (p2 & 7) * 16);
            const unsigned gq0 = (unsigned)(p0 * 16), gq1 = (unsigned)(q1 * 16);
            const unsigned lq0 = (unsigned)((p0 >> 3) * QP + (p0 & 7) * 16), lq1 = (unsigned)((q1 >> 3) * QP + (q1 & 7) * 16);
            const unsigned gu0 = (unsigned)((pu >> 2) * 12288 + (pu & 3) * 16), lu0 = (unsigned)((pu >> 2) * UP + (pu & 3) * 16);
            const char* Wg = (const char*)(WDN + rowb * D_ + h * 128);
            const char* Qg = (const char*)(QKV + rowb * 6144 + h * 128);
            const char* Kg = (const char*)(QKV + rowb * 6144 + 2048 + h * 128);
            const char* Ug = (const char*)(QKV + rowb * 6144 + 4096 + h * 128 + dvq * 32);
            const char* QKg = (const char*)(QKb + (size_t)(bh * 64) * 4096);
            const float* gcp = BA + (rowb + (lt & 63)) * 32 + 16 + h;
            u32x4 dA[12], dB[12], dC[12]; float gA = 0.f, gB = 0.f, gC = 0.f;
#define SC_LOAD(D, GV, n) do { const char* w_ = Wg + (size_t)(n) * (64 * D_ * 2); const char* q_ = Qg + (size_t)(n) * (64 * 12288); const char* k_ = Kg + (size_t)(n) * (64 * 12288); \
                const char* u_ = Ug + (size_t)(n) * (64 * 12288); const char* qk_ = QKg + (size_t)(n) * 8192; \
                D[0] = *(const u32x4*)(w_ + gw0); D[1] = *(const u32x4*)(w_ + gw1); D[2] = *(const u32x4*)(w_ + gw2); \
                D[3] = *(const u32x4*)(q_ + g60); D[4] = *(const u32x4*)(q_ + g61); D[5] = *(const u32x4*)(q_ + g62); \
                D[6] = *(const u32x4*)(k_ + g60); D[7] = *(const u32x4*)(k_ + g61); D[8] = *(const u32x4*)(k_ + g62); \
                D[9] = *(const u32x4*)(qk_ + gq0); D[10] = *(const u32x4*)(qk_ + gq1); D[11] = *(const u32x4*)(u_ + gu0); \
                GV = gcp[(size_t)(n) * 2048]; } while (0)
#define SC_STORE(D, GV, bb) do { LAS unsigned char* bp = lds + (bb) * BUF; \
                *(LAS u32x4*)(bp + O_W + lw0) = D[0]; *(LAS u32x4*)(bp + O_W + lw1) = D[1]; *(LAS u32x4*)(bp + O_W + lw2) = D[2]; \
                *(LAS u32x4*)(bp + O_Q + lw0) = D[3]; *(LAS u32x4*)(bp + O_Q + lw1) = D[4]; *(LAS u32x4*)(bp + O_Q + lw2) = D[5]; \
                *(LAS u32x4*)(bp + O_KT + lk0) = D[6]; *(LAS u32x4*)(bp + O_KT + lk1) = D[7]; *(LAS u32x4*)(bp + O_KT + lk2) = D[8]; \
                *(LAS u32x4*)(bp + O_QK + lq0) = D[9]; *(LAS u32x4*)(bp + O_QK + lq1) = D[10]; *(LAS u32x4*)(bp + O_U + lu0) = D[11]; \
                ((LAS float*)(bp + O_GC))[lt & 63] = GV; } while (0)
#define SC_CL(n) ((n) < 64 ? (n) : 63)
#define SC_STEP(D, GV, t, bb) do { if ((t) < 64) { if ((t) + 1 < 64) SC_STORE(D, GV, bb); SC_LOAD(D, GV, SC_CL((t) + 4)); SC_BAR(); } } while (0)
            SC_LOAD(dA, gA, 0); SC_STORE(dA, gA, 0);
            SC_LOAD(dA, gA, 1); SC_LOAD(dB, gB, 2); SC_LOAD(dC, gC, 3);
            SC_BAR();
#pragma unroll 1
            for (int n = 0; n < 64; n += 6) {
                SC_STEP(dA, gA, n, 1); SC_STEP(dB, gB, n + 1, 0); SC_STEP(dC, gC, n + 2, 1);
                SC_STEP(dA, gA, n + 3, 0); SC_STEP(dB, gB, n + 4, 1); SC_STEP(dC, gC, n + 5, 0);
            }
#undef SC_STEP
#undef SC_CL
#undef SC_LOAD
#undef SC_STORE
        } else {
            f32x4 S[8];
#pragma unroll
            for (int dt = 0; dt < 8; ++dt) S[dt] = (f32x4){0.f, 0.f, 0.f, 0.f};
            SC_BAR();
#pragma unroll 1
            for (int n = 0; n < 64; ++n) {
                const LAS unsigned char* bp = lds + (n & 1) * BUF;
                const LAS unsigned char* wr_ = bp + O_W + i16 * WP + 8 * g4;
                const LAS unsigned char* qr_ = bp + O_Q + i16 * WP + 8 * g4;
                const LAS unsigned char* qkr = bp + O_QK + i16 * QP + 8 * g4;
                const LAS unsigned char* ktr = bp + O_KT + i16 * KP + 8 * g4;
                const LAS unsigned char* ur = bp + O_U + (4 * g4) * UP + (wave * 16 + i16) * 2;
                const LAS float* gcl = (const LAS float*)(bp + O_GC) + 4 * g4;
                const float gl = ((const LAS float*)(bp + O_GC))[63];
                bf16_t* uo = QKV + (rowb + n * 64 + 4 * g4) * 6144 + 4096 + h * 128 + dvq * 32 + wave * 16 + i16;
                bf16x8 wf[4][4], qf4[4][4];
#pragma unroll
                for (int mt = 0; mt < 4; ++mt)
#pragma unroll
                    for (int kc = 0; kc < 4; ++kc) { wf[mt][kc] = ldl44(wr_ + 16 * mt * WP + 64 * kc); qf4[mt][kc] = ldl44(qr_ + 16 * mt * WP + 64 * kc); }
                asm volatile("" ::: "memory");
                bf16x8 sb[4];
#pragma unroll
                for (int kc = 0; kc < 4; ++kc) sb[kc] = pack44(S[2 * kc], S[2 * kc + 1]);
                f32x4 ws4[4], qs4[4];
#pragma unroll
                for (int mt = 0; mt < 4; ++mt) { ws4[mt] = (f32x4){0.f, 0.f, 0.f, 0.f}; qs4[mt] = ws4[mt]; }
#pragma unroll
                for (int kc = 0; kc < 4; ++kc)
#pragma unroll
                    for (int mt = 0; mt < 4; ++mt) { ws4[mt] = MFMA16(wf[mt][kc], sb[kc], ws4[mt]); qs4[mt] = MFMA16(qf4[mt][kc], sb[kc], qs4[mt]); }
                bf16x8 qkf[4][2], ktf[8][2];
#pragma unroll
                for (int mt = 0; mt < 4; ++mt) { qkf[mt][0] = ldl44(qkr + 16 * mt * QP); qkf[mt][1] = ldl44(qkr + 16 * mt * QP + 64); }
#pragma unroll
                for (int dt = 0; dt < 8; ++dt) { ktf[dt][0] = ldl44(ktr + 16 * dt * KP); ktf[dt][1] = ldl44(ktr + 16 * dt * KP + 64); }
                float gcv[4][4], uu[4][4];
#pragma unroll
                for (int mt = 0; mt < 4; ++mt)
#pragma unroll
                    for (int r = 0; r < 4; ++r) { gcv[mt][r] = gcl[16 * mt + r]; uu[mt][r] = bf2f(*(const LAS bf16_t*)(ur + (16 * mt + r) * UP)); }
                asm volatile("" ::: "memory");
                f32x4 vn[4], vs[4], eg[4];
#pragma unroll
                for (int mt = 0; mt < 4; ++mt)
#pragma unroll
                    for (int r = 0; r < 4; ++r) { eg[mt][r] = __expf(gcv[mt][r]); vn[mt][r] = uu[mt][r] - ws4[mt][r]; vs[mt][r] = vn[mt][r] * __expf(gl - gcv[mt][r]); }
                const bf16x8 vb10 = pack44(vn[0], vn[1]), vb11 = pack44(vn[2], vn[3]), vb20 = pack44(vs[0], vs[1]), vb21 = pack44(vs[2], vs[3]);
#pragma unroll
                for (int mt = 0; mt < 4; ++mt) { f32x4 o = qs4[mt] * eg[mt];
                    o = MFMA16(qkf[mt][0], vb10, o); o = MFMA16(qkf[mt][1], vb11, o);
#pragma unroll
                    for (int r = 0; r < 4; ++r) uo[(size_t)(16 * mt + r) * 6144] = f2bf(o[r]); }
                const float egl = __expf(gl);
#pragma unroll
                for (int dt = 0; dt < 8; ++dt) { f32x4 sn = S[dt] * egl; sn = MFMA16(ktf[dt][0], vb20, sn); sn = MFMA16(ktf[dt][1], vb21, sn); S[dt] = sn; }
                SC_BAR();
            }
        }
    }
}


__device__ __forceinline__ void phase_ba(const Params& p, LAS unsigned char* lds) {
    const int tid = tid_opaque(), lane = tid & 63, wave = __builtin_amdgcn_readfirstlane(tid >> 6), i32 = lane & 31, hh = lane >> 5;
    const bf16_t* U = (const bf16_t*)(p.ws + WS_U); const bf16_t* Wb = (const bf16_t*)(p.ws + WS_WIN1) + (size_t)12288 * 2048; float* BA = (float*)(p.ws + WS_BA);
    LAS float* red = (LAS float*)lds;
    for (int item = blockIdx.x; item < 256; item += gridDim.x) {
        const size_t row0 = (size_t)item * 64;
        f32x16 a0, a1;
#pragma unroll
        for (int r = 0; r < 16; ++r) { a0[r] = 0.f; a1[r] = 0.f; }
        const bf16_t* bp = Wb + (size_t)i32 * 2048 + 256 * wave + 8 * hh;
        const bf16_t* ap = U + (row0 + i32) * D_ + 256 * wave + 8 * hh;
#pragma unroll
        for (int kb = 0; kb < 2; ++kb) {
            bf16x8 bfr[8], af0[8], af1[8];
#pragma unroll
            for (int ks = 0; ks < 8; ++ks) { bfr[ks] = *(const bf16x8*)(bp + 16 * (8 * kb + ks)); af0[ks] = *(const bf16x8*)(ap + 16 * (8 * kb + ks)); af1[ks] = *(const bf16x8*)(ap + (size_t)32 * D_ + 16 * (8 * kb + ks)); }
            __builtin_amdgcn_sched_barrier(0);
#pragma unroll
            for (int ks = 0; ks < 8; ++ks) { a0 = MFMA32(af0[ks], bfr[ks], a0); a1 = MFMA32(af1[ks], bfr[ks], a1); }
        }
        __syncthreads();
#pragma unroll
        for (int r = 0; r < 16; ++r) { red[((wave * 2 + 0) * 16 + r) * 64 + lane] = a0[r]; red[((wave * 2 + 1) * 16 + r) * 64 + lane] = a1[r]; }
        __syncthreads();
#pragma unroll
        for (int q = 0; q < 4; ++q) { const int idx = tid + 512 * q, mt = idx >> 10, r = (idx >> 6) & 15, ln = idx & 63; float t = 0.f;
#pragma unroll
            for (int w8 = 0; w8 < 8; ++w8) t += red[((w8 * 2 + mt) * 16 + r) * 64 + ln];
            BA[(row0 + 32 * mt + (r & 3) + 8 * (r >> 2) + 4 * (ln >> 5)) * 32 + (ln & 31)] = t; }
    }
}

__device__ __forceinline__ void phase_ya(const Params& p) {
    const int tid_ = tid_opaque(); const int lane = tid_ & 63, wave = tid_ >> 6;
    const int gw = blockIdx.x * 8 + wave, NGW = gridDim.x * 8;
    bf16_t* QKV = (bf16_t*)(p.ws + WS_QKV);
    const int e8 = lane & 15;
    float gn[8];
#pragma unroll
    for (int i = 0; i < 8; ++i) gn[i] = p.dn_norm_g[e8 * 8 + i];
    for (int it = gw; it < M_ * 16 / 4; it += 2 * NGW) {
        const int it2 = it + NGW; const bool v2 = it2 < M_ * 16 / 4;
        const int pairA = it * 4 + (lane >> 4), pairB = (v2 ? it2 : it) * 4 + (lane >> 4);
        bf16_t* opA = QKV + (size_t)(pairA >> 4) * 6144 + 4096 + (pairA & 15) * 128 + e8 * 8; const bf16_t* zpA = opA - 4096;
        bf16_t* opB = QKV + (size_t)(pairB >> 4) * 6144 + 4096 + (pairB & 15) * 128 + e8 * 8; const bf16_t* zpB = opB - 4096;
        const u32x4 oA = *(const u32x4*)opA, zA = *(const u32x4*)zpA, oB = *(const u32x4*)opB, zB = *(const u32x4*)zpB;
#pragma unroll
        for (int half = 0; half < 2; ++half) {
            float of[8], zf[8]; unpack8(half ? oB : oA, of); unpack8(half ? zB : zA, zf);
            float ss = 0.f;
#pragma unroll
            for (int i = 0; i < 8; ++i) ss += of[i] * of[i];
            ss += __shfl_xor(ss, 1); ss += __shfl_xor(ss, 2); ss += __shfl_xor(ss, 4); ss += __shfl_xor(ss, 8);
            const float rs = rsqrtf(ss * (1.0f / 128.0f) + 1e-6f);
            u32x4 w;
#pragma unroll
            for (int e = 0; e < 4; ++e) w[e] = cvt_pk_bf16(of[2 * e] * rs * gn[2 * e] * siluf_(zf[2 * e]), of[2 * e + 1] * rs * gn[2 * e + 1] * siluf_(zf[2 * e + 1]));
            if (half == 0) *(u32x4*)opA = w; else if (v2) *(u32x4*)opB = w;
        }
    }
}


#define XB_TMO      128
#define XB_XCNT(j)  (256  + 64 * (j))
#define XB_XSUB(j)  (1280 + 64 * (j))
#define XB_XGEN(j)  (2304 + 64 * (j))
#define XB_TOP      3328
#define XB_TOPGEN   3392
#define XCD_BAR_WORDS 3456
#define XB_SPIN_CAP (1u << 18)
__device__ __forceinline__ unsigned xb_ld(unsigned* p)              { return __hip_atomic_load(p, __ATOMIC_RELAXED, __HIP_MEMORY_SCOPE_AGENT); }
__device__ __forceinline__ unsigned xb_add(unsigned* p, unsigned v) { return __hip_atomic_fetch_add(p, v, __ATOMIC_RELAXED, __HIP_MEMORY_SCOPE_AGENT); }
__device__ __forceinline__ unsigned xb_xcc_id() { return (unsigned)__builtin_amdgcn_s_getreg((3 << 11) | 20) & 0xFu; }
#define XB_SPIN(cond, bar) do { unsigned _sp = 0; while (cond) { __builtin_amdgcn_s_sleep(1); \
    if ((++_sp & 255u) == 0u) { if (xb_ld(&(bar)[XB_TMO])) break; if (_sp > XB_SPIN_CAP) { atomicAdd(&(bar)[XB_TMO], 1u); break; } } } } while (0)
struct XcdBarrier { unsigned* bar; unsigned x; volatile LAS unsigned* st; };
__device__ __forceinline__ XcdBarrier xcd_barrier_post(unsigned* bar, volatile LAS unsigned* st) {
    XcdBarrier b; b.bar = bar; b.x = xb_xcc_id(); b.st = st;
    if (threadIdx.x == 0) (void)xb_add(&bar[XB_XCNT(b.x)], 1u);
    return b;
}
__device__ __forceinline__ void xcd_barrier_complete(unsigned* bar, unsigned x, unsigned& nloc, unsigned& nx) {
    const unsigned G = gridDim.x * gridDim.y * gridDim.z;
    unsigned sum, cnt, mine, sp = 0u;
    for (;;) {
        sum = 0u; cnt = 0u; mine = 0u;
#pragma unroll
        for (unsigned j = 0; j < 16; ++j) { const unsigned c = xb_ld(&bar[XB_XCNT(j)]); sum += c; cnt += (c > 0u) ? 1u : 0u; mine = (j == x) ? c : mine; }
        if (sum == G) break;
        __builtin_amdgcn_s_sleep(1);
        if ((++sp & 255u) == 0u) { if (xb_ld(&bar[XB_TMO])) break; if (sp > XB_SPIN_CAP) { atomicAdd(&bar[XB_TMO], 1u); break; } }
    }
    nloc = mine > 0u ? mine : 1u; nx = cnt > 0u ? cnt : 1u;
}
__device__ __forceinline__ void xcd_barrier(const XcdBarrier& b) {
    asm volatile("s_waitcnt vmcnt(0)" ::: "memory");
    __syncthreads();
    if (threadIdx.x == 0) {
        unsigned* bar = b.bar;
        __builtin_amdgcn_s_waitcnt(0);
        unsigned nloc = b.st[0], nx = b.st[1];
        if (nloc == 0u) { xcd_barrier_complete(bar, b.x, nloc, nx); b.st[0] = nloc; b.st[1] = nx; }
        const unsigned old = xb_add(&bar[XB_XSUB(b.x)], 1u);
        const unsigned gen = old / nloc;
        if (old + 1u == (gen + 1u) * nloc) {
            __builtin_amdgcn_fence(__ATOMIC_RELEASE, "agent");
            asm volatile("s_waitcnt vmcnt(0)" ::: "memory");
            const unsigned og = xb_add(&bar[XB_TOP], 1u);
            const unsigned tg = og / nx;
            if (og + 1u == (tg + 1u) * nx) xb_add(&bar[XB_TOPGEN], 1u);
            else XB_SPIN(xb_ld(&bar[XB_TOPGEN]) == tg, bar);
            __builtin_amdgcn_fence(__ATOMIC_ACQUIRE, "agent");
            xb_add(&bar[XB_XGEN(b.x)], 1u);
            asm volatile("s_waitcnt vmcnt(0)" ::: "memory");
        } else {
            XB_SPIN(xb_ld(&bar[XB_XGEN(b.x)]) == gen, bar);
            __builtin_amdgcn_fence(__ATOMIC_ACQUIRE, "agent");
            asm volatile("s_waitcnt vmcnt(0)" ::: "memory");
        }
    }
    __syncthreads();
}

__global__ void __launch_bounds__(512, 2) fwd_megakernel(Params p) {
    extern __shared__ __attribute__((aligned(16))) unsigned char lds_raw[];
    LAS unsigned char* lds = (LAS unsigned char*)lds_raw;
    cg::grid_group grid = cg::this_grid();
    __shared__ unsigned xb_st[2];
    if (threadIdx.x == 0) { xb_st[0] = 0u; xb_st[1] = 0u; }
    __syncthreads();
    const XcdBarrier xbar = xcd_barrier_post((unsigned*)(p.ws + WS_XBAR), (volatile LAS unsigned*)xb_st);
#define GRID_SYNC() xcd_barrier(xbar)
    const int G = gridDim.x, bid = blockIdx.x;
    unsigned char* ws = p.ws;
    bf16_t* U = (bf16_t*)(ws + WS_U); bf16_t* ACT = (bf16_t*)(ws + WS_ACT); bf16_t* QKV = (bf16_t*)(ws + WS_QKV); bf16_t* MB = (bf16_t*)(ws + WS_MB);
    const float* ada = (const float*)(ws + WS_ADA);
    const bf16_t* W13 = (const bf16_t*)(ws + WS_W13); const bf16_t* W2 = (const bf16_t*)(ws + WS_W2);

    phase0(p, lds);
    grid.sync();
    phase_ada_reduce(p);
    GRID_SYNC();
    phase_normmod(p.x, p.norm1_g, ada, 0 * D_, 1 * D_, U);
    GRID_SYNC();
    { pg8::Gemm g{U, D_, W13, D_}; pg8::StaticOrder S; S.init(64, 44, G, bid); pg8::EpiSwiglu E{ACT}; pg8::gemm_phase(lds, g, S, E); }
    GRID_SYNC();
    { pg8::Gemm g{ACT, FF_, W2, FF_}; pg8::StaticOrder S; S.init(64, 8, G, bid); pg8::EpiResid E{p.x, p.out, ada + 2 * D_, 0.5f}; pg8::gemm_phase(lds, g, S, E); }
    GRID_SYNC();
#ifndef PROBE_N
#define PROBE_N 0
#endif
    for (int pass = (PROBE_N > 0 ? 0 : 1); pass < 2; ++pass) {
    const int lim = (pass == 0) ? PROBE_N : 99;
    if (lim >= 1) { phase_normmod(p.out, p.norm2_g, ada, 3 * D_, 4 * D_, U); GRID_SYNC(); }
    if (lim >= 2) { pg8::Gemm g{U, D_, (const bf16_t*)(ws + WS_WIN1), D_}; pg8::StaticOrder S; S.init(64, 48, G, bid); pg8::EpiIn1 E{QKV, MB, (float*)(ws + WS_BA)}; pg8::gemm_phase(lds, g, S, E); phase_ba(p, lds); GRID_SYNC(); }
    if (lim >= 3) { phase_halo(p); GRID_SYNC(); }
    if (lim >= 4) { phase_postproc(p, lds); GRID_SYNC(); }
    if (lim >= 6) { phase_dn_local(p, lds); GRID_SYNC(); }
    if (lim >= 7) { phase_dn_scan3(p, lds); __syncthreads(); }
    if (lim >= 8) { phase_moba_mfma(p, lds, (unsigned)(size_t)lds_raw); }
    if (lim >= 7) GRID_SYNC();
    if (lim >= 9) { pg8::Gemm g{U, D_, (const bf16_t*)(ws + WS_WIN2), D_}; pg8::StaticOrder S; S.init(64, 24, G, bid); pg8::EpiIn2 E{QKV, MB + (size_t)M_ * D_}; pg8::gemm_phase(lds, g, S, E); GRID_SYNC(); }
    if (lim >= 10) { phase_ya(p); GRID_SYNC(); }
    if (lim >= 11) {
      { pg8::Gemm g{QKV + 4096, 6144, (const bf16_t*)(ws + WS_WPAB), D_}; pg8::StaticOrder S; S.init(64, 8, G, bid);
        pg8::EpiProjA E{QKV + 2048, 6144, MB + 2 * (size_t)M_ * D_}; pg8::gemm_phase(lds, g, S, E); }
      { pg8::Gemm g{MB, D_, (const bf16_t*)(ws + WS_WPAB) + (size_t)2048 * 2048, D_}; pg8::StaticOrder S; S.init(64, 8, G, bid);
        pg8::EpiProjB E{MB + (size_t)M_ * D_, D_, MB + 2 * (size_t)M_ * D_, U}; pg8::gemm_phase(lds, g, S, E); }
      GRID_SYNC(); }
    }
    { pg8::Gemm g{U, D_, (const bf16_t*)(ws + WS_WOUT), D_}; pg8::StaticOrder S; S.init(64, 8, G, bid); pg8::EpiResid E{p.out, p.out, ada + 5 * D_, 1.0f}; pg8::gemm_phase(lds, g, S, E); }
    GRID_SYNC();
    phase_normmod(p.out, p.norm3_g, ada, 6 * D_, 7 * D_, U);
    { const int tid_ = tid_opaque(); const int lane = tid_ & 63, wave = tid_ >> 6; __syncthreads();
      convert_ffn(p.f2w1, p.f2w3, p.f2w2, (bf16_t*)(ws + WS_W13), (bf16_t*)(ws + WS_W2), (LAS float*)(lds + wave * 8448), bid * 8 + wave, G * 8, lane); }
    GRID_SYNC();
    { pg8::Gemm g{U, D_, W13, D_}; pg8::StaticOrder S; S.init(64, 44, G, bid); pg8::EpiSwiglu E{ACT}; pg8::gemm_phase(lds, g, S, E); }
    GRID_SYNC();
    { pg8::Gemm g{ACT, FF_, W2, FF_}; pg8::StaticOrder S; S.init(64, 8, G, bid); pg8::EpiResid E{p.out, p.out, ada + 8 * D_, 0.5f}; pg8::gemm_phase(lds, g, S, E); }
}

extern "C" void kernel_launch(void* const* d_in, const int* in_sizes, int n_in, void* d_out, int out_size, void* d_ws, size_t ws_size, hipStream_t stream) {
    static int grid_blocks = 0;
    if (grid_blocks == 0) {
        if (n_in != 24 || ws_size < WS_END) { fprintf(stderr, "kernel_launch: unexpected n_in %d or ws_size %zu (< %zu)\n", n_in, ws_size, (size_t)WS_END); grid_blocks = -1; return; }
        int dev = 0, cus = 0, per_cu = 0;
        hipGetDevice(&dev);
        hipDeviceGetAttribute(&cus, hipDeviceAttributeMultiprocessorCount, dev);
        hipFuncSetAttribute((const void*)fwd_megakernel, hipFuncAttributeMaxDynamicSharedMemorySize, LDS_BYTES);
        hipOccupancyMaxActiveBlocksPerMultiprocessor(&per_cu, (const void*)fwd_megakernel, 512, LDS_BYTES);
        if (per_cu < 1) { fprintf(stderr, "kernel_launch: occupancy query says %d blocks per CU\n", per_cu); per_cu = 1; }
        (void)hipGetLastError();
        grid_blocks = cus;
        if (grid_blocks > 256) grid_blocks = 256;
    }
    if (grid_blocks < 0) return;
    Params p{};
    const float** pp = (const float**)&p;
    for (int i = 0; i < 24; ++i) pp[i] = (const float*)d_in[i];
    p.out = (float*)d_out; p.ws = (unsigned char*)d_ws;
    (void)hipMemsetAsync((char*)d_ws + WS_XBAR, 0, 16384, stream);
    void* args[] = {&p};
    hipError_t e = hipLaunchCooperativeKernel((const void*)fwd_megakernel, dim3(grid_blocks), dim3(512), args, LDS_BYTES, stream);
    if (e != hipSuccess) fprintf(stderr, "cooperative launch failed: %s (grid %d)\n", hipGetErrorString(e), grid_blocks);
}
```

```cpp
#include <hip/hip_runtime.h>
#include <hip/hip_cooperative_groups.h>
#include <cstdio>
#include <cstdint>
namespace cg = cooperative_groups;

#define LAS __attribute__((address_space(3)))
typedef unsigned short bf16_t;
typedef short bf16x8 __attribute__((ext_vector_type(8)));
typedef float f32x4 __attribute__((ext_vector_type(4)));
typedef unsigned u32x4 __attribute__((ext_vector_type(4)));
typedef unsigned u32x2 __attribute__((ext_vector_type(2)));

constexpr int M_ = 16384, D_ = 2048, FF_ = 5632, T_ = 4096;
constexpr int NIN1 = 12544, NIN2 = 6144, NADA = 18432;
constexpr float LOG2E = 1.4426950408889634f;
constexpr float QSCALE = 0.08838834764831845f;

constexpr size_t SZ_MD = (size_t)M_ * D_ * 2;
constexpr size_t WS_W13 = 0;
constexpr size_t WS_W2 = WS_W13 + (size_t)11264 * 2048 * 2;
constexpr size_t WS_WIN1 = WS_W2 + (size_t)2048 * 5632 * 2;
constexpr size_t WS_WIN2 = WS_WIN1 + (size_t)NIN1 * 2048 * 2;
constexpr size_t WS_WPAB = WS_WIN2 + (size_t)NIN2 * 2048 * 2;
constexpr size_t WS_WOUT = WS_WPAB + (size_t)2048 * 4096 * 2;
constexpr size_t WS_ADA = WS_WOUT + (size_t)2048 * 2048 * 2;
constexpr size_t WS_BT = WS_ADA + (size_t)4 * NADA * 4;
constexpr size_t WS_KMEAN = WS_BT + (size_t)16 * 4096 * 4;
constexpr size_t WS_U = WS_KMEAN + (size_t)4 * 16 * 16 * 128 * 4;
constexpr size_t WS_BIG = WS_U + SZ_MD;
constexpr size_t WS_QKV = WS_BIG;
constexpr size_t WS_MB = WS_QKV + 3 * SZ_MD;
constexpr size_t WS_BA = WS_MB + 3 * SZ_MD;
constexpr size_t WS_WDN = WS_BA + (size_t)M_ * 32 * 4;
constexpr size_t WS_QK = WS_WDN + SZ_MD;
constexpr size_t WS_XBAR = WS_QK + SZ_MD / 2;
constexpr size_t WS_END = WS_XBAR + 16384;
constexpr size_t WS_ACT = WS_BIG;
constexpr size_t WS_ADAP = WS_BIG;
constexpr size_t WS_HALO = WS_WDN;

constexpr int LDS_BYTES = 147456;

struct Params {
    const float* x; const float* c; const float* ada_w; const float* ada_b; const float* norm1_g;
    const float* f1w1; const float* f1w3; const float* f1w2; const float* norm2_g; const float* w_in;
    const float* conv_w; const float* a_log; const float* dt_bias; const float* dn_norm_g; const float* qn_g; const float* kn_g;
    const float* rel_bias; const float* wpa; const float* wpb; const float* wout; const float* norm3_g;
    const float* f2w1; const float* f2w3; const float* f2w2;
    float* out; unsigned char* ws;
};

typedef float f32x2v __attribute__((ext_vector_type(2)));
typedef __bf16 bf16x2_t __attribute__((ext_vector_type(2)));
__device__ __forceinline__ unsigned cvt_pk_bf16(float lo, float hi) { f32x2v v = {lo, hi}; bf16x2_t r = __builtin_convertvector(v, bf16x2_t); return __builtin_bit_cast(unsigned, r); }
__device__ __forceinline__ bf16_t f2bf(float f) { return (bf16_t)(cvt_pk_bf16(f, 0.f) & 0xffffu); }
__device__ __forceinline__ float bf2f(unsigned b) { return __uint_as_float(b << 16); }
__device__ __forceinline__ float bflo(unsigned w) { return __uint_as_float(w << 16); }
__device__ __forceinline__ float bfhi(unsigned w) { return __uint_as_float(w & 0xffff0000u); }
__device__ __forceinline__ float wave_sum(float v) {
#pragma unroll
    for (int o = 1; o < 64; o <<= 1) v += __shfl_xor(v, o);
    return v;
}
__device__ __forceinline__ float wave_max(float v) {
#pragma unroll
    for (int o = 1; o < 64; o <<= 1) v = fmaxf(v, __shfl_xor(v, o));
    return v;
}
__device__ __forceinline__ float sigmoidf_(float x) { return __builtin_amdgcn_rcpf(1.0f + __builtin_amdgcn_exp2f(-x * LOG2E)); }
__device__ __forceinline__ float siluf_(float x) { return x * sigmoidf_(x); }
#define LDS_WAIT() asm volatile("s_waitcnt lgkmcnt(0)" ::: "memory")
__device__ __forceinline__ int tid_opaque() { int t = threadIdx.x; asm volatile("" : "+v"(t)); return t; }

namespace pg8 {
constexpr int BM = 256, BK = 64, HALF = 128, HTB = HALF * BK * 2, STAGE_BYTES = 8 * HTB, NXCD = 8, WGM = 4;
__host__ __device__ __forceinline__ int lds_byte(int r, int c) { const int st = (r >> 4) * 2 + (c >> 5), rr = r & 15, cc = c & 31, ob = rr * 64 + cc * 2; return st * 1024 + (ob ^ (((ob >> 9) & 1) << 5)); }
__host__ __device__ __forceinline__ void stage_rc(int b, int& R, int& C) { const int st = b / 1024, sb = b % 1024, swz = sb ^ (((sb >> 9) & 1) << 5); R = (st >> 1) * 16 + swz / 64; C = (st & 1) * 32 + (swz % 64) / 2; }
__host__ __device__ __forceinline__ int perm32(int rho) { const int n = rho >> 4, i = rho & 15; return 8 * (i >> 2) + 4 * n + (i & 3); }

struct Unit { int pm, pn; };
struct Gemm { const bf16_t* A; int lda; const bf16_t* Bt; int K; };

struct StaticOrder {
    int nM, nN, nwg, G, c;
    __device__ void init(int nM_, int nN_, int G_, int c_) { nM = nM_; nN = nN_; nwg = nM * nN; G = G_; c = c_; }
    __device__ bool next(int i, Unit& u) const {
        const long L = (long)i * G + c; if (L >= nwg) return false;
        int wgid = (int)L; { const int q = nwg / NXCD, r = nwg % NXCD, xcd = wgid % NXCD, off = wgid / NXCD; wgid = (xcd < r ? xcd * (q + 1) : r * (q + 1) + (xcd - r) * q) + off; }
        const int nig = WGM * nN, gid = wgid / nig, fm = gid * WGM, gsz = (nM - fm) < WGM ? (nM - fm) : WGM;
        u.pm = fm + ((wgid % nig) % gsz); u.pn = (wgid % nig) / gsz; return true;
    }
};

typedef f32x4 Acc[2][2][4][2];

struct EpiSwiglu {
    static constexpr bool PERM = true;
    bf16_t* O;
    __device__ __forceinline__ void operator()(const Acc& acc, const Unit& u, int wr, int wc, int fr, int fq) const {
        const int row0 = u.pm * BM + wr * 64 + fr, col0 = u.pn * 128 + wc * 32 + 8 * fq;
#pragma unroll
        for (int ai = 0; ai < 2; ++ai)
#pragma unroll
            for (int m = 0; m < 4; ++m) {
                bf16_t* rowp = O + (size_t)(row0 + ai * HALF + m * 16) * FF_ + col0;
                float v[8];
#pragma unroll
                for (int n = 0; n < 2; ++n)
#pragma unroll
                    for (int j = 0; j < 4; ++j) v[n * 4 + j] = siluf_(acc[ai][0][m][n][j]) * acc[ai][1][m][n][j];
                u32x4 w; w.x = cvt_pk_bf16(v[0], v[1]); w.y = cvt_pk_bf16(v[2], v[3]); w.z = cvt_pk_bf16(v[4], v[5]); w.w = cvt_pk_bf16(v[6], v[7]);
                *(u32x4*)rowp = w;
            }
    }
};
struct EpiResid {
    static constexpr bool PERM = false;
    const float* resid; float* out; const float* gada; float scale;
    __device__ __forceinline__ void operator()(const Acc& acc, const Unit& u, int wr, int wc, int fr, int fq) const {
        const int row0 = u.pm * BM + wr * 64 + fr, col0 = u.pn * BM + wc * 32 + 4 * fq;
        const float* g = gada + (size_t)(u.pm >> 4) * NADA;
        f32x4 gv[2][2];
#pragma unroll
        for (int bj = 0; bj < 2; ++bj)
#pragma unroll
            for (int n = 0; n < 2; ++n) gv[bj][n] = *(const f32x4*)(g + col0 + bj * HALF + n * 16) * scale;
#pragma unroll
        for (int ai = 0; ai < 2; ++ai) {
            f32x4 rr[4][2][2];
#pragma unroll
            for (int m = 0; m < 4; ++m)
#pragma unroll
                for (int bj = 0; bj < 2; ++bj)
#pragma unroll
                    for (int n = 0; n < 2; ++n) rr[m][bj][n] = *(const f32x4*)(resid + (size_t)(row0 + ai * HALF + m * 16) * D_ + col0 + bj * HALF + n * 16);
#pragma unroll
            for (int m = 0; m < 4; ++m)
#pragma unroll
                for (int bj = 0; bj < 2; ++bj)
#pragma unroll
                    for (int n = 0; n < 2; ++n) *(f32x4*)(out + (size_t)(row0 + ai * HALF + m * 16) * D_ + col0 + bj * HALF + n * 16) = rr[m][bj][n] + gv[bj][n] * acc[ai][bj][m][n];
        }
    }
};
__device__ __forceinline__ void store_bf16_tile(const Acc& acc, bf16_t* base, int ldc, int row0, int col0) {
#pragma unroll
    for (int ai = 0; ai < 2; ++ai)
#pragma unroll
        for (int m = 0; m < 4; ++m) {
            bf16_t* rowp = base + (size_t)(row0 + ai * HALF + m * 16) * ldc + col0;
#pragma unroll
            for (int bj = 0; bj < 2; ++bj) {
                const f32x4 v0 = acc[ai][bj][m][0], v1 = acc[ai][bj][m][1];
                u32x4 w; w.x = cvt_pk_bf16(v0[0], v0[1]); w.y = cvt_pk_bf16(v0[2], v0[3]); w.z = cvt_pk_bf16(v1[0], v1[1]); w.w = cvt_pk_bf16(v1[2], v1[3]);
                *(u32x4*)(rowp + bj * HALF) = w;
            }
        }
}
struct EpiIn1 {
    static constexpr bool PERM = true;
    bf16_t* QKV; bf16_t* MB; float* BA;
    __device__ __forceinline__ void operator()(const Acc& acc, const Unit& u, int wr, int wc, int fr, int fq) const {
        const int row0 = u.pm * BM + wr * 64 + fr, pn = u.pn;
        if (pn < 48) {
            bf16_t* base; int ldc, colt;
            if (pn < 24) { base = QKV; ldc = 6144; colt = pn * 256; }
            else { const int t = (pn - 24) >> 3; base = MB + (size_t)t * M_ * D_; ldc = 2048; colt = ((pn - 24) & 7) * 256; }
            store_bf16_tile(acc, base, ldc, row0, colt + wc * 32 + 8 * fq);
        } else if (wc == 0) {
#pragma unroll
            for (int ai = 0; ai < 2; ++ai)
#pragma unroll
                for (int m = 0; m < 4; ++m) { float* pp = BA + (size_t)(row0 + ai * HALF + m * 16) * 32 + 8 * fq; *(f32x4*)pp = acc[ai][0][m][0]; *(f32x4*)(pp + 4) = acc[ai][0][m][1]; }
        }
    }
};
struct EpiIn2 {
    static constexpr bool PERM = true;
    bf16_t* QKV; bf16_t* MBK;
    __device__ __forceinline__ void operator()(const Acc& acc, const Unit& u, int wr, int wc, int fr, int fq) const {
        const int row0 = u.pm * BM + wr * 64 + fr, pn = u.pn;
        bf16_t* base; int ldc, colt;
        if (pn < 16) { base = QKV; ldc = 6144; colt = pn * 256; }
        else { base = MBK; ldc = 2048; colt = (pn - 16) * 256; }
        store_bf16_tile(acc, base, ldc, row0, colt + wc * 32 + 8 * fq);
    }
};
struct EpiProjA {
    static constexpr bool PERM = true;
    const bf16_t* GA; int ldga; bf16_t* Tm;
    __device__ __forceinline__ void operator()(const Acc& acc, const Unit& u, int wr, int wc, int fr, int fq) const {
        const int row0 = u.pm * BM + wr * 64 + fr, col0 = u.pn * BM + wc * 32 + 8 * fq;
#pragma unroll
        for (int ai = 0; ai < 2; ++ai) {
            u32x4 ga[4][2];
#pragma unroll
            for (int m = 0; m < 4; ++m)
#pragma unroll
                for (int bj = 0; bj < 2; ++bj) ga[m][bj] = *(const u32x4*)(GA + (size_t)(row0 + ai * HALF + m * 16) * ldga + col0 + bj * HALF);
#pragma unroll
            for (int m = 0; m < 4; ++m)
#pragma unroll
                for (int bj = 0; bj < 2; ++bj) {
                    u32x4 w;
#pragma unroll
                    for (int e = 0; e < 4; ++e) {
                        const float s0 = sigmoidf_(bflo(ga[m][bj][e])), s1 = sigmoidf_(bfhi(ga[m][bj][e]));
                        w[e] = cvt_pk_bf16(acc[ai][bj][m][e >> 1][(e & 1) * 2] * s0, acc[ai][bj][m][e >> 1][(e & 1) * 2 + 1] * s1);
                    }
                    *(u32x4*)(Tm + (size_t)(row0 + ai * HALF + m * 16) * D_ + col0 + bj * HALF) = w;
                }
        }
    }
};
struct EpiProjB {
    static constexpr bool PERM = true;
    const bf16_t* GB; int ldgb; const bf16_t* Tm; bf16_t* O;
    __device__ __forceinline__ void operator()(const Acc& acc, const Unit& u, int wr, int wc, int fr, int fq) const {
        const int row0 = u.pm * BM + wr * 64 + fr, col0 = u.pn * BM + wc * 32 + 8 * fq;
#pragma unroll
        for (int ai = 0; ai < 2; ++ai) {
            u32x4 gb[4][2], tv[4][2];
#pragma unroll
            for (int m = 0; m < 4; ++m)
#pragma unroll
                for (int bj = 0; bj < 2; ++bj) { const size_t row = (size_t)(row0 + ai * HALF + m * 16);
                    gb[m][bj] = *(const u32x4*)(GB + row * ldgb + col0 + bj * HALF); tv[m][bj] = *(const u32x4*)(Tm + row * D_ + col0 + bj * HALF); }
#pragma unroll
            for (int m = 0; m < 4; ++m)
#pragma unroll
                for (int bj = 0; bj < 2; ++bj) {
                    u32x4 w;
#pragma unroll
                    for (int e = 0; e < 4; ++e) {
                        const float s0 = sigmoidf_(bflo(gb[m][bj][e])), s1 = sigmoidf_(bfhi(gb[m][bj][e]));
                        w[e] = cvt_pk_bf16(bflo(tv[m][bj][e]) + acc[ai][bj][m][e >> 1][(e & 1) * 2] * s0, bfhi(tv[m][bj][e]) + acc[ai][bj][m][e >> 1][(e & 1) * 2 + 1] * s1);
                    }
                    *(u32x4*)(O + (size_t)(row0 + ai * HALF + m * 16) * D_ + col0 + bj * HALF) = w;
                }
        }
    }
};

template <class Epi>
__device__ __forceinline__ void gemm_phase(LAS unsigned char* lds, const Gemm g, const StaticOrder& S, const Epi& E) {
    const int tid = tid_opaque(), wid = __builtin_amdgcn_readfirstlane(tid >> 6), lane = tid & 63, wr = wid >> 2, wc = wid & 3, fr = lane & 15, fq = lane >> 4;
    const int K = g.K, nt = K / BK;
    unsigned voffA[2], voffB[2];
#pragma unroll
    for (int i = 0; i < 2; ++i) { int R, C; stage_rc(tid * 16 + i * 8192, R, C); const int Rb = Epi::PERM ? ((R & ~31) + perm32(R & 31)) : R;
        voffA[i] = (unsigned)(R * g.lda + C) * 2u; voffB[i] = (unsigned)(Rb * K + C) * 2u; }
    const size_t kstep = (size_t)(BK * 2);
    const size_t hstepA = (size_t)HALF * g.lda * 2, hstepB = (size_t)HALF * K * 2;
    const unsigned ldsw = (unsigned)wid * 1024u;
    const int aoff = lds_byte(wr * 64 + fr, fq * 8), boff = lds_byte(wc * 32 + fr, fq * 8);
#define PG8_SA(b, h) (((b) * 2 + (h)) * HTB)
#define PG8_SB(b, h) ((4 + (b) * 2 + (h)) * HTB)
#define PG8_STAGE_B(bufoff, gbase) do { _Pragma("unroll") for (int _i = 0; _i < 2; ++_i) \
        __builtin_amdgcn_global_load_lds((const unsigned*)((const char*)(gbase) + voffB[_i]), (LAS unsigned*)(lds + (bufoff) + ldsw + _i * 8192), 16, 0, 0); } while (0)
#define PG8_STAGE_A(bufoff, gbase, second) do { _Pragma("unroll") for (int _i = 0; _i < 2; ++_i) \
        __builtin_amdgcn_global_load_lds((const unsigned*)((const char*)(gbase) + voffA[_i]), (LAS unsigned*)(lds + (bufoff) + ldsw + _i * 8192), 16, 0, 0); } while (0)
#define PG8_LDA(dst, b, h) do { _Pragma("unroll") for (int m = 0; m < 4; ++m) _Pragma("unroll") for (int k = 0; k < 2; ++k) dst[m][k] = *(const LAS bf16x8*)(lds + PG8_SA(b, h) + aoff + m * 2048 + k * 1024); } while (0)
#define PG8_LDB(dst, b, h) do { _Pragma("unroll") for (int n = 0; n < 2; ++n) _Pragma("unroll") for (int k = 0; k < 2; ++k) dst[n][k] = *(const LAS bf16x8*)(lds + PG8_SB(b, h) + boff + n * 2048 + k * 1024); } while (0)
#define PG8_MMA(ai, bj, At, Bt) do { __builtin_amdgcn_s_setprio(1); _Pragma("unroll") for (int m = 0; m < 4; ++m) _Pragma("unroll") for (int n = 0; n < 2; ++n) _Pragma("unroll") for (int k = 0; k < 2; ++k) \
        acc[ai][bj][m][n] = __builtin_amdgcn_mfma_f32_16x16x32_bf16(Bt[n][k], At[m][k], acc[ai][bj][m][n], 0, 0, 0); __builtin_amdgcn_s_setprio(0); } while (0)
#define PG8_WAIT_V(n) asm volatile("s_waitcnt vmcnt(" #n ")" ::: "memory")
#define PG8_WAIT_L(n) asm volatile("s_waitcnt lgkmcnt(" #n ")" ::: "memory")
#define PG8_BAR __builtin_amdgcn_s_barrier()
#define PG8_SCHED __builtin_amdgcn_sched_barrier(0)
    Unit cur, nxt; int ui = 0;
    if (!S.next(0, cur)) return;
    Acc acc;
#pragma unroll
    for (int a = 0; a < 2; ++a)
#pragma unroll
        for (int b = 0; b < 2; ++b)
#pragma unroll
            for (int m = 0; m < 4; ++m)
#pragma unroll
                for (int n = 0; n < 2; ++n) acc[a][b][m][n] = (f32x4){0.f, 0.f, 0.f, 0.f};
    bf16x8 At[4][2], B0[2][2], B1[2][2];
    const char* cA = (const char*)g.A + (size_t)cur.pm * 2 * hstepA; const char* cB = (const char*)g.Bt + (size_t)cur.pn * 2 * hstepB;
    PG8_STAGE_B(PG8_SB(0, 0), cB); PG8_STAGE_B(PG8_SB(0, 1), cB + hstepB); PG8_STAGE_A(PG8_SA(0, 0), cA, false); PG8_STAGE_A(PG8_SA(0, 1), cA + hstepA, false);
    if (wr == 1) PG8_BAR;
    PG8_WAIT_V(2); PG8_BAR;
    PG8_STAGE_B(PG8_SB(1, 0), cB + kstep); PG8_STAGE_A(PG8_SA(1, 0), cA + kstep, false); PG8_STAGE_B(PG8_SB(1, 1), cB + hstepB + kstep);
    PG8_WAIT_V(6); PG8_BAR;
    for (;;) {
        const bool has_next = S.next(ui + 1, nxt);
        const char* nA = has_next ? (const char*)g.A + (size_t)nxt.pm * 2 * hstepA : cA; const char* nB = has_next ? (const char*)g.Bt + (size_t)nxt.pn * 2 * hstepB : cB;
        for (int t = 0; t < nt; t += 2) {
            const bool last = (t == nt - 2);
            const char* a1 = cA + (size_t)(t + 1) * kstep;
            const char* a2 = last ? nA : cA + (size_t)(t + 2) * kstep; const char* a3 = a2 + kstep;
            const size_t h1 = hstepA, h2 = hstepA;
            const char* b2 = last ? nB : cB + (size_t)(t + 2) * kstep; const char* b3 = b2 + kstep;
            PG8_LDB(B0, 0, 0); PG8_LDB(B1, 0, 1); PG8_SCHED; PG8_LDA(At, 0, 0); PG8_STAGE_A(PG8_SA(1, 1), a1 + h1, false);
            PG8_WAIT_V(8); PG8_WAIT_L(0); PG8_BAR; PG8_MMA(0, 0, At, B0); PG8_MMA(0, 1, At, B1); PG8_BAR; PG8_SCHED;
            PG8_LDA(At, 0, 1); PG8_STAGE_B(PG8_SB(0, 0), b2); PG8_STAGE_B(PG8_SB(0, 1), b2 + hstepB); PG8_STAGE_A(PG8_SA(0, 0), a2, false);
            PG8_WAIT_V(8); PG8_WAIT_L(0); PG8_BAR; PG8_MMA(1, 0, At, B0); PG8_MMA(1, 1, At, B1); PG8_BAR; PG8_SCHED;
            PG8_LDB(B0, 1, 0); PG8_LDB(B1, 1, 1); PG8_SCHED; PG8_LDA(At, 1, 0); PG8_STAGE_A(PG8_SA(0, 1), a2 + h2, false);
            PG8_WAIT_V(8); PG8_WAIT_L(0); PG8_BAR; PG8_MMA(0, 0, At, B0); PG8_MMA(0, 1, At, B1); PG8_BAR; PG8_SCHED;
            PG8_LDA(At, 1, 1); PG8_STAGE_B(PG8_SB(1, 0), b3); PG8_STAGE_B(PG8_SB(1, 1), b3 + hstepB); PG8_STAGE_A(PG8_SA(1, 0), a3, false);
            PG8_WAIT_V(8); PG8_WAIT_L(0); PG8_BAR; PG8_MMA(1, 0, At, B0); PG8_MMA(1, 1, At, B1); PG8_BAR; PG8_SCHED;
        }
        if (wr == 0) PG8_BAR;
        E(acc, cur, wr, wc, fr, fq);
        if (!has_next) break;
#pragma unroll
        for (int a = 0; a < 2; ++a)
#pragma unroll
            for (int b = 0; b < 2; ++b)
#pragma unroll
                for (int m = 0; m < 4; ++m)
#pragma unroll
                    for (int n = 0; n < 2; ++n) acc[a][b][m][n] = (f32x4){0.f, 0.f, 0.f, 0.f};
        cur = nxt; cA = nA; cB = nB; ++ui;
        if (wr == 1) PG8_BAR;
    }
    PG8_WAIT_V(0);
    PG8_BAR;
#undef PG8_SA
#undef PG8_SB
#undef PG8_STAGE_A
#undef PG8_STAGE_B
#undef PG8_LDA
#undef PG8_LDB
#undef PG8_MMA
#undef PG8_WAIT_V
#undef PG8_WAIT_L
#undef PG8_BAR
#undef PG8_SCHED
}
}

__device__ __forceinline__ void tr_item(const float* __restrict__ W, int N, int k0, int n0, bf16_t* dst, int ldd, LAS float* scr, int lane) {
    { float wv[32];
#pragma unroll
      for (int i = 0; i < 32; ++i) wv[i] = W[(size_t)(k0 + 2 * i + (lane >> 5)) * N + n0 + (lane & 31)];
      __builtin_amdgcn_sched_barrier(0);
#pragma unroll
      for (int i = 0; i < 32; ++i) scr[(2 * i + (lane >> 5)) * 33 + (lane & 31)] = wv[i]; }
    LDS_WAIT();
    const int c = lane & 7;
#pragma unroll
    for (int j = 0; j < 4; ++j) { const int n = (lane >> 3) + 8 * j; const LAS float* s = scr + (8 * c) * 33 + n;
        u32x4 o; o.x = cvt_pk_bf16(s[0 * 33], s[1 * 33]); o.y = cvt_pk_bf16(s[2 * 33], s[3 * 33]); o.z = cvt_pk_bf16(s[4 * 33], s[5 * 33]); o.w = cvt_pk_bf16(s[6 * 33], s[7 * 33]);
        *(u32x4*)(dst + (size_t)n * ldd + 8 * c) = o; }
    LDS_WAIT();
}
__device__ __forceinline__ void convert_ffn(const float* w1, const float* w3, const float* w2, bf16_t* W13, bf16_t* W2, LAS float* scr, int gw, int NGW, int lane) {
    constexpr int I_UP = 32 * 176, I_DN = 88 * 64;
    for (int it = gw; it < 2 * I_UP + I_DN; it += NGW) {
        int r = it;
        if (r < 2 * I_UP) { const int which = r >= I_UP; if (which) r -= I_UP; const int kb = r / 176, nb = r % 176, n0 = nb * 32;
            tr_item(which ? w3 : w1, FF_, kb * 64, n0, W13 + (size_t)((n0 >> 7) * 256 + which * 128 + (n0 & 127)) * 2048 + kb * 64, 2048, scr, lane); }
        else { r -= 2 * I_UP; const int kb = r / 64, nb = r % 64; tr_item(w2, D_, kb * 64, nb * 32, W2 + (size_t)(nb * 32) * FF_ + kb * 64, FF_, scr, lane); }
    }
}
__device__ __forceinline__ void convert_mixer(const Params& p, LAS float* scr, int gw, int NGW, int lane) {
    bf16_t* WIN1 = (bf16_t*)(p.ws + WS_WIN1); bf16_t* WIN2 = (bf16_t*)(p.ws + WS_WIN2); bf16_t* WPAB = (bf16_t*)(p.ws + WS_WPAB); bf16_t* WOUT = (bf16_t*)(p.ws + WS_WOUT);
    constexpr int I_IN = 32 * 577, I_P = 32 * 64;
    for (int it = gw; it < I_IN + 3 * I_P; it += NGW) {
        int r = it;
        if (r < I_IN) { const int kb = r / 577, nb = r % 577, n0 = nb * 32; bf16_t* dst; int drow;
            if (n0 < 6144) { dst = WIN1; drow = n0; }
            else if (n0 < 8192) { dst = WIN2; drow = n0 - 6144; }
            else if (n0 < 8224) { dst = WIN1; drow = 12288 + (n0 - 8192); }
            else if (n0 < 10272) { dst = WIN1; drow = 6144 + (n0 - 8224); }
            else if (n0 < 12320) { dst = WIN1; drow = 8192 + (n0 - 10272); }
            else if (n0 < 14368) { dst = WIN1; drow = 10240 + (n0 - 12320); }
            else if (n0 < 16416) { dst = WIN2; drow = 2048 + (n0 - 14368); }
            else { dst = WIN2; drow = 4096 + (n0 - 16416); }
            tr_item(p.w_in, 18464, kb * 64, n0, dst + (size_t)drow * 2048 + kb * 64, 2048, scr, lane); continue; }
        r -= I_IN;
        const int which = r / I_P; r -= which * I_P; const int kb = r / 64, nb = r % 64;
        if (which == 0) tr_item(p.wpa, D_, kb * 64, nb * 32, WPAB + (size_t)(nb * 32) * 2048 + kb * 64, 2048, scr, lane);
        else if (which == 1) tr_item(p.wpb, D_, kb * 64, nb * 32, WPAB + (size_t)2048 * 2048 + (size_t)(nb * 32) * 2048 + kb * 64, 2048, scr, lane);
        else tr_item(p.wout, D_, kb * 64, nb * 32, WOUT + (size_t)(nb * 32) * 2048 + kb * 64, 2048, scr, lane);
    }
}

__device__ __forceinline__ void phase0(const Params& p, LAS unsigned char* lds) {
    const int tid = tid_opaque(), lane = tid & 63, wave = tid >> 6;
    const int gw = blockIdx.x * 8 + wave, NGW = gridDim.x * 8;
    const int gt = blockIdx.x * 512 + tid, NGT = gridDim.x * 512;
    {
        LAS float* sil = (LAS float*)lds;
        float* ADAP = (float*)(p.ws + WS_ADAP);
        for (int item = blockIdx.x; item < 9 * 32; item += gridDim.x) {
            const int cb = item % 9, ks = item / 9;
            if (tid < 256) { const int b = tid >> 6, kk = tid & 63; sil[tid] = siluf_(p.c[b * D_ + ks * 64 + kk]); }
            __syncthreads();
            const int col = cb * 2048 + tid * 4;
            f32x4 a0 = {0, 0, 0, 0}, a1 = a0, a2 = a0, a3 = a0;
#pragma unroll 1
            for (int kq = 0; kq < 4; ++kq) {
                f32x4 w[16];
#pragma unroll
                for (int kk = 0; kk < 16; ++kk) w[kk] = *(const f32x4*)(p.ada_w + (size_t)(ks * 64 + kq * 16 + kk) * NADA + col);
                __builtin_amdgcn_sched_barrier(0);
#pragma unroll
                for (int kk = 0; kk < 16; ++kk) { const int k2 = kq * 16 + kk; a0 += sil[k2] * w[kk]; a1 += sil[64 + k2] * w[kk]; a2 += sil[128 + k2] * w[kk]; a3 += sil[192 + k2] * w[kk]; }
            }
            *(f32x4*)(ADAP + (size_t)(ks * 4 + 0) * NADA + col) = a0; *(f32x4*)(ADAP + (size_t)(ks * 4 + 1) * NADA + col) = a1;
            *(f32x4*)(ADAP + (size_t)(ks * 4 + 2) * NADA + col) = a2; *(f32x4*)(ADAP + (size_t)(ks * 4 + 3) * NADA + col) = a3;
            __syncthreads();
        }
    }
    LAS float* scr = (LAS float*)(lds + wave * 8448);
    convert_ffn(p.f1w1, p.f1w3, p.f1w2, (bf16_t*)(p.ws + WS_W13), (bf16_t*)(p.ws + WS_W2), scr, gw, NGW, lane);
    convert_mixer(p, scr, gw, NGW, lane);
    { u32x4* z = (u32x4*)(p.ws + WS_WIN1 + (size_t)12320 * 2048 * 2); for (int i = gt; i < 224 * 2048 * 2 / 16; i += NGT) z[i] = (u32x4){0u, 0u, 0u, 0u}; }
    { float* BT = (float*)(p.ws + WS_BT);
      for (int i = gt; i < 16 * 4096; i += NGT) { const int h = i >> 12, d = i & 4095; int bucket;
          if (d < 16) bucket = d; else { const double dd = (double)d, d2 = dd * dd, d4 = d2 * d2, d8 = d4 * d4; int k = 0; double thr = 34359738368.0  ;
              for (int q = 1; q <= 15; ++q) { if (d8 >= thr) k = q; thr *= 8.0; } bucket = 16 + k; if (bucket > 31) bucket = 31; }
          BT[i] = p.rel_bias[bucket * 16 + h] * LOG2E; } }
}
__device__ __forceinline__ void phase_ada_reduce(const Params& p) {
    const int gt = blockIdx.x * 512 + tid_opaque(), NGT = gridDim.x * 512;
    const float* ADAP = (const float*)(p.ws + WS_ADAP); float* ada = (float*)(p.ws + WS_ADA);
    for (int i = gt; i < 4 * NADA; i += NGT) { const int b = i / NADA, n = i - b * NADA; float s = p.ada_b[n];
        for (int ks = 0; ks < 32; ++ks) s += ADAP[(size_t)(ks * 4 + b) * NADA + n];
        ada[i] = s; }
}
__device__ __forceinline__ void phase_normmod(const float* src, const float* gain, const float* ada, int shoff, int scoff, bf16_t* dst) {
    const int tid_ = tid_opaque(); const int lane = tid_ & 63, wave = tid_ >> 6;
    const int gw = blockIdx.x * 8 + wave, NGW = gridDim.x * 8;
    f32x4 g[8];
#pragma unroll
    for (int j = 0; j < 8; ++j) g[j] = *(const f32x4*)(gain + 4 * (lane + 64 * j));
    f32x4 v[8];
    if (gw < M_) {
#pragma unroll
        for (int j = 0; j < 8; ++j) v[j] = ((const f32x4*)(src + (size_t)gw * D_) + lane)[64 * j];
    }
    for (int m = gw; m < M_; m += NGW) {
        const int mn = (m + NGW < M_) ? m + NGW : m;
        const float* ab = ada + (size_t)(m >> 12) * NADA;
        f32x4 vn[8], sh[8], sc[8];
#pragma unroll
        for (int j = 0; j < 8; ++j) { const int col = 4 * (lane + 64 * j); sh[j] = *(const f32x4*)(ab + shoff + col); sc[j] = *(const f32x4*)(ab + scoff + col); vn[j] = ((const f32x4*)(src + (size_t)mn * D_) + lane)[64 * j]; }
        __builtin_amdgcn_sched_barrier(0);
        float ss = 0.f;
#pragma unroll
        for (int j = 0; j < 8; ++j) ss += (v[j][0] * v[j][0] + v[j][1] * v[j][1]) + (v[j][2] * v[j][2] + v[j][3] * v[j][3]);
        ss = wave_sum(ss);
        const float rstd = rsqrtf(ss * (1.0f / D_) + 1e-6f);
#pragma unroll
        for (int j = 0; j < 8; ++j) { const int col = 4 * (lane + 64 * j);
            const f32x4 y = v[j] * rstd * g[j] * (sc[j] + 1.0f) + sh[j];
            u32x2 w; w.x = cvt_pk_bf16(y[0], y[1]); w.y = cvt_pk_bf16(y[2], y[3]);
            *(u32x2*)(dst + (size_t)m * D_ + col) = w; }
#pragma unroll
        for (int j = 0; j < 8; ++j) v[j] = vn[j];
    }
}
__device__ __forceinline__ void phase_halo(const Params& p) {
    const int tid_ = tid_opaque(); const int lane = tid_ & 63, wave = tid_ >> 6;
    const int gw = blockIdx.x * 8 + wave, NGW = gridDim.x * 8;
    const bf16_t* QKV = (const bf16_t*)(p.ws + WS_QKV); bf16_t* HALO = (bf16_t*)(p.ws + WS_HALO);
    for (int r = gw; r < 4 * 16 * 3; r += NGW) {
        const int j = r % 3, tile = (r / 3) & 15, b = r / 48;
        u32x4* d = (u32x4*)(HALO + (size_t)r * 6144);
        if (tile == 0) { for (int i = lane; i < 768; i += 64) d[i] = (u32x4){0u, 0u, 0u, 0u}; }
        else { const u32x4* s = (const u32x4*)(QKV + ((size_t)b * T_ + tile * 256 - 3 + j) * 6144); u32x4 t12[12];
#pragma unroll
            for (int i = 0; i < 12; ++i) t12[i] = s[lane + 64 * i];
#pragma unroll
            for (int i = 0; i < 12; ++i) d[lane + 64 * i] = t12[i]; }
    }
}
__device__ __forceinline__ void unpack8(const u32x4 w, float* f) {
#pragma unroll
    for (int e = 0; e < 4; ++e) { f[2 * e] = bflo(w[e]); f[2 * e + 1] = bfhi(w[e]); }
}
__device__ __forceinline__ void phase_postproc(const Params& p, LAS unsigned char* lds) {
    const int tid = tid_opaque(), ti = tid >> 3, cg8 = tid & 7, lane = tid & 63, wave = tid >> 6;
    bf16_t* QKV = (bf16_t*)(p.ws + WS_QKV); const bf16_t* HALO = (const bf16_t*)(p.ws + WS_HALO); bf16_t* MB = (bf16_t*)(p.ws + WS_MB); float* BA = (float*)(p.ws + WS_BA);
    float* KM = (float*)(p.ws + WS_KMEAN);
    for (int item = blockIdx.x; item < 4 * 16 * 48; item += gridDim.x) {
        const int s = item % 48, tile = (item / 48) & 15, b = item / 768;
        const int c0 = s * 128 + cg8 * 16; const size_t row0 = (size_t)b * T_ + tile * 256 + ti * 4;
        u32x4 xr[7][2];
#pragma unroll
        for (int j = 0; j < 7; ++j) {
            const bf16_t* src = (ti > 0 || j >= 3) ? QKV + (row0 - 3 + j) * 6144 + c0 : HALO + ((size_t)((b * 16 + tile) * 3) + j) * 6144 + c0;
            xr[j][0] = *(const u32x4*)src; xr[j][1] = *(const u32x4*)(src + 8);
        }
        f32x4 w[4][4];
#pragma unroll
        for (int j = 0; j < 4; ++j)
#pragma unroll
            for (int q = 0; q < 4; ++q) w[j][q] = *(const f32x4*)(p.conv_w + j * 6144 + c0 + 4 * q);
        u32x4 o[4][2];
#pragma unroll
        for (int r = 0; r < 4; ++r) {
            float y[16];
#pragma unroll
            for (int i = 0; i < 16; ++i) y[i] = 0.f;
#pragma unroll
            for (int j = 0; j < 4; ++j) { float xf[16]; unpack8(xr[r + j][0], xf); unpack8(xr[r + j][1], xf + 8);
#pragma unroll
                for (int q = 0; q < 4; ++q)
#pragma unroll
                    for (int e = 0; e < 4; ++e) y[4 * q + e] += w[j][q][e] * xf[4 * q + e]; }
            float ss = 0.f;
#pragma unroll
            for (int i = 0; i < 16; ++i) { y[i] = siluf_(y[i]); ss += y[i] * y[i]; }
            ss += __shfl_xor(ss, 1); ss += __shfl_xor(ss, 2); ss += __shfl_xor(ss, 4);
            float sc = 1.0f;
            if (s < 32) { sc = rsqrtf(ss + 1e-6f); if (s < 16) sc *= QSCALE; }
#pragma unroll
            for (int e = 0; e < 4; ++e) { o[r][0][e] = cvt_pk_bf16(y[2 * e] * sc, y[2 * e + 1] * sc); o[r][1][e] = cvt_pk_bf16(y[8 + 2 * e] * sc, y[8 + 2 * e + 1] * sc); }
        }
        __syncthreads();
#pragma unroll
        for (int r = 0; r < 4; ++r) { bf16_t* dp = QKV + (row0 + r) * 6144 + c0; *(u32x4*)dp = o[r][0]; *(u32x4*)(dp + 8) = o[r][1]; }
    }
    LAS float* red = (LAS float*)lds;
    for (int item = blockIdx.x; item < 4 * 16 * 32; item += gridDim.x) {
        const int hh = item & 31, tile = (item >> 5) & 15, b = item >> 9; const int which = hh >> 4, h = hh & 15;
        bf16_t* dp = MB + (size_t)which * M_ * D_ + ((size_t)b * T_ + tile * 256 + ti * 4) * D_ + h * 128 + cg8 * 16;
        u32x4 xr[4][2];
#pragma unroll
        for (int r = 0; r < 4; ++r) { xr[r][0] = *(const u32x4*)(dp + (size_t)r * D_); xr[r][1] = *(const u32x4*)(dp + (size_t)r * D_ + 8); }
        const float* gp = (which == 0 ? p.qn_g : p.kn_g) + cg8 * 16;
        float gn[16];
#pragma unroll
        for (int i = 0; i < 16; ++i) gn[i] = gp[i] * (which == 0 ? QSCALE * LOG2E : 1.0f);
        float ks[16];
#pragma unroll
        for (int i = 0; i < 16; ++i) ks[i] = 0.f;
#pragma unroll
        for (int r = 0; r < 4; ++r) {
            float xf[16]; unpack8(xr[r][0], xf); unpack8(xr[r][1], xf + 8);
            float ss = 0.f;
#pragma unroll
            for (int i = 0; i < 16; ++i) ss += xf[i] * xf[i];
            ss += __shfl_xor(ss, 1); ss += __shfl_xor(ss, 2); ss += __shfl_xor(ss, 4);
            const float rs = rsqrtf(ss * (1.0f / 128.0f) + 1e-6f);
            u32x4 o0, o1;
#pragma unroll
            for (int i = 0; i < 16; ++i) { xf[i] = xf[i] * rs * gn[i]; ks[i] += xf[i]; }
#pragma unroll
            for (int e = 0; e < 4; ++e) { o0[e] = cvt_pk_bf16(xf[2 * e], xf[2 * e + 1]); o1[e] = cvt_pk_bf16(xf[8 + 2 * e], xf[8 + 2 * e + 1]); }
            *(u32x4*)(dp + (size_t)r * D_) = o0; *(u32x4*)(dp + (size_t)r * D_ + 8) = o1;
        }
        if (which == 1) {
#pragma unroll
            for (int i = 0; i < 16; ++i) { float v = ks[i]; v += __shfl_xor(v, 8); v += __shfl_xor(v, 16); v += __shfl_xor(v, 32); ks[i] = v; }
            if (lane < 8) {
#pragma unroll
                for (int i = 0; i < 16; ++i) red[wave * 128 + lane * 16 + i] = ks[i]; }
            __syncthreads();
            if (tid < 128) { float t = 0.f;
#pragma unroll
                for (int w8 = 0; w8 < 8; ++w8) t += red[w8 * 128 + tid];
                KM[((size_t)((b * 16 + h) * 16 + tile)) * 128 + tid] = t * (1.0f / 256.0f); }
            __syncthreads();
        }
    }
    {
        const int gt = blockIdx.x * 512 + tid, NGT = gridDim.x * 512;
        for (int i = gt; i < M_ * 16; i += NGT) { const int h = i & 15; const size_t r = (size_t)(i >> 4) * 32;
            const float bv = BA[r + h], av = BA[r + 16 + h] + p.dt_bias[h];
            const float sp = fmaxf(av, 0.f) + log1pf(expf(-fabsf(av)));
            BA[r + h] = 1.0f / (1.0f + expf(-bv)); BA[r + 16 + h] = -expf(p.a_log[h]) * sp; }
    }
}

typedef float f32x16 __attribute__((ext_vector_type(16)));
__device__ __forceinline__ unsigned pkbf(float a, float b) { return cvt_pk_bf16(a, b); }
#define MFMA32(a, b, c) __builtin_amdgcn_mfma_f32_32x32x16_bf16((a), (b), (c), 0, 0, 0)
template <int OFF, int ROWQ, int COLT> __device__ __forceinline__ void tr8(unsigned addr, u32x2 (&v)[8]) {
    asm volatile(
        "ds_read_b64_tr_b16 %0, %8 offset:%9\n\t"
        "ds_read_b64_tr_b16 %1, %8 offset:%10\n\t"
        "ds_read_b64_tr_b16 %2, %8 offset:%11\n\t"
        "ds_read_b64_tr_b16 %3, %8 offset:%12\n\t"
        "ds_read_b64_tr_b16 %4, %8 offset:%13\n\t"
        "ds_read_b64_tr_b16 %5, %8 offset:%14\n\t"
        "ds_read_b64_tr_b16 %6, %8 offset:%15\n\t"
        "ds_read_b64_tr_b16 %7, %8 offset:%16\n\t"
        "s_waitcnt lgkmcnt(0)"
        : "=&v"(v[0]), "=&v"(v[1]), "=&v"(v[2]), "=&v"(v[3]), "=&v"(v[4]), "=&v"(v[5]), "=&v"(v[6]), "=&v"(v[7])
        : "v"(addr), "n"(OFF), "n"(OFF + ROWQ), "n"(OFF + COLT), "n"(OFF + COLT + ROWQ), "n"(OFF + 2 * COLT), "n"(OFF + 2 * COLT + ROWQ), "n"(OFF + 3 * COLT), "n"(OFF + 3 * COLT + ROWQ)
        : "memory");
}
__device__ __forceinline__ bf16x8 frag2(const u32x2 a, const u32x2 b) { u32x4 w = {a.x, a.y, b.x, b.y}; return __builtin_bit_cast(bf16x8, w); }
__device__ __forceinline__ bf16x8 pack8(const f32x16& x, int s) {
    u32x4 w = {pkbf(x[8 * s], x[8 * s + 1]), pkbf(x[8 * s + 2], x[8 * s + 3]), pkbf(x[8 * s + 4], x[8 * s + 5]), pkbf(x[8 * s + 6], x[8 * s + 7])};
    return __builtin_bit_cast(bf16x8, w);
}

__device__ __forceinline__ void phase_moba_mfma(const Params& p, LAS unsigned char* lds, unsigned lds_base) {
    constexpr int KST = 272, VST = 320;
    constexpr int OFF_K = 0, OFF_V = 2 * 64 * KST, OFF_KM = OFF_V + 2 * 64 * VST, OFF_BT = OFF_KM + 32 * KST, OFF_UM = OFF_BT + 4096;
    const int tid = tid_opaque(), lane = tid & 63, wave = __builtin_amdgcn_readfirstlane(tid >> 6);
    const int i32 = lane & 31, hh = lane >> 5;
    bf16_t* MBQ = (bf16_t*)(p.ws + WS_MB); const bf16_t* MBK = MBQ + (size_t)M_ * D_; const bf16_t* MBV = MBK + (size_t)M_ * D_;
    const float* KM = (const float*)(p.ws + WS_KMEAN); const float* BT = (const float*)(p.ws + WS_BT);
    const int G = gridDim.x, cblk = blockIdx.x;
    const int lrow = tid >> 3, lc = tid & 7;
    const unsigned vbase = lds_base + OFF_V + (4 * hh + ((lane & 15) >> 2)) * VST + (16 * ((lane >> 4) & 1) + 4 * (lane & 3)) * 2;
    const float NINF = -__builtin_inff();
    for (int k = 0;; ++k) {
        const int it = k * G + ((k & 1) ? (G - 1 - cblk) : cblk);
        if (it >= 1024) break;
        const int qb = 15 - (it >> 6), bh = it & 63, b = bh >> 4, h = bh & 15;
        const size_t rowb = (size_t)b * T_;
        __syncthreads();
        { const int r = tid >> 5, c4 = (tid & 31) * 4; const f32x4 kv = *(const f32x4*)(KM + ((size_t)(bh * 16 + r)) * 128 + c4);
          u32x2 w = {pkbf(kv[0], kv[1]), pkbf(kv[2], kv[3])}; *(LAS u32x2*)(lds + OFF_KM + r * KST + c4 * 2) = w; *(LAS u32x2*)(lds + OFF_KM + (r + 16) * KST + c4 * 2) = (u32x2){0u, 0u}; }
        { LAS float* bts = (LAS float*)(lds + OFF_BT); bts[tid] = BT[h * 4096 + tid]; bts[tid + 512] = BT[h * 4096 + tid + 512]; }
        const float c31 = BT[h * 4096 + 1023];
        const int q0 = qb * 256 + 32 * wave;
        bf16_t* qptr = MBQ + (rowb + q0 + i32) * D_ + h * 128;
        bf16x8 qf[8];
#pragma unroll
        for (int kc = 0; kc < 8; ++kc) qf[kc] = *(const bf16x8*)(qptr + 16 * kc + 8 * hh);
        __syncthreads();
        unsigned sel = 0;
        {
            f32x16 g;
#pragma unroll
            for (int r = 0; r < 16; ++r) g[r] = 0.f;
#pragma unroll
            for (int kc = 0; kc < 8; ++kc) { const bf16x8 a = *(const LAS bf16x8*)(lds + OFF_KM + i32 * KST + (16 * kc + 8 * hh) * 2); g = MFMA32(a, qf[kc], g); }
            float gate[16];
#pragma unroll
            for (int j = 0; j < 16; ++j) { const int half = (j >> 2) & 1, r = (j & 3) + 4 * (j >> 3); const float og = __shfl_xor(g[r], 32); gate[j] = (hh == half) ? g[r] : og; }
#pragma unroll
            for (int rep = 0; rep < 3; ++rep) { float best = NINF; int bi = -1;
#pragma unroll
                for (int j = 0; j < 16; ++j) if (j < qb && !((sel >> j) & 1u) && gate[j] > best) { best = gate[j]; bi = j; }
                if (bi >= 0) sel |= 1u << bi; }
        }
        { unsigned wsel = sel;
#pragma unroll
          for (int o = 1; o < 64; o <<= 1) wsel |= (unsigned)__shfl_xor((int)wsel, o);
          if (lane == 0) ((LAS unsigned*)(lds + OFF_UM))[wave] = wsel; }
        __syncthreads();
        unsigned um = 0;
#pragma unroll
        for (int w = 0; w < 8; ++w) um |= ((const LAS unsigned*)(lds + OFF_UM))[w];
        um = __builtin_amdgcn_readfirstlane(um);

        f32x16 O[4];
#pragma unroll
        for (int dt = 0; dt < 4; ++dt)
#pragma unroll
            for (int r = 0; r < 16; ++r) O[dt][r] = 0.f;
        float m = NINF, l = 0.f;
        int j = qb, kt = 0, buf = 0;
        u32x4 rk0, rk1, rv0, rv1;
#define MOBA_LOAD(jj, kk) do { const size_t r_ = (rowb + (jj) * 256 + (kk) * 64 + lrow) * D_ + h * 128 + lc * 16; rk0 = *(const u32x4*)(MBK + r_); rk1 = *(const u32x4*)(MBK + r_ + 8); rv0 = *(const u32x4*)(MBV + r_); rv1 = *(const u32x4*)(MBV + r_ + 8); } while (0)
#define MOBA_STORE(bb) do { LAS unsigned char* kd = lds + OFF_K + (bb) * 64 * KST + lrow * KST + lc * 32; *(LAS u32x4*)kd = rk0; *(LAS u32x4*)(kd + 16) = rk1; \
        LAS unsigned char* vd = lds + OFF_V + (bb) * 64 * VST + lrow * VST + lc * 32; *(LAS u32x4*)vd = rv0; *(LAS u32x4*)(vd + 16) = rv1; } while (0)
        MOBA_LOAD(j, kt); MOBA_STORE(0); __syncthreads();
        while (j >= 0) {
            int nj = j, nkt = kt + 1;
            if (nkt == 4) { nkt = 0; do { --nj; } while (nj >= 0 && !((um >> nj) & 1u)); }
            if (nj >= 0) MOBA_LOAD(nj, nkt);
            const bool own = (j == qb);
            bool need;
            if (own) need = (kt * 64 <= 32 * wave + 31); else need = (__ballot((sel >> j) & 1u) != 0ull);
            if (need) {
                const LAS unsigned char* Ks = lds + OFF_K + buf * 64 * KST + i32 * KST + 16 * hh;
                f32x16 s0, s1;
#pragma unroll
                for (int r = 0; r < 16; ++r) { s0[r] = 0.f; s1[r] = 0.f; }
#pragma unroll
                for (int kc = 0; kc < 8; ++kc) { const bf16x8 a0 = *(const LAS bf16x8*)(Ks + 32 * kc), a1 = *(const LAS bf16x8*)(Ks + 32 * KST + 32 * kc);
                    s0 = MFMA32(a0, qf[kc], s0); s1 = MFMA32(a1, qf[kc], s1); }
                const int tq = q0 + i32, kbase = j * 256 + kt * 64;
                const bool far = (q0 - (kbase + 63)) >= 790;
                const bool diag = own && (kbase + 63 > q0);
                const bool lsel = own || ((sel >> j) & 1u);
                const int db = tq - kbase - 4 * hh;
                if (far) {
#pragma unroll
                    for (int r = 0; r < 16; ++r) { s0[r] += c31; s1[r] += c31; }
                } else {
                    const LAS float* bp = (const LAS float*)(lds + OFF_BT) + db;
                    float b0[16], b1[16];
#pragma unroll
                    for (int r = 0; r < 16; ++r) { b0[r] = bp[-(8 * (r >> 2) + (r & 3))]; b1[r] = bp[-(32 + 8 * (r >> 2) + (r & 3))]; }
#pragma unroll
                    for (int r = 0; r < 16; ++r) { s0[r] += b0[r]; s1[r] += b1[r]; }
                }
                if (diag) {
#pragma unroll
                    for (int r = 0; r < 16; ++r) { const int d0 = db - (8 * (r >> 2) + (r & 3)); if (d0 < 0) s0[r] = NINF; if (d0 < 32) s1[r] = NINF; }
                }
                float mx = NINF;
#pragma unroll
                for (int r = 0; r < 16; ++r) { if (!lsel) { s0[r] = NINF; s1[r] = NINF; } mx = fmaxf(mx, fmaxf(s0[r], s1[r])); }
                mx = fmaxf(mx, __shfl_xor(mx, 32));
                const float mnew = fmaxf(m, mx);
                const float alpha = __builtin_amdgcn_exp2f(m - mnew);
                float ps = 0.f;
#pragma unroll
                for (int r = 0; r < 16; ++r) { s0[r] = __builtin_amdgcn_exp2f(s0[r] - mnew); s1[r] = __builtin_amdgcn_exp2f(s1[r] - mnew); ps += s0[r] + s1[r]; }
                l = l * alpha + ps; m = mnew;
                if (__ballot(alpha != 1.0f) != 0ull) {
#pragma unroll
                    for (int dt = 0; dt < 4; ++dt)
#pragma unroll
                        for (int r = 0; r < 16; ++r) O[dt][r] *= alpha;
                }
                const unsigned va = vbase + buf * 64 * VST;
                u32x2 v[8];
                { const bf16x8 pf = pack8(s0, 0); tr8<0, 8 * VST, 64>(va, v);
#pragma unroll
                  for (int dt = 0; dt < 4; ++dt) O[dt] = MFMA32(frag2(v[2 * dt], v[2 * dt + 1]), pf, O[dt]); }
                { const bf16x8 pf = pack8(s0, 1); tr8<16 * VST, 8 * VST, 64>(va, v);
#pragma unroll
                  for (int dt = 0; dt < 4; ++dt) O[dt] = MFMA32(frag2(v[2 * dt], v[2 * dt + 1]), pf, O[dt]); }
                { const bf16x8 pf = pack8(s1, 0); tr8<32 * VST, 8 * VST, 64>(va, v);
#pragma unroll
                  for (int dt = 0; dt < 4; ++dt) O[dt] = MFMA32(frag2(v[2 * dt], v[2 * dt + 1]), pf, O[dt]); }
                { const bf16x8 pf = pack8(s1, 1); tr8<48 * VST, 8 * VST, 64>(va, v);
#pragma unroll
                  for (int dt = 0; dt < 4; ++dt) O[dt] = MFMA32(frag2(v[2 * dt], v[2 * dt + 1]), pf, O[dt]); }
            }
            if (nj >= 0) MOBA_STORE(buf ^ 1);
            __syncthreads();
            j = nj; kt = nkt; buf ^= 1;
        }
#undef MOBA_LOAD
#undef MOBA_STORE
        l += __shfl_xor(l, 32);
        const float inv = 1.0f / l;
#pragma unroll
        for (int dt = 0; dt < 4; ++dt)
#pragma unroll
            for (int r4 = 0; r4 < 4; ++r4) {
                u32x2 w = {pkbf(O[dt][4 * r4] * inv, O[dt][4 * r4 + 1] * inv), pkbf(O[dt][4 * r4 + 2] * inv, O[dt][4 * r4 + 3] * inv)};
                *(u32x2*)(qptr + 32 * dt + 4 * hh + 8 * r4) = w;
            }
    }
}


#define MFMA16(a, b, c) __builtin_amdgcn_mfma_f32_16x16x32_bf16((a), (b), (c), 0, 0, 0)
__device__ __forceinline__ void phase_dn_local(const Params& p, LAS unsigned char* lds) {
    const int tid = tid_opaque(), lane = tid & 63, wave = __builtin_amdgcn_readfirstlane(tid >> 6), i32 = lane & 31, hh = lane >> 5;
    LAS unsigned char* wl = lds + wave * 18432;
    LAS float* Am = (LAS float*)wl; LAS bf16_t* Tb = (LAS bf16_t*)wl; LAS bf16_t* Tb2 = (LAS bf16_t*)(wl + 8192);
    LAS float* gcs = (LAS float*)(wl + 16384); LAS float* bes = gcs + 64;
    bf16_t* QKV = (bf16_t*)(p.ws + WS_QKV); float* BA = (float*)(p.ws + WS_BA); bf16_t* WDN = (bf16_t*)(p.ws + WS_WDN); bf16_t* QKb = (bf16_t*)(p.ws + WS_QK);
    const int gw = blockIdx.x * 8 + wave, NGW = gridDim.x * 8;
    const unsigned fo6 = (unsigned)(i32 * 6144 + 8 * hh);
    const unsigned go6 = (unsigned)(8 * hh * 6144 + i32);
    const unsigned so6 = (unsigned)(4 * hh * 6144 + i32);
    const unsigned so2 = (unsigned)(4 * hh * D_ + i32);
    const unsigned soq = (unsigned)(4 * hh * 64 + i32);
    for (int ch = gw; ch < 4096; ch += NGW) {
        const int n = ch & 63, bh = ch >> 6, b = bh >> 4, h = bh & 15;
        const size_t r0 = (size_t)b * T_ + n * 64;
        float* bap = BA + r0 * 32 + h;
        const float be = bap[lane * 32];
        float gc = bap[lane * 32 + 16];
        { int ln = lane; asm volatile("" : "+v"(ln));
#pragma unroll
          for (int o = 1; o < 64; o <<= 1) { const float t = __shfl(gc, (ln - o) & 63); if (ln >= o) gc += t; } }
        gcs[lane] = gc; bes[lane] = be;
        bf16_t* kslab = QKV + r0 * 6144 + 2048 + h * 128;
        bf16_t* vslab = QKV + r0 * 6144 + 4096 + h * 128;
        const bf16_t* qslab = QKV + r0 * 6144 + h * 128;
        LDS_WAIT();
        const float gcj0 = gcs[i32], gcj1 = gcs[32 + i32];
        {
            f32x16 a00, a10, a11; bf16x8 kk0[8], kk1[8];
#pragma unroll
            for (int r = 0; r < 16; ++r) { a00[r] = 0.f; a10[r] = 0.f; a11[r] = 0.f; }
#pragma unroll
            for (int kc = 0; kc < 8; ++kc) { kk0[kc] = *(const bf16x8*)(kslab + 16 * kc + fo6); kk1[kc] = *(const bf16x8*)(kslab + 32 * 6144 + 16 * kc + fo6); }
            __builtin_amdgcn_sched_barrier(0);
#pragma unroll
            for (int kc = 0; kc < 8; ++kc) { a00 = MFMA32(kk0[kc], kk0[kc], a00); a10 = MFMA32(kk1[kc], kk0[kc], a10); a11 = MFMA32(kk1[kc], kk1[kc], a11); }
            const LAS float* gcl = gcs + 4 * hh; const LAS float* bel = bes + 4 * hh; LAS float* aml = Am + soq;
#pragma unroll
            for (int r = 0; r < 16; ++r) {
                const int ic = (r & 3) + 8 * (r >> 2);
                const float gi0 = gcl[ic], gi1 = gcl[32 + ic], bi0 = bel[ic], bi1 = bel[32 + ic];
                aml[ic * 64] = bi0 * a00[r] * __expf(fminf(gi0 - gcj0, 0.f));
                aml[(32 + ic) * 64] = bi1 * a10[r] * __expf(fminf(gi1 - gcj0, 0.f));
                aml[(32 + ic) * 64 + 32] = bi1 * a11[r] * __expf(fminf(gi1 - gcj1, 0.f));
            }
        }
        LDS_WAIT();
        {
            float T[64];
            f32x4 ra[16];
#define DN_LOADROW(i_, buf_) do { _Pragma("unroll") for (int j4 = 0; j4 < ((i_) + 3) / 4; ++j4) buf_[j4] = *(const LAS f32x4*)(Am + (i_) * 64 + 4 * j4); } while (0)
#define DN_ROW(i_, buf_) do { float c0 = 0.f, c1 = 0.f, c2 = 0.f, c3 = 0.f; \
                _Pragma("unroll") for (int j4 = 0; j4 < ((i_) + 3) / 4; ++j4) { \
                    if (4 * j4 + 0 < (i_)) c0 += buf_[j4][0] * T[4 * j4 + 0]; if (4 * j4 + 1 < (i_)) c1 += buf_[j4][1] * T[4 * j4 + 1]; \
                    if (4 * j4 + 2 < (i_)) c2 += buf_[j4][2] * T[4 * j4 + 2]; if (4 * j4 + 3 < (i_)) c3 += buf_[j4][3] * T[4 * j4 + 3]; } \
                T[i_] = ((lane == (i_)) ? 1.0f : 0.0f) - ((c0 + c1) + (c2 + c3)); } while (0)
#pragma unroll
            for (int i = 0; i < 64; ++i) {
                DN_LOADROW(i, ra); asm volatile("" ::: "memory");
                DN_ROW(i, ra);
                asm volatile("" ::: "memory");
            }
#undef DN_LOADROW
#undef DN_ROW
            LDS_WAIT();
            const float eg = __expf(gc);
#pragma unroll
            for (int i = 0; i < 64; ++i) { const float tp = T[i] * be; Tb[i * 64 + lane] = f2bf(tp); Tb2[i * 64 + lane] = f2bf(tp * eg); }
        }
        LDS_WAIT();
#define DN_TMUL(TBUF, SRC, DST, DSTLD, SOFF) do { \
            _Pragma("unroll 1") for (int dt = 0; dt < 4; ++dt) { \
                f32x16 u0, u1; \
                _Pragma("unroll") for (int r = 0; r < 16; ++r) { u0[r] = 0.f; u1[r] = 0.f; } \
                unsigned short rw[4][8]; \
                _Pragma("unroll") for (int jc = 0; jc < 4; ++jc) _Pragma("unroll") for (int e = 0; e < 8; ++e) rw[jc][e] = ((SRC) + (16 * jc + e) * 6144 + 32 * dt)[go6]; \
                __builtin_amdgcn_sched_barrier(0);     \
                _Pragma("unroll") for (int jc = 0; jc < 4; ++jc) { \
                    bf16x8 vb; \
                    _Pragma("unroll") for (int e = 0; e < 8; ++e) vb[e] = (short)rw[jc][e]; \
                    const bf16x8 ta0 = *(const LAS bf16x8*)((const LAS unsigned char*)(TBUF) + ((i32) * 64 + 16 * jc + 8 * hh) * 2); \
                    const bf16x8 ta1 = *(const LAS bf16x8*)((const LAS unsigned char*)(TBUF) + ((32 + i32) * 64 + 16 * jc + 8 * hh) * 2); \
                    u0 = MFMA32(ta0, vb, u0); u1 = MFMA32(ta1, vb, u1); } \
                asm volatile("" ::: "memory"); \
                _Pragma("unroll") for (int r = 0; r < 16; ++r) { \
                    ((DST) + ((r & 3) + 8 * (r >> 2)) * (DSTLD) + 32 * dt)[SOFF] = f2bf(u0[r]); \
                    ((DST) + (32 + (r & 3) + 8 * (r >> 2)) * (DSTLD) + 32 * dt)[SOFF] = f2bf(u1[r]); } \
                asm volatile("" ::: "memory"); } } while (0)
        DN_TMUL(Tb, vslab, vslab, 6144, so6);
        { bf16_t* wslab = WDN + r0 * D_ + h * 128; DN_TMUL(Tb2, kslab, wslab, D_, so2); }
#undef DN_TMUL
        {
            bf16x8 kf[2][8];
#pragma unroll
            for (int it = 0; it < 2; ++it)
#pragma unroll
                for (int kc = 0; kc < 8; ++kc) kf[it][kc] = *(const bf16x8*)(kslab + 32 * it * 6144 + 16 * kc + fo6);
            f32x16 q00, q10, q11; bf16x8 qa0[4], qa1[4];
#pragma unroll
            for (int r = 0; r < 16; ++r) { q00[r] = 0.f; q10[r] = 0.f; q11[r] = 0.f; }
#pragma unroll
            for (int kh = 0; kh < 2; ++kh) {
#pragma unroll
                for (int kc = 0; kc < 4; ++kc) { qa0[kc] = *(const bf16x8*)(qslab + 16 * (4 * kh + kc) + fo6); qa1[kc] = *(const bf16x8*)(qslab + 32 * 6144 + 16 * (4 * kh + kc) + fo6); }
                __builtin_amdgcn_sched_barrier(0);
#pragma unroll
                for (int kc = 0; kc < 4; ++kc) { q00 = MFMA32(qa0[kc], kf[0][4 * kh + kc], q00); q10 = MFMA32(qa1[kc], kf[0][4 * kh + kc], q10); q11 = MFMA32(qa1[kc], kf[1][4 * kh + kc], q11); }
                __builtin_amdgcn_sched_barrier(0);
            }
            asm volatile("" ::: "memory");
            bf16_t* qkc = QKb + (size_t)ch * 4096;
            const LAS float* gcl = gcs + 4 * hh;
#pragma unroll
            for (int r = 0; r < 16; ++r) {
                const int ic = (r & 3) + 8 * (r >> 2);
                const float gi0 = gcl[ic], gi1 = gcl[32 + ic];
                const bool low = (ic + 4 * hh >= i32);
                (qkc + ic * 64)[soq] = f2bf(low ? q00[r] * __expf(fminf(gi0 - gcj0, 0.f)) : 0.f);
                (qkc + ic * 64 + 32)[soq] = (bf16_t)0;
                (qkc + (32 + ic) * 64)[soq] = f2bf(q10[r] * __expf(fminf(gi1 - gcj0, 0.f)));
                (qkc + (32 + ic) * 64 + 32)[soq] = f2bf(low ? q11[r] * __expf(fminf(gi1 - gcj1, 0.f)) : 0.f);
            }
            asm volatile("" ::: "memory");
#pragma unroll
            for (int it = 0; it < 2; ++it)
#pragma unroll
                for (int kc = 0; kc < 8; ++kc) {
#pragma unroll
                    for (int e = 0; e < 8; ++e) (kslab + (8 * kc + (e >> 1)) * 6144 + (e & 1) * 64 + 32 * it)[so6] = (bf16_t)kf[it][kc][e];
                    asm volatile("" ::: "memory"); }
        }
        bap[lane * 32 + 16] = gc;
        LDS_WAIT();
    }
}
__device__ __forceinline__ bf16x8 pack44(const f32x4 a, const f32x4 b) { u32x4 w = {pkbf(a[0], a[1]), pkbf(a[2], a[3]), pkbf(b[0], b[1]), pkbf(b[2], b[3])}; return __builtin_bit_cast(bf16x8, w); }

__device__ __forceinline__ bf16x8 ldl44(const LAS unsigned char* p0) { const u32x2 a = *(const LAS u32x2*)p0, b = *(const LAS u32x2*)(p0 + 32); u32x4 w = {a.x, a.y, b.x, b.y}; return __builtin_bit_cast(bf16x8, w); }
#define SC_BAR() do { asm volatile("s_waitcnt lgkmcnt(0)" ::: "memory"); __builtin_amdgcn_s_barrier(); asm volatile("" ::: "memory"); } while (0)
__device__ __forceinline__ void phase_dn_scan3(const Params& p, LAS unsigned char* lds) {
    constexpr int WP = 272, KP = 144, QP = 144, UP = 80;
    constexpr int O_W = 0, O_Q = O_W + 64 * WP, O_KT = O_Q + 64 * WP, O_QK = O_KT + 128 * KP, O_U = O_QK + 64 * QP, O_GC = O_U + 64 * UP, BUF = O_GC + 256;
    static_assert(2 * BUF <= LDS_BYTES, "scan LDS image");
    const int tid = tid_opaque(), lane = tid & 63, wave = __builtin_amdgcn_readfirstlane(tid >> 6), i16 = lane & 15, g4 = lane >> 4;
    bf16_t* QKV = (bf16_t*)(p.ws + WS_QKV); const float* BA = (const float*)(p.ws + WS_BA); const bf16_t* WDN = (const bf16_t*)(p.ws + WS_WDN); const bf16_t* QKb = (const bf16_t*)(p.ws + WS_QK);
    for (int item = blockIdx.x; item < 256; item += gridDim.x) {
        const int xc = item & 7, sl = item >> 3, dvq = sl & 3, bh = (sl >> 2) * 8 + xc, b = bh >> 4, h = bh & 15;
        const size_t rowb = (size_t)b * T_;
        __syncthreads();
        if (wave >= 2) {
            const int lt = tid - 128;
            const int p0 = lt, p1 = lt + 384, p2 = (lt + 768 < 1024) ? lt + 768 : lt, q1 = (lt + 384 < 512) ? lt + 384 : lt, pu = lt & 255;
            const unsigned gw0 = (unsigned)((p0 >> 4) * (D_ * 2) + (p0 & 15) * 16), gw1 = (unsigned)((p1 >> 4) * (D_ * 2) + (p1 & 15) * 16), gw2 = (unsigned)((p2 >> 4) * (D_ * 2) + (p2 & 15) * 16);
            const unsigned g60 = (unsigned)((p0 >> 4) * 12288 + (p0 & 15) * 16), g61 = (unsigned)((p1 >> 4) * 12288 + (p1 & 15) * 16), g62 = (unsigned)((p2 >> 4) * 12288 + (p2 & 15) * 16);
            const unsigned lw0 = (unsigned)((p0 >> 4) * WP + (p0 & 15) * 16), lw1 = (unsigned)((p1 >> 4) * WP + (p1 & 15) * 16), lw2 = (unsigned)((p2 >> 4) * WP + (p2 & 15) * 16);
            const unsigned lk0 = (unsigned)((2 * (p0 >> 4) + ((p0 >> 3) & 1)) * KP + (p0 & 7) * 16), lk1 = (unsigned)((2 * (p1 >> 4) + ((p1 >> 3) & 1)) * KP + (p1 & 7) * 16), lk2 = (unsigned)((2 * (p2 >> 4) + ((p2 >> 3) & 1)) * KP + (p2 & 7) * 16);
            const unsigned gq0 = (unsigned)(p0 * 16), gq1 = (unsigned)(q1 * 16);
            const unsigned lq0 = (unsigned)((p0 >> 3) * QP + (p0 & 7) * 16), lq1 = (unsigned)((q1 >> 3) * QP + (q1 & 7) * 16);
            const unsigned gu0 = (unsigned)((pu >> 2) * 12288 + (pu & 3) * 16), lu0 = (unsigned)((pu >> 2) * UP + (pu & 3) * 16);
            const char* Wg = (const char*)(WDN + rowb * D_ + h * 128);
            const char* Qg = (const char*)(QKV + rowb * 6144 + h * 128);
            const char* Kg = (const char*)(QKV + rowb * 6144 + 2048 + h * 128);
            const char* Ug = (const char*)(QKV + rowb * 6144 + 4096 + h * 128 + dvq * 32);
            const char* QKg = (const char*)(QKb + (size_t)(bh * 64) * 4096);
            const float* gcp = BA + (rowb + (lt & 63)) * 32 + 16 + h;
            u32x4 dA[12], dB[12], dC[12]; float gA = 0.f, gB = 0.f, gC = 0.f;
#define SC_LOAD(D, GV, n) do { const char* w_ = Wg + (size_t)(n) * (64 * D_ * 2); const char* q_ = Qg + (size_t)(n) * (64 * 12288); const char* k_ = Kg + (size_t)(n) * (64 * 12288); \
                const char* u_ = Ug + (size_t)(n) * (64 * 12288); const char* qk_ = QKg + (size_t)(n) * 8192; \
                D[0] = *(const u32x4*)(w_ + gw0); D[1] = *(const u32x4*)(w_ + gw1); D[2] = *(const u32x4*)(w_ + gw2); \
                D[3] = *(const u32x4*)(q_ + g60); D[4] = *(const u32x4*)(q_ + g61); D[5] = *(const u32x4*)(q_ + g62); \
                D[6] = *(const u32x4*)(k_ + g60); D[7] = *(const u32x4*)(k_ + g61); D[8] = *(const u32x4*)(k_ + g62); \
                D[9] = *(const u32x4*)(qk_ + gq0); D[10] = *(const u32x4*)(qk_ + gq1); D[11] = *(const u32x4*)(u_ + gu0); \
                GV = gcp[(size_t)(n) * 2048]; } while (0)
#define SC_STORE(D, GV, bb) do { LAS unsigned char* bp = lds + (bb) * BUF; \
                *(LAS u32x4*)(bp + O_W + lw0) = D[0]; *(LAS u32x4*)(bp + O_W + lw1) = D[1]; *(LAS u32x4*)(bp + O_W + lw2) = D[2]; \
                *(LAS u32x4*)(bp + O_Q + lw0) = D[3]; *(LAS u32x4*)(bp + O_Q + lw1) = D[4]; *(LAS u32x4*)(bp + O_Q + lw2) = D[5]; \
                *(LAS u32x4*)(bp + O_KT + lk0) = D[6]; *(LAS u32x4*)(bp + O_KT + lk1) = D[7]; *(LAS u32x4*)(bp + O_KT + lk2) = D[8]; \
                *(LAS u32x4*)(bp + O_QK + lq0) = D[9]; *(LAS u32x4*)(bp + O_QK + lq1) = D[10]; *(LAS u32x4*)(bp + O_U + lu0) = D[11]; \
                ((LAS float*)(bp + O_GC))[lt & 63] = GV; } while (0)
#define SC_CL(n) ((n) < 64 ? (n) : 63)
#define SC_STEP(D, GV, t, bb) do { if ((t) < 64) { if ((t) + 1 < 64) SC_STORE(D, GV, bb); SC_LOAD(D, GV, SC_CL((t) + 4)); SC_BAR(); } } while (0)
            SC_LOAD(dA, gA, 0); SC_STORE(dA, gA, 0);
            SC_LOAD(dA, gA, 1); SC_LOAD(dB, gB, 2); SC_LOAD(dC, gC, 3);
            SC_BAR();
#pragma unroll 1
            for (int n = 0; n < 64; n += 6) {
                SC_STEP(dA, gA, n, 1); SC_STEP(dB, gB, n + 1, 0); SC_STEP(dC, gC, n + 2, 1);
                SC_STEP(dA, gA, n + 3, 0); SC_STEP(dB, gB, n + 4, 1); SC_STEP(dC, gC, n + 5, 0);
            }
#undef SC_STEP
#undef SC_CL
#undef SC_LOAD
#undef SC_STORE
        } else {
            f32x4 S[8];
#pragma unroll
            for (int dt = 0; dt < 8; ++dt) S[dt] = (f32x4){0.f, 0.f, 0.f, 0.f};
            SC_BAR();
#pragma unroll 1
            for (int n = 0; n < 64; ++n) {
                const LAS unsigned char* bp = lds + (n & 1) * BUF;
                const LAS unsigned char* wr_ = bp + O_W + i16 * WP + 8 * g4;
                const LAS unsigned char* qr_ = bp + O_Q + i16 * WP + 8 * g4;
                const LAS unsigned char* qkr = bp + O_QK + i16 * QP + 8 * g4;
                const LAS unsigned char* ktr = bp + O_KT + i16 * KP + 8 * g4;
                const LAS unsigned char* ur = bp + O_U + (4 * g4) * UP + (wave * 16 + i16) * 2;
                const LAS float* gcl = (const LAS float*)(bp + O_GC) + 4 * g4;
                const float gl = ((const LAS float*)(bp + O_GC))[63];
                bf16_t* uo = QKV + (rowb + n * 64 + 4 * g4) * 6144 + 4096 + h * 128 + dvq * 32 + wave * 16 + i16;
                bf16x8 wf[4][4], qf4[4][4];
#pragma unroll
                for (int mt = 0; mt < 4; ++mt)
#pragma unroll
                    for (int kc = 0; kc < 4; ++kc) { wf[mt][kc] = ldl44(wr_ + 16 * mt * WP + 64 * kc); qf4[mt][kc] = ldl44(qr_ + 16 * mt * WP + 64 * kc); }
                asm volatile("" ::: "memory");
                bf16x8 sb[4];
#pragma unroll
                for (int kc = 0; kc < 4; ++kc) sb[kc] = pack44(S[2 * kc], S[2 * kc + 1]);
                f32x4 ws4[4], qs4[4];
#pragma unroll
                for (int mt = 0; mt < 4; ++mt) { ws4[mt] = (f32x4){0.f, 0.f, 0.f, 0.f}; qs4[mt] = ws4[mt]; }
#pragma unroll
                for (int kc = 0; kc < 4; ++kc)
#pragma unroll
                    for (int mt = 0; mt < 4; ++mt) { ws4[mt] = MFMA16(wf[mt][kc], sb[kc], ws4[mt]); qs4[mt] = MFMA16(qf4[mt][kc], sb[kc], qs4[mt]); }
                bf16x8 qkf[4][2], ktf[8][2];
#pragma unroll
                for (int mt = 0; mt < 4; ++mt) { qkf[mt][0] = ldl44(qkr + 16 * mt * QP); qkf[mt][1] = ldl44(qkr + 16 * mt * QP + 64); }
#pragma unroll
                for (int dt = 0; dt < 8; ++dt) { ktf[dt][0] = ldl44(ktr + 16 * dt * KP); ktf[dt][1] = ldl44(ktr + 16 * dt * KP + 64); }
                float gcv[4][4], uu[4][4];
#pragma unroll
                for (int mt = 0; mt < 4; ++mt)
#pragma unroll
                    for (int r = 0; r < 4; ++r) { gcv[mt][r] = gcl[16 * mt + r]; uu[mt][r] = bf2f(*(const LAS bf16_t*)(ur + (16 * mt + r) * UP)); }
                asm volatile("" ::: "memory");
                f32x4 vn[4], vs[4], eg[4];
#pragma unroll
                for (int mt = 0; mt < 4; ++mt)
#pragma unroll
                    for (int r = 0; r < 4; ++r) { eg[mt][r] = __expf(gcv[mt][r]); vn[mt][r] = uu[mt][r] - ws4[mt][r]; vs[mt][r] = vn[mt][r] * __expf(gl - gcv[mt][r]); }
                const bf16x8 vb10 = pack44(vn[0], vn[1]), vb11 = pack44(vn[2], vn[3]), vb20 = pack44(vs[0], vs[1]), vb21 = pack44(vs[2], vs[3]);
#pragma unroll
                for (int mt = 0; mt < 4; ++mt) { f32x4 o = qs4[mt] * eg[mt];
                    o = MFMA16(qkf[mt][0], vb10, o); o = MFMA16(qkf[mt][1], vb11, o);
#pragma unroll
                    for (int r = 0; r < 4; ++r) uo[(size_t)(16 * mt + r) * 6144] = f2bf(o[r]); }
                const float egl = __expf(gl);
#pragma unroll
                for (int dt = 0; dt < 8; ++dt) { f32x4 sn = S[dt] * egl; sn = MFMA16(ktf[dt][0], vb20, sn); sn = MFMA16(ktf[dt][1], vb21, sn); S[dt] = sn; }
                SC_BAR();
            }
        }
    }
}


__device__ __forceinline__ void phase_ba(const Params& p, LAS unsigned char* lds) {
    const int tid = tid_opaque(), lane = tid & 63, wave = __builtin_amdgcn_readfirstlane(tid >> 6), i32 = lane & 31, hh = lane >> 5;
    const bf16_t* U = (const bf16_t*)(p.ws + WS_U); const bf16_t* Wb = (const bf16_t*)(p.ws + WS_WIN1) + (size_t)12288 * 2048; float* BA = (float*)(p.ws + WS_BA);
    LAS float* red = (LAS float*)lds;
    for (int item = blockIdx.x; item < 256; item += gridDim.x) {
        const size_t row0 = (size_t)item * 64;
        f32x16 a0, a1;
#pragma unroll
        for (int r = 0; r < 16; ++r) { a0[r] = 0.f; a1[r] = 0.f; }
        const bf16_t* bp = Wb + (size_t)i32 * 2048 + 256 * wave + 8 * hh;
        const bf16_t* ap = U + (row0 + i32) * D_ + 256 * wave + 8 * hh;
#pragma unroll
        for (int kb = 0; kb < 2; ++kb) {
            bf16x8 bfr[8], af0[8], af1[8];
#pragma unroll
            for (int ks = 0; ks < 8; ++ks) { bfr[ks] = *(const bf16x8*)(bp + 16 * (8 * kb + ks)); af0[ks] = *(const bf16x8*)(ap + 16 * (8 * kb + ks)); af1[ks] = *(const bf16x8*)(ap + (size_t)32 * D_ + 16 * (8 * kb + ks)); }
            __builtin_amdgcn_sched_barrier(0);
#pragma unroll
            for (int ks = 0; ks < 8; ++ks) { a0 = MFMA32(af0[ks], bfr[ks], a0); a1 = MFMA32(af1[ks], bfr[ks], a1); }
        }
        __syncthreads();
#pragma unroll
        for (int r = 0; r < 16; ++r) { red[((wave * 2 + 0) * 16 + r) * 64 + lane] = a0[r]; red[((wave * 2 + 1) * 16 + r) * 64 + lane] = a1[r]; }
        __syncthreads();
#pragma unroll
        for (int q = 0; q < 4; ++q) { const int idx = tid + 512 * q, mt = idx >> 10, r = (idx >> 6) & 15, ln = idx & 63; float t = 0.f;
#pragma unroll
            for (int w8 = 0; w8 < 8; ++w8) t += red[((w8 * 2 + mt) * 16 + r) * 64 + ln];
            BA[(row0 + 32 * mt + (r & 3) + 8 * (r >> 2) + 4 * (ln >> 5)) * 32 + (ln & 31)] = t; }
    }
}

__device__ __forceinline__ void phase_ya(const Params& p) {
    const int tid_ = tid_opaque(); const int lane = tid_ & 63, wave = tid_ >> 6;
    const int gw = blockIdx.x * 8 + wave, NGW = gridDim.x * 8;
    bf16_t* QKV = (bf16_t*)(p.ws + WS_QKV);
    const int e8 = lane & 15;
    float gn[8];
#pragma unroll
    for (int i = 0; i < 8; ++i) gn[i] = p.dn_norm_g[e8 * 8 + i];
    constexpr int NIT = M_ * 16 / 4;
    u32x4 oA = {0u, 0u, 0u, 0u}, zA = oA, oB = oA, zB = oA;
#define YA_PTRS(it_, opA_, opB_, v2_) const int it2_ = (it_) + NGW; const bool v2_ = it2_ < NIT; \
        const int pairA_ = (it_) * 4 + (lane >> 4), pairB_ = (v2_ ? it2_ : (it_)) * 4 + (lane >> 4); \
        bf16_t* opA_ = QKV + (size_t)(pairA_ >> 4) * 6144 + 4096 + (pairA_ & 15) * 128 + e8 * 8; \
        bf16_t* opB_ = QKV + (size_t)(pairB_ >> 4) * 6144 + 4096 + (pairB_ & 15) * 128 + e8 * 8
    if (gw < NIT) { YA_PTRS(gw, a_, b_, v_); (void)v_; oA = *(const u32x4*)a_; zA = *(const u32x4*)(a_ - 4096); oB = *(const u32x4*)b_; zB = *(const u32x4*)(b_ - 4096); }
    for (int it = gw; it < NIT; it += 2 * NGW) {
        YA_PTRS(it, opA, opB, v2);
        const int itn = (it + 2 * NGW < NIT) ? it + 2 * NGW : it;
        u32x4 noA, nzA, noB, nzB;
        { YA_PTRS(itn, a_, b_, v_); (void)v_; noA = *(const u32x4*)a_; nzA = *(const u32x4*)(a_ - 4096); noB = *(const u32x4*)b_; nzB = *(const u32x4*)(b_ - 4096); }
        __builtin_amdgcn_sched_barrier(0);
#pragma unroll
        for (int half = 0; half < 2; ++half) {
            float of[8], zf[8]; unpack8(half ? oB : oA, of); unpack8(half ? zB : zA, zf);
            float ss = 0.f;
#pragma unroll
            for (int i = 0; i < 8; ++i) ss += of[i] * of[i];
            ss += __shfl_xor(ss, 1); ss += __shfl_xor(ss, 2); ss += __shfl_xor(ss, 4); ss += __shfl_xor(ss, 8);
            const float rs = rsqrtf(ss * (1.0f / 128.0f) + 1e-6f);
            u32x4 w;
#pragma unroll
            for (int e = 0; e < 4; ++e) w[e] = cvt_pk_bf16(of[2 * e] * rs * gn[2 * e] * siluf_(zf[2 * e]), of[2 * e + 1] * rs * gn[2 * e + 1] * siluf_(zf[2 * e + 1]));
            if (half == 0) *(u32x4*)opA = w; else if (v2) *(u32x4*)opB = w;
        }
        oA = noA; zA = nzA; oB = noB; zB = nzB;
    }
#undef YA_PTRS
}


#define XB_TMO      128
#define XB_XCNT(j)  (256  + 64 * (j))
#define XB_XSUB(j)  (1280 + 64 * (j))
#define XB_XGEN(j)  (2304 + 64 * (j))
#define XB_TOP      3328
#define XB_TOPGEN   3392
#define XCD_BAR_WORDS 3456
#define XB_SPIN_CAP (1u << 18)
__device__ __forceinline__ unsigned xb_ld(unsigned* p)              { return __hip_atomic_load(p, __ATOMIC_RELAXED, __HIP_MEMORY_SCOPE_AGENT); }
__device__ __forceinline__ unsigned xb_add(unsigned* p, unsigned v) { return __hip_atomic_fetch_add(p, v, __ATOMIC_RELAXED, __HIP_MEMORY_SCOPE_AGENT); }
__device__ __forceinline__ unsigned xb_xcc_id() { return (unsigned)__builtin_amdgcn_s_getreg((3 << 11) | 20) & 0xFu; }
#define XB_SPIN(cond, bar) do { unsigned _sp = 0; while (cond) { __builtin_amdgcn_s_sleep(1); \
    if ((++_sp & 255u) == 0u) { if (xb_ld(&(bar)[XB_TMO])) break; if (_sp > XB_SPIN_CAP) { atomicAdd(&(bar)[XB_TMO], 1u); break; } } } } while (0)
struct XcdBarrier { unsigned* bar; unsigned x; volatile LAS unsigned* st; };
__device__ __forceinline__ XcdBarrier xcd_barrier_post(unsigned* bar, volatile LAS unsigned* st) {
    XcdBarrier b; b.bar = bar; b.x = xb_xcc_id(); b.st = st;
    if (threadIdx.x == 0) (void)xb_add(&bar[XB_XCNT(b.x)], 1u);
    return b;
}
__device__ __forceinline__ void xcd_barrier_complete(unsigned* bar, unsigned x, unsigned& nloc, unsigned& nx) {
    const unsigned G = gridDim.x * gridDim.y * gridDim.z;
    unsigned sum, cnt, mine, sp = 0u;
    for (;;) {
        sum = 0u; cnt = 0u; mine = 0u;
#pragma unroll
        for (unsigned j = 0; j < 16; ++j) { const unsigned c = xb_ld(&bar[XB_XCNT(j)]); sum += c; cnt += (c > 0u) ? 1u : 0u; mine = (j == x) ? c : mine; }
        if (sum == G) break;
        __builtin_amdgcn_s_sleep(1);
        if ((++sp & 255u) == 0u) { if (xb_ld(&bar[XB_TMO])) break; if (sp > XB_SPIN_CAP) { atomicAdd(&bar[XB_TMO], 1u); break; } }
    }
    nloc = mine > 0u ? mine : 1u; nx = cnt > 0u ? cnt : 1u;
}
__device__ __forceinline__ void xcd_barrier(const XcdBarrier& b) {
    asm volatile("s_waitcnt vmcnt(0)" ::: "memory");
    __syncthreads();
    if (threadIdx.x == 0) {
        unsigned* bar = b.bar;
        __builtin_amdgcn_s_waitcnt(0);
        unsigned nloc = b.st[0], nx = b.st[1];
        if (nloc == 0u) { xcd_barrier_complete(bar, b.x, nloc, nx); b.st[0] = nloc; b.st[1] = nx; }
        const unsigned old = xb_add(&bar[XB_XSUB(b.x)], 1u);
        const unsigned gen = old / nloc;
        if (old + 1u == (gen + 1u) * nloc) {
            __builtin_amdgcn_fence(__ATOMIC_RELEASE, "agent");
            asm volatile("s_waitcnt vmcnt(0)" ::: "memory");
            const unsigned og = xb_add(&bar[XB_TOP], 1u);
            const unsigned tg = og / nx;
            if (og + 1u == (tg + 1u) * nx) xb_add(&bar[XB_TOPGEN], 1u);
            else XB_SPIN(xb_ld(&bar[XB_TOPGEN]) == tg, bar);
            __builtin_amdgcn_fence(__ATOMIC_ACQUIRE, "agent");
            xb_add(&bar[XB_XGEN(b.x)], 1u);
            asm volatile("s_waitcnt vmcnt(0)" ::: "memory");
        } else {
            XB_SPIN(xb_ld(&bar[XB_XGEN(b.x)]) == gen, bar);
            __builtin_amdgcn_fence(__ATOMIC_ACQUIRE, "agent");
            asm volatile("s_waitcnt vmcnt(0)" ::: "memory");
        }
    }
    __syncthreads();
}

__global__ void __launch_bounds__(512, 2) fwd_megakernel(Params p) {
    extern __shared__ __attribute__((aligned(16))) unsigned char lds_raw[];
    LAS unsigned char* lds = (LAS unsigned char*)lds_raw;
    cg::grid_group grid = cg::this_grid();
    __shared__ unsigned xb_st[2];
    if (threadIdx.x == 0) { xb_st[0] = 0u; xb_st[1] = 0u; }
    __syncthreads();
    const XcdBarrier xbar = xcd_barrier_post((unsigned*)(p.ws + WS_XBAR), (volatile LAS unsigned*)xb_st);
#define GRID_SYNC() xcd_barrier(xbar)
    const int G = gridDim.x, bid = blockIdx.x;
    unsigned char* ws = p.ws;
    bf16_t* U = (bf16_t*)(ws + WS_U); bf16_t* ACT = (bf16_t*)(ws + WS_ACT); bf16_t* QKV = (bf16_t*)(ws + WS_QKV); bf16_t* MB = (bf16_t*)(ws + WS_MB);
    const float* ada = (const float*)(ws + WS_ADA);
    const bf16_t* W13 = (const bf16_t*)(ws + WS_W13); const bf16_t* W2 = (const bf16_t*)(ws + WS_W2);

    phase0(p, lds);
    grid.sync();
    phase_ada_reduce(p);
    GRID_SYNC();
    phase_normmod(p.x, p.norm1_g, ada, 0 * D_, 1 * D_, U);
    GRID_SYNC();
    { pg8::Gemm g{U, D_, W13, D_}; pg8::StaticOrder S; S.init(64, 44, G, bid); pg8::EpiSwiglu E{ACT}; pg8::gemm_phase(lds, g, S, E); }
    GRID_SYNC();
    { pg8::Gemm g{ACT, FF_, W2, FF_}; pg8::StaticOrder S; S.init(64, 8, G, bid); pg8::EpiResid E{p.x, p.out, ada + 2 * D_, 0.5f}; pg8::gemm_phase(lds, g, S, E); }
    GRID_SYNC();
#ifndef PROBE_N
#define PROBE_N 0
#endif
    for (int pass = (PROBE_N > 0 ? 0 : 1); pass < 2; ++pass) {
    const int lim = (pass == 0) ? PROBE_N : 99;
    if (lim >= 1) { phase_normmod(p.out, p.norm2_g, ada, 3 * D_, 4 * D_, U); GRID_SYNC(); }
    if (lim >= 2) { pg8::Gemm g{U, D_, (const bf16_t*)(ws + WS_WIN1), D_}; pg8::StaticOrder S; S.init(64, 48, G, bid); pg8::EpiIn1 E{QKV, MB, (float*)(ws + WS_BA)}; pg8::gemm_phase(lds, g, S, E); phase_ba(p, lds); GRID_SYNC(); }
    if (lim >= 3) { phase_halo(p); GRID_SYNC(); }
    if (lim >= 4) { phase_postproc(p, lds); GRID_SYNC(); }
    if (lim >= 6) { phase_dn_local(p, lds); GRID_SYNC(); }
    if (lim >= 7) { phase_dn_scan3(p, lds); __syncthreads(); }
    if (lim >= 8) { phase_moba_mfma(p, lds, (unsigned)(size_t)lds_raw); }
    if (lim >= 7) GRID_SYNC();
    if (lim >= 9) { pg8::Gemm g{U, D_, (const bf16_t*)(ws + WS_WIN2), D_}; pg8::StaticOrder S; S.init(64, 24, G, bid); pg8::EpiIn2 E{QKV, MB + (size_t)M_ * D_}; pg8::gemm_phase(lds, g, S, E); GRID_SYNC(); }
    if (lim >= 10) { phase_ya(p); GRID_SYNC(); }
    if (lim >= 11) {
      { pg8::Gemm g{QKV + 4096, 6144, (const bf16_t*)(ws + WS_WPAB), D_}; pg8::StaticOrder S; S.init(64, 8, G, bid);
        pg8::EpiProjA E{QKV + 2048, 6144, MB + 2 * (size_t)M_ * D_}; pg8::gemm_phase(lds, g, S, E); }
      { pg8::Gemm g{MB, D_, (const bf16_t*)(ws + WS_WPAB) + (size_t)2048 * 2048, D_}; pg8::StaticOrder S; S.init(64, 8, G, bid);
        pg8::EpiProjB E{MB + (size_t)M_ * D_, D_, MB + 2 * (size_t)M_ * D_, U}; pg8::gemm_phase(lds, g, S, E); }
      GRID_SYNC(); }
    }
    { pg8::Gemm g{U, D_, (const bf16_t*)(ws + WS_WOUT), D_}; pg8::StaticOrder S; S.init(64, 8, G, bid); pg8::EpiResid E{p.out, p.out, ada + 5 * D_, 1.0f}; pg8::gemm_phase(lds, g, S, E); }
    GRID_SYNC();
    phase_normmod(p.out, p.norm3_g, ada, 6 * D_, 7 * D_, U);
    { const int tid_ = tid_opaque(); const int lane = tid_ & 63, wave = tid_ >> 6; __syncthreads();
      convert_ffn(p.f2w1, p.f2w3, p.f2w2, (bf16_t*)(ws + WS_W13), (bf16_t*)(ws + WS_W2), (LAS float*)(lds + wave * 8448), bid * 8 + wave, G * 8, lane); }
    GRID_SYNC();
    { pg8::Gemm g{U, D_, W13, D_}; pg8::StaticOrder S; S.init(64, 44, G, bid); pg8::EpiSwiglu E{ACT}; pg8::gemm_phase(lds, g, S, E); }
    GRID_SYNC();
    { pg8::Gemm g{ACT, FF_, W2, FF_}; pg8::StaticOrder S; S.init(64, 8, G, bid); pg8::EpiResid E{p.out, p.out, ada + 8 * D_, 0.5f}; pg8::gemm_phase(lds, g, S, E); }
}

extern "C" void kernel_launch(void* const* d_in, const int* in_sizes, int n_in, void* d_out, int out_size, void* d_ws, size_t ws_size, hipStream_t stream) {
    static int grid_blocks = 0;
    if (grid_blocks == 0) {
        if (n_in != 24 || ws_size < WS_END) { fprintf(stderr, "kernel_launch: unexpected n_in %d or ws_size %zu (< %zu)\n", n_in, ws_size, (size_t)WS_END); grid_blocks = -1; return; }
        int dev = 0, cus = 0, per_cu = 0;
        hipGetDevice(&dev);
        hipDeviceGetAttribute(&cus, hipDeviceAttributeMultiprocessorCount, dev);
        hipFuncSetAttribute((const void*)fwd_megakernel, hipFuncAttributeMaxDynamicSharedMemorySize, LDS_BYTES);
        hipOccupancyMaxActiveBlocksPerMultiprocessor(&per_cu, (const void*)fwd_megakernel, 512, LDS_BYTES);
        if (per_cu < 1) { fprintf(stderr, "kernel_launch: occupancy query says %d blocks per CU\n", per_cu); per_cu = 1; }
        (void)hipGetLastError();
        grid_blocks = cus;
        if (grid_blocks > 256) grid_blocks = 256;
    }
    if (grid_blocks < 0) return;
    Params p{};
    const float** pp = (const float**)&p;
    for (int i = 0; i < 24; ++i) pp[i] = (const float*)d_in[i];
    p.out = (float*)d_out; p.ws = (unsigned char*)d_ws;
    (void)hipMemsetAsync((char*)d_ws + WS_XBAR, 0, 16384, stream);
    void* args[] = {&p};
    hipError_t e = hipLaunchCooperativeKernel((const void*)fwd_megakernel, dim3(grid_blocks), dim3(512), args, LDS_BYTES, stream);
    if (e != hipSuccess) fprintf(stderr, "cooperative launch failed: %s (grid %d)\n", hipGetErrorString(e), grid_blocks);
}
```
